# Optimizing an MI355X kernel written in HIP

```python
import math
import jax, jax.numpy as jnp
from jax import lax
import numpy as np

D_MODEL = 1024
BATCH = 4
SEQ = 4096
DEPTH = 1

MEM_LEN = 256
D_FF = 2752
MLA_HEADS = 4
MLA_Q_RANK = 384
MLA_KV_RANK = 256
MLA_NOPE = 128
MLA_ROPE = 64
MLA_V = 128
MLA_QK = MLA_NOPE + MLA_ROPE
MLA_WIDTH = MLA_HEADS * MLA_V
SSM_WIDTH = D_MODEL - MLA_WIDTH
SSM_GROUP = 16
SSM_GROUPS = SSM_WIDTH // SSM_GROUP
SSM_STATE = 64
DT_MIN = 1e-3
DT_MAX = 1e-1
XATTN_HEADS = 4
XATTN_HEAD_DIM = 128
XATTN_WIDTH = XATTN_HEADS * XATTN_HEAD_DIM
IN_SPLITS = [MLA_Q_RANK, MLA_Q_RANK + MLA_KV_RANK, MLA_Q_RANK + MLA_KV_RANK + MLA_ROPE]
IN_WIDTH = MLA_Q_RANK + MLA_KV_RANK + MLA_ROPE + SSM_WIDTH
Q_BLOCK = 128
ROPE_THETA = 10000.0
EPS = 1e-6

kernel_name = "hymba_mla_s5_macaron_memxattn"


def rms_norm(x, g):
    xf = x.astype(jnp.float32)
    y = xf * lax.rsqrt(jnp.mean(xf * xf, axis=-1, keepdims=True) + EPS)
    return (y * g.astype(jnp.float32)).astype(x.dtype)


def swiglu(h, w_gate, w_up, w_down):
    return (jax.nn.silu(h @ w_gate) * (h @ w_up)) @ w_down


def rope(x, pos):
    half = x.shape[-1] // 2
    inv = ROPE_THETA ** (-jnp.arange(half, dtype=jnp.float32) / half)
    ang = (pos.astype(jnp.float32)[..., None] * inv)[:, :, None, :]
    cos, sin = jnp.cos(ang), jnp.sin(ang)
    x1 = x[..., :half].astype(jnp.float32)
    x2 = x[..., half:].astype(jnp.float32)
    return jnp.concatenate([x1 * cos - x2 * sin, x2 * cos + x1 * sin], axis=-1).astype(x.dtype)


def causal_block_attention(q, k, v):
    B, S, H, Dk = q.shape
    Dv = v.shape[-1]
    nb = S // Q_BLOCK
    scale = Dk ** -0.5
    qb = q.reshape(B, nb, Q_BLOCK, H, Dk).transpose(1, 0, 2, 3, 4)
    kpos = jnp.arange(S)

    def one_block(args):
        q_blk, i = args
        s = jnp.einsum('bqhd,bkhd->bhqk', q_blk, k).astype(jnp.float32) * scale
        qpos = i * Q_BLOCK + jnp.arange(Q_BLOCK)
        s = jnp.where(qpos[:, None] >= kpos[None, :], s, -jnp.inf)
        p = jax.nn.softmax(s, axis=-1).astype(v.dtype)
        return jnp.einsum('bhqk,bkhd->bqhd', p, v)

    out = lax.map(one_block, (qb, jnp.arange(nb)))
    return out.transpose(1, 0, 2, 3, 4).reshape(B, S, H, Dv)


def mla_mixer(c_q_in, c_kv_in, k_r, pos, q_norm, w_uq, kv_norm, w_ukv, qk_norm_q, qk_norm_k):
    B, S, _ = c_q_in.shape
    c_q = rms_norm(c_q_in, q_norm)
    q = (c_q @ w_uq).reshape(B, S, MLA_HEADS, MLA_QK)
    c_kv = rms_norm(c_kv_in, kv_norm)
    kv = (c_kv @ w_ukv).reshape(B, S, MLA_HEADS, MLA_NOPE + MLA_V)
    k_nope, v = kv[..., :MLA_NOPE], kv[..., MLA_NOPE:]
    k_rope = jnp.broadcast_to(k_r[:, :, None, :], (B, S, MLA_HEADS, MLA_ROPE))
    k = jnp.concatenate([k_nope, k_rope], axis=-1)
    q = rms_norm(q, qk_norm_q)
    k = rms_norm(k, qk_norm_k)
    q = jnp.concatenate([q[..., :MLA_NOPE], rope(q[..., MLA_NOPE:], pos)], axis=-1)
    k = jnp.concatenate([k[..., :MLA_NOPE], rope(k[..., MLA_NOPE:], pos)], axis=-1)
    o = causal_block_attention(q, k, v)
    return o.reshape(B, S, MLA_WIDTH)


def _complex_linear_combine(e1, e2):
    a1r, a1i, b1r, b1i = e1
    a2r, a2i, b2r, b2i = e2
    ar = a2r * a1r - a2i * a1i
    ai = a2r * a1i + a2i * a1r
    br = a2r * b1r - a2i * b1i + b2r
    bi = a2r * b1i + a2i * b1r + b2i
    return (ar, ai, br, bi)


def s5_mixer(u, a_re, a_im, log_dt, b_re, b_im, c_re, c_im, d, w_glu, b_glu):
    B, S, _ = u.shape
    f32 = jnp.float32
    uf = u.astype(f32).reshape(B, S, SSM_GROUPS, SSM_GROUP)
    lr, li = a_re.astype(f32), a_im.astype(f32)
    dt = jnp.exp(log_dt.astype(f32))[:, None]
    decay = jnp.exp(lr * dt)
    ar = decay * jnp.cos(li * dt)
    ai = decay * jnp.sin(li * dt)
    den = lr * lr + li * li
    nr = ar - 1.0
    coef_r = (nr * lr + ai * li) / den
    coef_i = (ai * lr - nr * li) / den
    br, bi = b_re.astype(f32), b_im.astype(f32)
    bbar_r = coef_r[..., None] * br - coef_i[..., None] * bi
    bbar_i = coef_r[..., None] * bi + coef_i[..., None] * br
    bu_r = jnp.einsum('bsgh,gph->bsgp', uf, bbar_r)
    bu_i = jnp.einsum('bsgh,gph->bsgp', uf, bbar_i)
    ar_t = jnp.broadcast_to(ar, bu_r.shape)
    ai_t = jnp.broadcast_to(ai, bu_r.shape)
    _, _, xr, xi = lax.associative_scan(_complex_linear_combine, (ar_t, ai_t, bu_r, bu_i), axis=1)
    y = (jnp.einsum('bsgp,ghp->bsgh', xr, c_re.astype(f32))
         - jnp.einsum('bsgp,ghp->bsgh', xi, c_im.astype(f32))
         + d.astype(f32) * uf)
    y = y.reshape(B, S, SSM_WIDTH)
    g = jax.nn.gelu(y)
    out = g * jax.nn.sigmoid(g @ w_glu.astype(f32) + b_glu.astype(f32))
    return out.astype(u.dtype)


def memory_cross_attention(h, mem, mem_norm, w_q, w_kv, qn, kn, w_o):
    B, S, _ = h.shape
    M = mem.shape[1]
    q = (h @ w_q).reshape(B, S, XATTN_HEADS, XATTN_HEAD_DIM)
    m = rms_norm(mem, mem_norm)
    kv = (m @ w_kv).reshape(B, M, 2, XATTN_HEADS, XATTN_HEAD_DIM)
    k, v = kv[:, :, 0], kv[:, :, 1]
    q = rms_norm(q, qn)
    k = rms_norm(k, kn)
    s = jnp.einsum('bshd,bmhd->bhsm', q, k).astype(jnp.float32) * (XATTN_HEAD_DIM ** -0.5)
    p = jax.nn.softmax(s, axis=-1).astype(v.dtype)
    o = jnp.einsum('bhsm,bmhd->bshd', p, v).reshape(B, S, XATTN_WIDTH)
    return o @ w_o


def setup_inputs(seed: int = 0) -> dict:
    key = jax.random.key(seed)
    ks = iter(jax.random.split(key, 48))
    f32 = jnp.float32

    def nrm(shape):
        return jax.random.normal(next(ks), (DEPTH,) + shape, f32)

    def w(shape, fan_in):
        return nrm(shape) * (fan_in ** -0.5)

    def gain(dim):
        return 1.0 + 0.02 * nrm((dim,))

    x = jax.random.normal(next(ks), (BATCH, SEQ, D_MODEL), f32)
    mem = jax.random.normal(next(ks), (BATCH, MEM_LEN, D_MODEL), f32)
    positions = (jax.random.randint(next(ks), (BATCH, 1), 0, 1024, jnp.int32)
                 + jnp.arange(SEQ, dtype=jnp.int32)[None, :])
    ffn1_norm = gain(D_MODEL)
    ffn1_w_gate = w((D_MODEL, D_FF), D_MODEL)
    ffn1_w_up = w((D_MODEL, D_FF), D_MODEL)
    ffn1_w_down = w((D_FF, D_MODEL), D_FF)
    mix_norm = gain(D_MODEL)
    w_in = w((D_MODEL, IN_WIDTH), D_MODEL)
    mla_q_norm = gain(MLA_Q_RANK)
    mla_w_uq = w((MLA_Q_RANK, MLA_HEADS * MLA_QK), MLA_Q_RANK)
    mla_kv_norm = gain(MLA_KV_RANK)
    mla_w_ukv = w((MLA_KV_RANK, MLA_HEADS * (MLA_NOPE + MLA_V)), MLA_KV_RANK)
    mla_qk_norm_q = gain(MLA_QK)
    mla_qk_norm_k = gain(MLA_QK)
    n = jnp.arange(SSM_STATE, dtype=f32)
    ssm_a_re = -0.5 + 0.01 * nrm((SSM_GROUPS, SSM_STATE))
    ssm_a_im = math.pi * n + 0.01 * nrm((SSM_GROUPS, SSM_STATE))
    ssm_log_dt = jax.random.uniform(next(ks), (DEPTH, SSM_GROUPS), f32, math.log(DT_MIN), math.log(DT_MAX))
    ssm_b_re = nrm((SSM_GROUPS, SSM_STATE, SSM_GROUP)) * (0.5 / SSM_GROUP) ** 0.5
    ssm_b_im = nrm((SSM_GROUPS, SSM_STATE, SSM_GROUP)) * (0.5 / SSM_GROUP) ** 0.5
    ssm_c_re = nrm((SSM_GROUPS, SSM_GROUP, SSM_STATE)) * (0.5 / SSM_STATE) ** 0.5
    ssm_c_im = nrm((SSM_GROUPS, SSM_GROUP, SSM_STATE)) * (0.5 / SSM_STATE) ** 0.5
    ssm_d = nrm((SSM_GROUPS, SSM_GROUP))
    ssm_w_glu = w((SSM_WIDTH, SSM_WIDTH), SSM_WIDTH)
    ssm_b_glu = 0.01 * nrm((SSM_WIDTH,))
    out_norm_mla = gain(MLA_WIDTH)
    out_norm_ssm = gain(SSM_WIDTH)
    w_o = w((MLA_WIDTH + SSM_WIDTH, D_MODEL), MLA_WIDTH + SSM_WIDTH)
    xattn_norm = gain(D_MODEL)
    mem_norm = gain(D_MODEL)
    xattn_w_q = w((D_MODEL, XATTN_WIDTH), D_MODEL)
    xattn_w_kv = w((D_MODEL, 2 * XATTN_WIDTH), D_MODEL)
    xattn_q_norm = gain(XATTN_HEAD_DIM)
    xattn_k_norm = gain(XATTN_HEAD_DIM)
    xattn_w_o = w((XATTN_WIDTH, D_MODEL), XATTN_WIDTH)
    ffn2_norm = gain(D_MODEL)
    ffn2_w_gate = w((D_MODEL, D_FF), D_MODEL)
    ffn2_w_up = w((D_MODEL, D_FF), D_MODEL)
    ffn2_w_down = w((D_FF, D_MODEL), D_FF)
    return {
        'x': x, 'mem': mem, 'positions': positions,
        'ffn1_norm': ffn1_norm, 'ffn1_w_gate': ffn1_w_gate, 'ffn1_w_up': ffn1_w_up, 'ffn1_w_down': ffn1_w_down,
        'mix_norm': mix_norm, 'w_in': w_in,
        'mla_q_norm': mla_q_norm, 'mla_w_uq': mla_w_uq, 'mla_kv_norm': mla_kv_norm, 'mla_w_ukv': mla_w_ukv,
        'mla_qk_norm_q': mla_qk_norm_q, 'mla_qk_norm_k': mla_qk_norm_k,
        'ssm_a_re': ssm_a_re, 'ssm_a_im': ssm_a_im, 'ssm_log_dt': ssm_log_dt,
        'ssm_b_re': ssm_b_re, 'ssm_b_im': ssm_b_im, 'ssm_c_re': ssm_c_re, 'ssm_c_im': ssm_c_im,
        'ssm_d': ssm_d, 'ssm_w_glu': ssm_w_glu, 'ssm_b_glu': ssm_b_glu,
        'out_norm_mla': out_norm_mla, 'out_norm_ssm': out_norm_ssm, 'w_o': w_o,
        'xattn_norm': xattn_norm, 'mem_norm': mem_norm, 'xattn_w_q': xattn_w_q, 'xattn_w_kv': xattn_w_kv,
        'xattn_q_norm': xattn_q_norm, 'xattn_k_norm': xattn_k_norm, 'xattn_w_o': xattn_w_o,
        'ffn2_norm': ffn2_norm, 'ffn2_w_gate': ffn2_w_gate, 'ffn2_w_up': ffn2_w_up, 'ffn2_w_down': ffn2_w_down,
    }


def reference(x, mem, positions,
              ffn1_norm, ffn1_w_gate, ffn1_w_up, ffn1_w_down,
              mix_norm, w_in,
              mla_q_norm, mla_w_uq, mla_kv_norm, mla_w_ukv, mla_qk_norm_q, mla_qk_norm_k,
              ssm_a_re, ssm_a_im, ssm_log_dt, ssm_b_re, ssm_b_im, ssm_c_re, ssm_c_im,
              ssm_d, ssm_w_glu, ssm_b_glu,
              out_norm_mla, out_norm_ssm, w_o,
              xattn_norm, mem_norm, xattn_w_q, xattn_w_kv, xattn_q_norm, xattn_k_norm, xattn_w_o,
              ffn2_norm, ffn2_w_gate, ffn2_w_up, ffn2_w_down):
    for l in range(DEPTH):
        x = x + 0.5 * swiglu(rms_norm(x, ffn1_norm[l]), ffn1_w_gate[l], ffn1_w_up[l], ffn1_w_down[l])
        h = rms_norm(x, mix_norm[l])
        proj = h @ w_in[l]
        c_q_in, c_kv_in, k_r, u = jnp.split(proj, IN_SPLITS, axis=-1)
        y_mla = mla_mixer(c_q_in, c_kv_in, k_r, positions, mla_q_norm[l], mla_w_uq[l],
                          mla_kv_norm[l], mla_w_ukv[l], mla_qk_norm_q[l], mla_qk_norm_k[l])
        y_ssm = s5_mixer(u, ssm_a_re[l], ssm_a_im[l], ssm_log_dt[l], ssm_b_re[l], ssm_b_im[l],
                         ssm_c_re[l], ssm_c_im[l], ssm_d[l], ssm_w_glu[l], ssm_b_glu[l])
        y = jnp.concatenate([rms_norm(y_mla, out_norm_mla[l]), rms_norm(y_ssm, out_norm_ssm[l])], axis=-1)
        x = x + y @ w_o[l]
        x = x + memory_cross_attention(rms_norm(x, xattn_norm[l]), mem, mem_norm[l], xattn_w_q[l],
                                       xattn_w_kv[l], xattn_q_norm[l], xattn_k_norm[l], xattn_w_o[l])
        x = x + 0.5 * swiglu(rms_norm(x, ffn2_norm[l]), ffn2_w_gate[l], ffn2_w_up[l], ffn2_w_down[l])
    return x
```

```cpp
#include <hip/hip_runtime.h>
#include <cstdint>
#include <cstdio>

typedef unsigned short bf16_t;
typedef short bf16x8 __attribute__((ext_vector_type(8)));
typedef short bf16x4 __attribute__((ext_vector_type(4)));
typedef float f32x4 __attribute__((ext_vector_type(4)));
typedef float f32x16 __attribute__((ext_vector_type(16)));
typedef unsigned u32x2 __attribute__((ext_vector_type(2)));
typedef unsigned u32x4 __attribute__((ext_vector_type(4)));

constexpr int BATCH = 4, SEQ = 4096, DM = 1024, T = BATCH * SEQ, MEML = 256, TM = BATCH * MEML;
constexpr int DFF = 2752, DFFP = 2816, NUP = 2 * DFFP;
constexpr int NIN = 1280;
constexpr int PQ = 0, PKR = 384, PKV = 512, PU = 768;
constexpr int QRANK = 384, KVRANK = 256, NH = 4, DQK = 192, DNOPE = 128, DROPE = 64, DV = 128;
constexpr int SSMW = 512, SG = 32, SP = 64;
constexpr float EPS = 1e-6f;
constexpr float LOG2E = 1.4426950408889634f;
constexpr float QSCALE = 0.07216878364870322f * LOG2E;
constexpr float XSCALE = 0.08838834764831845f * LOG2E;

constexpr size_t MiB = 1u << 20;
constexpr size_t WS_CTL = 0;
constexpr size_t WS_W1T = 1 * MiB;
constexpr size_t WS_WD1T = 12 * MiB;
constexpr size_t WS_W2T = 18 * MiB;
constexpr size_t WS_WD2T = 29 * MiB;
constexpr size_t WS_WINT = 35 * MiB;
constexpr size_t WS_WUQT = 38 * MiB;
constexpr size_t WS_WUKVT = 39 * MiB;
constexpr size_t WS_WGLUT = 40 * MiB;
constexpr size_t WS_WOT = 41 * MiB;
constexpr size_t WS_WXQT = 43 * MiB;
constexpr size_t WS_WXKVT = 44 * MiB;
constexpr size_t WS_WXOT = 46 * MiB;
constexpr size_t WS_ROPE = 63 * MiB;
constexpr size_t WS_SS = 67 * MiB;
constexpr size_t WS_SSQ = WS_SS + 256 * 1024;
constexpr size_t WS_SSKR = WS_SSQ + 128 * 1024;
constexpr size_t WS_SSKV = WS_SSKR + 64 * 1024;
constexpr size_t WS_SSY = 68 * MiB;
constexpr size_t WS_SSMEM = WS_SSY + 512 * 1024;
constexpr size_t WS_MEMB = 69 * MiB;
constexpr size_t WS_XK = 71 * MiB;
constexpr size_t WS_XVT = 72 * MiB;
constexpr size_t WS_XB = 74 * MiB;
constexpr size_t WS_G = WS_XB;
constexpr size_t WS_H = 106 * MiB;
constexpr size_t WS_PROJ = WS_H;
constexpr size_t WS_Q = WS_H + 40 * MiB;
constexpr size_t WS_K = WS_H + 64 * MiB;
constexpr size_t WS_XQ = WS_Q;
constexpr size_t WS_XO = WS_K;
constexpr size_t WS_VT = 194 * MiB;
constexpr size_t WS_YCAT = 210 * MiB;
constexpr size_t WS_END = 256 * MiB;

__device__ __forceinline__ unsigned f2bf(float f) { unsigned u = __builtin_bit_cast(unsigned, f); return (u + 0x7fffu + ((u >> 16) & 1u)) >> 16; }
__device__ __forceinline__ unsigned pk2(float lo, float hi) { return f2bf(lo) | (f2bf(hi) << 16); }
__device__ __forceinline__ float bf2f(unsigned short b) { return __builtin_bit_cast(float, (unsigned)b << 16); }
__device__ __forceinline__ float wave_sum(float v) {
#pragma unroll
    for (int o = 1; o < 64; o <<= 1) v += __shfl_xor(v, o);
    return v;
}
__device__ __forceinline__ float quad_row_sum(float v) { v += __shfl_xor(v, 16); v += __shfl_xor(v, 32); return v; }
__device__ __forceinline__ void st_bf4(bf16_t* p, f32x4 v) { u32x2 w; w.x = pk2(v[0], v[1]); w.y = pk2(v[2], v[3]); *(u32x2*)p = w; }
__device__ __forceinline__ float dot4(f32x4 v) { return (v[0] * v[0] + v[1] * v[1]) + (v[2] * v[2] + v[3] * v[3]); }

struct WDesc { const float* W; const float* W2; int ldw; int Ksrc; bf16_t* dst; int N; int K; const float* g; const float* g2; int gsplit; int mode; int ncols_src; int pad; };
__device__ __forceinline__ int src_chunk_col(const WDesc& d, int c, const float*& src) {
    src = d.W;
    switch (d.mode) {
        case 0: return (64 * c < d.ncols_src) ? 64 * c : -1;
        case 1: { const int pn = c >> 2, q = c & 3; const int col = 128 * pn + 64 * (q & 1); if (q >= 2) src = d.W2; return col < d.ncols_src ? col : -1; }
        case 2: { if (c < 6) return 64 * c; if (c == 6) return 640; if (c == 7) return -1; if (c < 12) return 384 + 64 * (c - 8); return 704 + 64 * (c - 12); }
        case 3: { const int h = c >> 2, q = c & 3; return q < 3 ? 192 * h + 64 * q : -1; }
    }
    return -1;
}
__global__ void __launch_bounds__(256) convert_w(WDesc d) {
    __shared__ float tile[64][65];
    const int nc = blockIdx.x, kc = blockIdx.y, tid = threadIdx.x;
    const float* src; const int col0 = src_chunk_col(d, nc, src); const int k0 = 64 * kc;
    const bool valid = (col0 >= 0) && (k0 < d.Ksrc);
    if (valid) {
        for (int e = tid; e < 64 * 64; e += 256) { const int kk = e >> 6, nn = e & 63; const int k = k0 + kk;
            float gg = 1.f; if (d.g) gg = (k < d.gsplit) ? d.g[k] : d.g2[k - d.gsplit];
            tile[kk][nn] = src[(size_t)k * d.ldw + col0 + nn] * gg; }
    }
    __syncthreads();
    for (int e = tid; e < 64 * 8; e += 256) { const int nn = e >> 3, ch = e & 7;
        u32x4 o = {0u, 0u, 0u, 0u};
        if (valid) { o.x = pk2(tile[8 * ch + 0][nn], tile[8 * ch + 1][nn]); o.y = pk2(tile[8 * ch + 2][nn], tile[8 * ch + 3][nn]);
                     o.z = pk2(tile[8 * ch + 4][nn], tile[8 * ch + 5][nn]); o.w = pk2(tile[8 * ch + 6][nn], tile[8 * ch + 7][nn]); }
        *(u32x4*)(d.dst + (size_t)(64 * nc + nn) * d.K + k0 + 8 * ch) = o; }
}
__global__ void __launch_bounds__(256) rows_to_bf16(const float* x, bf16_t* out, float* ss4, int rows, int pad) {
    const int row = blockIdx.x * 4 + (threadIdx.x >> 6), lane = threadIdx.x & 63; if (row >= rows) return;
    const f32x4* xr = (const f32x4*)(x + (size_t)row * DM) + lane; float s = 0.f;
    unsigned long long* o8 = (unsigned long long*)(out + (size_t)row * DM) + lane;
#pragma unroll
    for (int j = 0; j < 4; ++j) { const f32x4 v = xr[64 * j]; s += dot4(v); o8[64 * j] = (unsigned long long)pk2(v[0], v[1]) | ((unsigned long long)pk2(v[2], v[3]) << 32); }
    s = wave_sum(s);
    if (lane < 4) ss4[row * 4 + lane] = lane == 0 ? s : 0.f;
}
__global__ void __launch_bounds__(256) rope_table(const int* pos, float2* tab) {
    const int idx = blockIdx.x * 256 + threadIdx.x; if (idx >= T * 32) return;
    const int t = idx >> 5, i = idx & 31;
    const double inv = exp2(-(double)i / 32.0 * 13.287712379549449);
    double a = (double)pos[t] * inv; a -= 6.283185307179586 * rint(a / 6.283185307179586);
    float s, c; sincosf((float)a, &s, &c); tab[idx] = make_float2(c, s);
}

template <class Epi> __global__ void __launch_bounds__(256) gemm_simple(const bf16_t* A, const bf16_t* Bt, int lda, int ldb, int K, int kmid, Epi epi) {
    const int lane = threadIdx.x & 63, w = threadIdx.x >> 6, fr = lane & 15, fq = lane >> 4, pn = blockIdx.x, m0 = 64 * blockIdx.y + 16 * w;
    f32x4 acc[16];
#pragma unroll
    for (int f = 0; f < 16; ++f) acc[f] = (f32x4){0.f, 0.f, 0.f, 0.f};
    const bf16_t* ap = A + (size_t)(m0 + fr) * lda + 8 * fq;
    const bf16_t* bp = Bt + (size_t)(256 * pn + fr) * ldb + 8 * fq;
    for (int k0 = 0; k0 < K; k0 += 32) {
        if (k0 == kmid) epi.mid(acc, m0 + fr);
        const bf16x8 a = *(const bf16x8*)(ap + k0);
#pragma unroll
        for (int f = 0; f < 16; ++f) { const bf16x8 b = *(const bf16x8*)(bp + (size_t)(16 * f) * ldb + k0); acc[f] = __builtin_amdgcn_mfma_f32_16x16x32_bf16(b, a, acc[f], 0, 0, 0); }
    }
    epi(acc, m0 + fr, pn, fq);
}
__device__ __forceinline__ float rs_from4(const float* ss4, int row, float invc) { const f32x4 s = *(const f32x4*)(ss4 + 4 * row); return rsqrtf(((s[0] + s[1]) + (s[2] + s[3])) * invc + EPS); }

struct EpiUp {
    const float* ss; bf16_t* H;
    __device__ void mid(f32x4 (&)[16], int) const {}
    __device__ void operator()(f32x4 (&acc)[16], int row, int pn, int fq) const {
        const float rs = rs_from4(ss, row, 1.f / DM);
#pragma unroll
        for (int f = 0; f < 8; ++f) { f32x4 o;
#pragma unroll
            for (int i = 0; i < 4; ++i) { const float g = acc[f][i] * rs, u = acc[f + 8][i] * rs; o[i] = g / (1.f + __expf(-g)) * u; }
            st_bf4(H + (size_t)row * DFFP + 128 * pn + 16 * f + 4 * fq, o); }
    }
};
struct EpiRes {
    const float* resid; float* out; bf16_t* xb; float* ssout; float alpha; float pad;
    __device__ void mid(f32x4 (&)[16], int) const {}
    __device__ void operator()(f32x4 (&acc)[16], int row, int pn, int fq) const {
        float s = 0.f;
#pragma unroll
        for (int f = 0; f < 16; ++f) { const size_t off = (size_t)row * DM + 256 * pn + 16 * f + 4 * fq; const f32x4 v = *(const f32x4*)(resid + off) + acc[f] * alpha;
            *(f32x4*)(out + off) = v; if (xb) { st_bf4(xb + off, v); s += dot4(v); } }
        if (ssout) { s = quad_row_sum(s); if (fq == 0) ssout[row * 4 + pn] = s; }
    }
};
struct EpiWo {
    const float* ssy; float* out; bf16_t* xb; float* ssout;
    __device__ void rsv(int row, float& rm, float& rsm) const { const f32x4 a = *(const f32x4*)(ssy + 8 * row), b = *(const f32x4*)(ssy + 8 * row + 4);
        rm = rsqrtf(((a[0] + a[1]) + (a[2] + a[3])) * (1.f / 512) + EPS); rsm = rsqrtf((b[0] + b[1]) * (1.f / 512) + EPS); }
    __device__ void mid(f32x4 (&acc)[16], int row) const { float rm, rsm; rsv(row, rm, rsm); const float r = rm / rsm;
#pragma unroll
        for (int f = 0; f < 16; ++f) acc[f] = acc[f] * r; }
    __device__ void operator()(f32x4 (&acc)[16], int row, int pn, int fq) const {
        float rm, rsm; rsv(row, rm, rsm); float s = 0.f;
#pragma unroll
        for (int f = 0; f < 16; ++f) { const size_t off = (size_t)row * DM + 256 * pn + 16 * f + 4 * fq; const f32x4 v = *(const f32x4*)(out + off) + acc[f] * rsm;
            *(f32x4*)(out + off) = v; st_bf4(xb + off, v); s += dot4(v); }
        s = quad_row_sum(s); if (fq == 0) ssout[row * 4 + pn] = s;
    }
};
struct EpiIn {
    const float* ss; bf16_t* proj; float* ssq; float* sskr; float* sskv;
    __device__ void mid(f32x4 (&)[16], int) const {}
    __device__ void operator()(f32x4 (&acc)[16], int row, int pn, int fq) const {
        const float rs = rs_from4(ss, row, 1.f / DM); float s0 = 0.f, s1 = 0.f;
#pragma unroll
        for (int f = 0; f < 16; ++f) { const f32x4 v = acc[f] * rs; st_bf4(proj + (size_t)row * NIN + 256 * pn + 16 * f + 4 * fq, v);
            if (f < 8) s0 += dot4(v); else if (f < 12) s1 += dot4(v); else s0 += dot4(v); }
        if (pn == 0) { const float s = quad_row_sum(s0 + s1); if (fq == 0) ssq[row * 2] = s; }
        else if (pn == 1) { float a = 0.f, b = 0.f;
#pragma unroll
            for (int f = 0; f < 8; ++f) a += dot4(acc[f] * rs);
            b = s1; a = quad_row_sum(a); b = quad_row_sum(b); if (fq == 0) { ssq[row * 2 + 1] = a; sskr[row] = b; } }
        else if (pn == 2) { const float s = quad_row_sum(s0 + s1); if (fq == 0) sskv[row] = s; }
    }
};
struct EpiQ {
    const float* ssq; const float* gq; const float2* tab; bf16_t* Q;
    __device__ void mid(f32x4 (&)[16], int) const {}
    __device__ void operator()(f32x4 (&acc)[16], int row, int pn, int fq) const {
        const float rs = rsqrtf((ssq[2 * row] + ssq[2 * row + 1]) * (1.f / QRANK) + EPS); float s = 0.f;
#pragma unroll
        for (int f = 0; f < 12; ++f) { acc[f] = acc[f] * rs; s += dot4(acc[f]); }
        s = quad_row_sum(s); const float rh = rsqrtf(s * (1.f / DQK) + EPS) * QSCALE;
        bf16_t* qp = Q + (size_t)row * (NH * DQK) + DQK * pn + 4 * fq;
#pragma unroll
        for (int f = 0; f < 8; ++f) { const f32x4 g = *(const f32x4*)(gq + 16 * f + 4 * fq); st_bf4(qp + 16 * f, acc[f] * g * rh); }
#pragma unroll
        for (int f = 8; f < 10; ++f) { const f32x4 g1 = *(const f32x4*)(gq + 16 * f + 4 * fq), g2 = *(const f32x4*)(gq + 16 * (f + 2) + 4 * fq);
            f32x4 o1, o2;
#pragma unroll
            for (int i = 0; i < 4; ++i) { const float2 cs = tab[(size_t)row * 32 + 16 * (f - 8) + 4 * fq + i]; const float x1 = acc[f][i] * g1[i] * rh, x2 = acc[f + 2][i] * g2[i] * rh;
                o1[i] = x1 * cs.x - x2 * cs.y; o2[i] = x2 * cs.x + x1 * cs.y; }
            st_bf4(qp + 16 * f, o1); st_bf4(qp + 16 * (f + 2), o2); }
    }
};
struct EpiKV {
    const float* sskv; const float* sskr; const float* gk; const float2* tab; const bf16_t* proj; bf16_t* K; bf16_t* Vt;
    __device__ void mid(f32x4 (&)[16], int) const {}
    __device__ void operator()(f32x4 (&acc)[16], int row, int pn, int fq) const {
        const float rs = rsqrtf(sskv[row] * (1.f / KVRANK) + EPS); float s = 0.f;
#pragma unroll
        for (int f = 0; f < 16; ++f) acc[f] = acc[f] * rs;
#pragma unroll
        for (int f = 0; f < 8; ++f) s += dot4(acc[f]);
        s = quad_row_sum(s); const float rk = rsqrtf((s + sskr[row]) * (1.f / DQK) + EPS);
        bf16_t* kp = K + (size_t)row * (NH * DQK) + DQK * pn;
#pragma unroll
        for (int f = 0; f < 8; ++f) { const f32x4 g = *(const f32x4*)(gk + 16 * f + 4 * fq); st_bf4(kp + 16 * f + 4 * fq, acc[f] * g * rk); }
        const int b = row / SEQ, t = row % SEQ;
#pragma unroll
        for (int f = 8; f < 16; ++f)
#pragma unroll
            for (int i = 0; i < 4; ++i) { const int d = 16 * (f - 8) + 4 * fq + i; Vt[((size_t)(b * NH + pn) * DV + d) * SEQ + t] = (bf16_t)f2bf(acc[f][i]); }
        const bf16_t* kr = proj + (size_t)row * NIN + PKR;
        const bf16x8 a1 = *(const bf16x8*)(kr + 8 * fq), a2 = *(const bf16x8*)(kr + 32 + 8 * fq);
        float o1[8], o2[8];
#pragma unroll
        for (int j = 0; j < 8; ++j) { const int idx = 8 * fq + j; const float2 cs = tab[(size_t)row * 32 + idx];
            const float x1 = bf2f((unsigned short)a1[j]) * gk[128 + idx] * rk, x2 = bf2f((unsigned short)a2[j]) * gk[160 + idx] * rk;
            o1[j] = x1 * cs.x - x2 * cs.y; o2[j] = x2 * cs.x + x1 * cs.y; }
        u32x4 w1 = {pk2(o1[0], o1[1]), pk2(o1[2], o1[3]), pk2(o1[4], o1[5]), pk2(o1[6], o1[7])}, w2 = {pk2(o2[0], o2[1]), pk2(o2[2], o2[3]), pk2(o2[4], o2[5]), pk2(o2[6], o2[7])};
        *(u32x4*)(kp + 128 + 8 * fq) = w1; *(u32x4*)(kp + 160 + 8 * fq) = w2;
    }
};
struct EpiGlu {
    const bf16_t* G; const float* bias; bf16_t* ycat; float* ssy;
    __device__ void mid(f32x4 (&)[16], int) const {}
    __device__ void operator()(f32x4 (&acc)[16], int row, int pn, int fq) const {
        float s = 0.f;
#pragma unroll
        for (int f = 0; f < 16; ++f) { const int col = 256 * pn + 16 * f + 4 * fq; const bf16x4 gb = *(const bf16x4*)(G + (size_t)row * SSMW + col); const f32x4 bv = *(const f32x4*)(bias + col); f32x4 o;
#pragma unroll
            for (int i = 0; i < 4; ++i) { const float g = bf2f((unsigned short)gb[i]); o[i] = g / (1.f + __expf(-(acc[f][i] + bv[i]))); }
            st_bf4(ycat + (size_t)row * DM + 512 + col, o); s += dot4(o); }
        s = quad_row_sum(s); if (fq == 0) ssy[row * 8 + 4 + pn] = s;
    }
};
struct EpiXQ {
    const float* ss; const float* gq; bf16_t* XQ;
    __device__ void mid(f32x4 (&)[16], int) const {}
    __device__ void operator()(f32x4 (&acc)[16], int row, int pn, int fq) const {
        const float rs = rs_from4(ss, row, 1.f / DM); float s0 = 0.f, s1 = 0.f;
#pragma unroll
        for (int f = 0; f < 16; ++f) { acc[f] = acc[f] * rs; if (f < 8) s0 += dot4(acc[f]); else s1 += dot4(acc[f]); }
        s0 = quad_row_sum(s0); s1 = quad_row_sum(s1); const float r0 = rsqrtf(s0 * (1.f / 128) + EPS) * XSCALE, r1 = rsqrtf(s1 * (1.f / 128) + EPS) * XSCALE;
#pragma unroll
        for (int f = 0; f < 16; ++f) { const f32x4 g = *(const f32x4*)(gq + 16 * (f & 7) + 4 * fq); st_bf4(XQ + (size_t)row * 512 + 256 * pn + 16 * f + 4 * fq, acc[f] * g * (f < 8 ? r0 : r1)); }
    }
};
struct EpiMemKV {
    const float* ss; const float* gk; bf16_t* XK; bf16_t* XVt;
    __device__ void mid(f32x4 (&)[16], int) const {}
    __device__ void operator()(f32x4 (&acc)[16], int row, int pn, int fq) const {
        const float rs = rs_from4(ss, row, 1.f / DM);
#pragma unroll
        for (int f = 0; f < 16; ++f) acc[f] = acc[f] * rs;
        if (pn < 2) { float s0 = 0.f, s1 = 0.f;
#pragma unroll
            for (int f = 0; f < 16; ++f) { if (f < 8) s0 += dot4(acc[f]); else s1 += dot4(acc[f]); }
            s0 = quad_row_sum(s0); s1 = quad_row_sum(s1); const float r0 = rsqrtf(s0 * (1.f / 128) + EPS), r1 = rsqrtf(s1 * (1.f / 128) + EPS);
#pragma unroll
            for (int f = 0; f < 16; ++f) { const f32x4 g = *(const f32x4*)(gk + 16 * (f & 7) + 4 * fq); st_bf4(XK + (size_t)row * 512 + 256 * pn + 16 * f + 4 * fq, acc[f] * g * (f < 8 ? r0 : r1)); }
        } else { const int b = row / MEML, m = row % MEML;
#pragma unroll
            for (int f = 0; f < 16; ++f)
#pragma unroll
                for (int i = 0; i < 4; ++i) { const int c = 256 * (pn - 2) + 16 * f + 4 * fq + i, h = c >> 7, d = c & 127; XVt[((size_t)(b * NH + h) * 128 + d) * MEML + m] = (bf16_t)f2bf(acc[f][i]); }
        }
    }
};

template <int DK, int DVv, bool CAUSAL> __global__ void __launch_bounds__(256) attn_simple(const bf16_t* Q, const bf16_t* K, const bf16_t* Vt, bf16_t* O, float* ssout, int ldq, int ldk, int ldo, int ssld, int Sq, int Skv) {
    const int lane = threadIdx.x & 63, w = threadIdx.x >> 6, c = lane & 31, hi = lane >> 5;
    const int bh = blockIdx.y, b = bh / NH, h = bh % NH, q0 = 128 * blockIdx.x + 32 * w;
    const bf16_t* qp = Q + (size_t)(b * Sq + q0 + c) * ldq + h * DK + 8 * hi;
    bf16x8 qf[DK / 16];
#pragma unroll
    for (int s = 0; s < DK / 16; ++s) qf[s] = *(const bf16x8*)(qp + 16 * s);
    f32x16 o[DVv / 32];
#pragma unroll
    for (int d = 0; d < DVv / 32; ++d)
#pragma unroll
        for (int r = 0; r < 16; ++r) o[d][r] = 0.f;
    float m = -1e30f, l = 0.f;
    const int ntile = CAUSAL ? (q0 / 32 + 1) : (Skv / 32);
    const bf16_t* kbase = K + (size_t)(b * Skv) * ldk + h * DK + 8 * hi;
    const bf16_t* vbase = Vt + (size_t)bh * DVv * Skv;
    for (int tt = 0; tt < ntile; ++tt) {
        const int key0 = 32 * tt;
        f32x16 p;
#pragma unroll
        for (int r = 0; r < 16; ++r) p[r] = 0.f;
        const bf16_t* kp = kbase + (size_t)(key0 + c) * ldk;
#pragma unroll
        for (int s = 0; s < DK / 16; ++s) { const bf16x8 kf = *(const bf16x8*)(kp + 16 * s); p = __builtin_amdgcn_mfma_f32_32x32x16_bf16(kf, qf[s], p, 0, 0, 0); }
        if (CAUSAL && tt == ntile - 1) {
#pragma unroll
            for (int r = 0; r < 16; ++r) { const int key = key0 + (r & 3) + 8 * (r >> 2) + 4 * hi; if (key > q0 + c) p[r] = -INFINITY; }
        }
        float tm = p[0];
#pragma unroll
        for (int r = 1; r < 16; ++r) tm = fmaxf(tm, p[r]);
        tm = fmaxf(tm, __shfl_xor(tm, 32));
        const float mn = fmaxf(m, tm), alpha = exp2f(m - mn); m = mn;
        float ps = 0.f;
#pragma unroll
        for (int r = 0; r < 16; ++r) { p[r] = exp2f(p[r] - mn); ps += p[r]; }
        l = l * alpha + ps;
        bf16x8 pf[2];
#pragma unroll
        for (int s = 0; s < 2; ++s)
#pragma unroll
            for (int j = 0; j < 8; ++j) pf[s][j] = (short)f2bf(p[8 * s + j]);
#pragma unroll
        for (int d = 0; d < DVv / 32; ++d) {
#pragma unroll
            for (int r = 0; r < 16; ++r) o[d][r] *= alpha;
            const bf16_t* vp = vbase + (size_t)(32 * d + c) * Skv + key0 + 4 * hi;
#pragma unroll
            for (int s = 0; s < 2; ++s) { const bf16x4 v0 = *(const bf16x4*)(vp + 16 * s), v1 = *(const bf16x4*)(vp + 16 * s + 8);
                const bf16x8 vf = {v0[0], v0[1], v0[2], v0[3], v1[0], v1[1], v1[2], v1[3]};
                o[d] = __builtin_amdgcn_mfma_f32_32x32x16_bf16(vf, pf[s], o[d], 0, 0, 0); }
        }
    }
    l += __shfl_xor(l, 32); const float il = 1.f / l; float ss = 0.f;
    bf16_t* op = O + (size_t)(b * Sq + q0 + c) * ldo + h * DVv;
#pragma unroll
    for (int d = 0; d < DVv / 32; ++d)
#pragma unroll
        for (int g = 0; g < 4; ++g) { f32x4 v = {o[d][4 * g] * il, o[d][4 * g + 1] * il, o[d][4 * g + 2] * il, o[d][4 * g + 3] * il}; ss += dot4(v); st_bf4(op + 32 * d + 8 * g + 4 * hi, v); }
    if (ssout) { ss += __shfl_xor(ss, 32); if (hi == 0) ssout[(size_t)(b * Sq + q0 + c) * ssld + h] = ss; }
}

__global__ void __launch_bounds__(64) ssm_seq(const bf16_t* proj, const float* a_re, const float* a_im, const float* log_dt, const float* b_re, const float* b_im, const float* c_re, const float* c_im, const float* dd, bf16_t* G) {
    const int b = blockIdx.x / SG, g = blockIdx.x % SG, p = threadIdx.x;
    const float lr = a_re[g * SP + p], li = a_im[g * SP + p], dt = expf(log_dt[g]);
    const float decay = expf(lr * dt); float sn, cs; sincosf(li * dt, &sn, &cs);
    const float ar = decay * cs, ai = decay * sn, den = lr * lr + li * li, nr = ar - 1.f;
    const float cr = (nr * lr + ai * li) / den, ci = (ai * lr - nr * li) / den;
    float bbr[16], bbi[16], ccr[16], cci[16];
#pragma unroll
    for (int h = 0; h < 16; ++h) { const float br = b_re[(g * SP + p) * 16 + h], bi = b_im[(g * SP + p) * 16 + h]; bbr[h] = cr * br - ci * bi; bbi[h] = cr * bi + ci * br;
        ccr[h] = c_re[(g * 16 + h) * SP + p]; cci[h] = c_im[(g * 16 + h) * SP + p]; }
    const float dmy = dd[g * 16 + (p & 15)];
    float xr = 0.f, xi = 0.f;
    for (int t = 0; t < SEQ; ++t) {
        const bf16_t* up = proj + (size_t)(b * SEQ + t) * NIN + PU + g * 16;
        const bf16x8 u0 = *(const bf16x8*)up, u1 = *(const bf16x8*)(up + 8);
        float u[16];
#pragma unroll
        for (int h = 0; h < 8; ++h) { u[h] = bf2f((unsigned short)u0[h]); u[8 + h] = bf2f((unsigned short)u1[h]); }
        float bur = 0.f, bui = 0.f;
#pragma unroll
        for (int h = 0; h < 16; ++h) { bur += bbr[h] * u[h]; bui += bbi[h] * u[h]; }
        const float nxr = ar * xr - ai * xi + bur, nxi = ar * xi + ai * xr + bui; xr = nxr; xi = nxi;
        float ymine = 0.f;
#pragma unroll
        for (int h = 0; h < 16; ++h) { float v = wave_sum(xr * ccr[h] - xi * cci[h]); if ((p & 15) == h) ymine = v + dmy * u[h]; }
        if (p < 16) { const float y = ymine; const float gl = 0.5f * y * (1.f + tanhf(0.7978845608028654f * (y + 0.044715f * y * y * y)));
            G[(size_t)(b * SEQ + t) * SSMW + g * 16 + p] = (bf16_t)f2bf(gl); }
    }
}

template <class Epi> static void run_gemm(hipStream_t st, const bf16_t* A, int lda, const bf16_t* Bt, int ldb, int M, int N, int K, int kmid, Epi e) {
    hipLaunchKernelGGL((gemm_simple<Epi>), dim3(N / 256, M / 64), dim3(256), 0, st, A, Bt, lda, ldb, K, kmid, e);
}
static void run_convert(hipStream_t st, const float* W, const float* W2, int ldw, int Ksrc, int ncols_src, bf16_t* dst, int N, int K, const float* g, const float* g2, int gsplit, int mode) {
    WDesc d{W, W2, ldw, Ksrc, dst, N, K, g, g2, gsplit, mode, ncols_src, 0};
    hipLaunchKernelGGL(convert_w, dim3(N / 64, K / 64), dim3(256), 0, st, d);
}

extern "C" void kernel_launch(void* const* d_in, const int* in_sizes, int n_in, void* d_out, int out_size, void* d_ws, size_t ws_size, hipStream_t stream) {
    if (n_in != 39 || out_size != T * DM || ws_size < WS_END) { fprintf(stderr, "kernel_launch: unexpected shapes (n_in %d out %d ws %zu)\n", n_in, out_size, ws_size); return; }
    auto F = [&](int i) { return (const float*)d_in[i]; };
    unsigned char* ws = (unsigned char*)d_ws; float* out = (float*)d_out;
    auto B16 = [&](size_t off) { return (bf16_t*)(ws + off); };
    auto F32 = [&](size_t off) { return (float*)(ws + off); };
    const float* x = F(0); const float* mem = F(1); const int* pos = (const int*)d_in[2];
    run_convert(stream, F(4), F(5), DFF, DM, DFF, B16(WS_W1T), NUP, DM, F(3), F(3), DM, 1);
    run_convert(stream, F(6), nullptr, DM, DFF, DM, B16(WS_WD1T), DM, DFFP, nullptr, nullptr, 0, 0);
    run_convert(stream, F(36), F(37), DFF, DM, DFF, B16(WS_W2T), NUP, DM, F(35), F(35), DM, 1);
    run_convert(stream, F(38), nullptr, DM, DFF, DM, B16(WS_WD2T), DM, DFFP, nullptr, nullptr, 0, 0);
    run_convert(stream, F(8), nullptr, 1216, DM, 1216, B16(WS_WINT), NIN, DM, F(7), F(7), DM, 2);
    run_convert(stream, F(10), nullptr, 768, QRANK, 768, B16(WS_WUQT), 1024, QRANK, F(9), F(9), QRANK, 3);
    run_convert(stream, F(12), nullptr, 1024, KVRANK, 1024, B16(WS_WUKVT), 1024, KVRANK, F(11), F(11), KVRANK, 0);
    run_convert(stream, F(23), nullptr, 512, 512, 512, B16(WS_WGLUT), 512, 512, nullptr, nullptr, 0, 0);
    run_convert(stream, F(27), nullptr, DM, DM, DM, B16(WS_WOT), DM, DM, F(25), F(26), 512, 0);
    run_convert(stream, F(30), nullptr, 512, DM, 512, B16(WS_WXQT), 512, DM, F(28), F(28), DM, 0);
    run_convert(stream, F(31), nullptr, DM, DM, DM, B16(WS_WXKVT), DM, DM, F(29), F(29), DM, 0);
    run_convert(stream, F(34), nullptr, DM, 512, DM, B16(WS_WXOT), DM, 512, nullptr, nullptr, 0, 0);
    hipLaunchKernelGGL(rope_table, dim3(T * 32 / 256), dim3(256), 0, stream, pos, (float2*)(ws + WS_ROPE));
    hipLaunchKernelGGL(rows_to_bf16, dim3(T / 4), dim3(256), 0, stream, x, B16(WS_XB), F32(WS_SS), T, 0);
    hipLaunchKernelGGL(rows_to_bf16, dim3(TM / 4), dim3(256), 0, stream, mem, B16(WS_MEMB), F32(WS_SSMEM), TM, 0);
    run_gemm(stream, B16(WS_MEMB), DM, B16(WS_WXKVT), DM, TM, DM, DM, -1, EpiMemKV{F32(WS_SSMEM), F(33), B16(WS_XK), B16(WS_XVT)});
    run_gemm(stream, B16(WS_XB), DM, B16(WS_W1T), DM, T, NUP, DM, -1, EpiUp{F32(WS_SS), B16(WS_H)});
    run_gemm(stream, B16(WS_H), DFFP, B16(WS_WD1T), DFFP, T, DM, DFFP, -1, EpiRes{x, out, B16(WS_XB), F32(WS_SS), 0.5f, 0.f});
    run_gemm(stream, B16(WS_XB), DM, B16(WS_WINT), DM, T, NIN, DM, -1, EpiIn{F32(WS_SS), B16(WS_PROJ), F32(WS_SSQ), F32(WS_SSKR), F32(WS_SSKV)});
    run_gemm(stream, B16(WS_PROJ) + PQ, NIN, B16(WS_WUQT), QRANK, T, 1024, QRANK, -1, EpiQ{F32(WS_SSQ), F(13), (const float2*)(ws + WS_ROPE), B16(WS_Q)});
    run_gemm(stream, B16(WS_PROJ) + PKV, NIN, B16(WS_WUKVT), KVRANK, T, 1024, KVRANK, -1, EpiKV{F32(WS_SSKV), F32(WS_SSKR), F(14), (const float2*)(ws + WS_ROPE), B16(WS_PROJ), B16(WS_K), B16(WS_VT)});
    hipLaunchKernelGGL((attn_simple<DQK, DV, true>), dim3(SEQ / 128, BATCH * NH), dim3(256), 0, stream, B16(WS_Q), B16(WS_K), B16(WS_VT), B16(WS_YCAT), F32(WS_SSY), NH * DQK, NH * DQK, DM, 8, SEQ, SEQ);
    hipLaunchKernelGGL(ssm_seq, dim3(BATCH * SG), dim3(64), 0, stream, B16(WS_PROJ), F(15), F(16), F(17), F(18), F(19), F(20), F(21), F(22), B16(WS_G));
    run_gemm(stream, B16(WS_G), SSMW, B16(WS_WGLUT), SSMW, T, SSMW, SSMW, -1, EpiGlu{B16(WS_G), F(24), B16(WS_YCAT), F32(WS_SSY)});
    run_gemm(stream, B16(WS_YCAT), DM, B16(WS_WOT), DM, T, DM, DM, 512, EpiWo{F32(WS_SSY), out, B16(WS_XB), F32(WS_SS)});
    run_gemm(stream, B16(WS_XB), DM, B16(WS_WXQT), DM, T, 512, DM, -1, EpiXQ{F32(WS_SS), F(32), B16(WS_XQ)});
    hipLaunchKernelGGL((attn_simple<128, 128, false>), dim3(SEQ / 128, BATCH * NH), dim3(256), 0, stream, B16(WS_XQ), B16(WS_XK), B16(WS_XVT), B16(WS_XO), (float*)nullptr, 512, 512, 512, 0, SEQ, MEML);
    run_gemm(stream, B16(WS_XO), 512, B16(WS_WXOT), 512, T, DM, 512, -1, EpiRes{out, out, B16(WS_XB), F32(WS_SS), 1.0f, 0.f});
    run_gemm(stream, B16(WS_XB), DM, B16(WS_W2T), DM, T, NUP, DM, -1, EpiUp{F32(WS_SS), B16(WS_H)});
    run_gemm(stream, B16(WS_H), DFFP, B16(WS_WD2T), DFFP, T, DM, DFFP, -1, EpiRes{out, out, nullptr, nullptr, 0.5f, 0.f});
}
```

```cpp
#include <hip/hip_runtime.h>
#include <cstdint>
#include <cstdio>

typedef unsigned short bf16_t;
typedef short bf16x8 __attribute__((ext_vector_type(8)));
typedef short bf16x4 __attribute__((ext_vector_type(4)));
typedef float f32x4 __attribute__((ext_vector_type(4)));
typedef float f32x16 __attribute__((ext_vector_type(16)));
typedef unsigned u32x2 __attribute__((ext_vector_type(2)));
typedef unsigned u32x4 __attribute__((ext_vector_type(4)));

constexpr int BATCH = 4, SEQ = 4096, DM = 1024, T = BATCH * SEQ, MEML = 256, TM = BATCH * MEML;
constexpr int DFF = 2752, DFFP = 2816, NUP = 2 * DFFP;
constexpr int NIN = 1280;
constexpr int PQ = 0, PKR = 384, PKV = 512, PU = 768;
constexpr int QRANK = 384, KVRANK = 256, NH = 4, DQK = 192, DNOPE = 128, DROPE = 64, DV = 128;
constexpr int SSMW = 512, SG = 32, SP = 64;
constexpr float EPS = 1e-6f;
constexpr float LOG2E = 1.4426950408889634f;
constexpr float QSCALE = 0.07216878364870322f * LOG2E;
constexpr float XSCALE = 0.08838834764831845f * LOG2E;

constexpr size_t MiB = 1u << 20;
constexpr size_t WS_CTL = 0;
constexpr size_t WS_W1T = 1 * MiB;
constexpr size_t WS_WD1T = 12 * MiB;
constexpr size_t WS_W2T = 18 * MiB;
constexpr size_t WS_WD2T = 29 * MiB;
constexpr size_t WS_WINT = 35 * MiB;
constexpr size_t WS_WUQT = 38 * MiB;
constexpr size_t WS_WUKVT = 39 * MiB;
constexpr size_t WS_WGLUT = 40 * MiB;
constexpr size_t WS_WOT = 41 * MiB;
constexpr size_t WS_WXQT = 43 * MiB;
constexpr size_t WS_WXKVT = 44 * MiB;
constexpr size_t WS_WXOT = 46 * MiB;
constexpr size_t WS_ROPE = 63 * MiB;
constexpr size_t WS_SS = 67 * MiB;
constexpr size_t WS_SSQ = WS_SS + 256 * 1024;
constexpr size_t WS_SSKR = WS_SSQ + 128 * 1024;
constexpr size_t WS_SSKV = WS_SSKR + 64 * 1024;
constexpr size_t WS_SSY = 68 * MiB;
constexpr size_t WS_SSMEM = WS_SSY + 512 * 1024;
constexpr size_t WS_MEMB = 69 * MiB;
constexpr size_t WS_XK = 71 * MiB;
constexpr size_t WS_XVT = 72 * MiB;
constexpr size_t WS_XB = 74 * MiB;
constexpr size_t WS_G = WS_XB;
constexpr size_t WS_H = 106 * MiB;
constexpr size_t WS_PROJ = WS_H;
constexpr size_t WS_Q = WS_H + 40 * MiB;
constexpr size_t WS_K = WS_H + 64 * MiB;
constexpr size_t WS_XQ = WS_Q;
constexpr size_t WS_XO = WS_K;
constexpr size_t WS_VT = 194 * MiB;
constexpr size_t WS_YCAT = 210 * MiB;
constexpr size_t WS_END = 256 * MiB;

__device__ __forceinline__ unsigned f2bf(float f) { unsigned u = __builtin_bit_cast(unsigned, f); return (u + 0x7fffu + ((u >> 16) & 1u)) >> 16; }
__device__ __forceinline__ unsigned pk2(float lo, float hi) { return f2bf(lo) | (f2bf(hi) << 16); }
__device__ __forceinline__ float bf2f(unsigned short b) { return __builtin_bit_cast(float, (unsigned)b << 16); }
__device__ __forceinline__ float wave_sum(float v) {
#pragma unroll
    for (int o = 1; o < 64; o <<= 1) v += __shfl_xor(v, o);
    return v;
}
__device__ __forceinline__ float quad_row_sum(float v) { v += __shfl_xor(v, 16); v += __shfl_xor(v, 32); return v; }
__device__ __forceinline__ void st_bf4(bf16_t* p, f32x4 v) { u32x2 w; w.x = pk2(v[0], v[1]); w.y = pk2(v[2], v[3]); *(u32x2*)p = w; }
__device__ __forceinline__ float dot4(f32x4 v) { return (v[0] * v[0] + v[1] * v[1]) + (v[2] * v[2] + v[3] * v[3]); }

#define LAS __attribute__((address_space(3)))
#define GAS __attribute__((address_space(1)))
struct Params { const void* in[39]; float* out; unsigned char* ws; };
__device__ __forceinline__ const void* karg(int i) {
    const void* p;
    asm volatile("s_load_dwordx2 %0, %1, %2\n\ts_waitcnt lgkmcnt(0)" : "=s"(p) : "s"(__builtin_amdgcn_kernarg_segment_ptr()), "i"(8 * i) : "memory");
    return p;
}

struct WDesc { const float* W; const float* W2; int ldw; int Ksrc; bf16_t* dst; int N; int K; const float* g; const float* g2; int gsplit; int mode; int ncols_src; int pad; };
__device__ __forceinline__ int src_chunk_col(const WDesc& d, int c, const float*& src) {
    src = d.W;
    switch (d.mode) {
        case 0: return (64 * c < d.ncols_src) ? 64 * c : -1;
        case 1: { const int pn = c >> 2, q = c & 3; const int col = 128 * pn + 64 * (q & 1); if (q >= 2) src = d.W2; return col < d.ncols_src ? col : -1; }
        case 2: { if (c < 6) return 64 * c; if (c == 6) return 640; if (c == 7) return -1; if (c < 12) return 384 + 64 * (c - 8); return 704 + 64 * (c - 12); }
        case 3: { const int h = c >> 2, q = c & 3; return q < 3 ? 192 * h + 64 * q : -1; }
    }
    return -1;
}
constexpr int NWMAT = 12;
__device__ __forceinline__ WDesc get_wdesc(unsigned char* ws, int m) {
#define FI(i) ((const float*)karg(i))
#define WB(off) ((bf16_t*)(ws + (off)))
    switch (m) {
        case 0: return WDesc{FI(4), FI(5), DFF, DM, WB(WS_W1T), NUP, DM, FI(3), FI(3), DM, 1, DFF, 0};
        case 1: return WDesc{FI(36), FI(37), DFF, DM, WB(WS_W2T), NUP, DM, FI(35), FI(35), DM, 1, DFF, 0};
        case 2: return WDesc{FI(6), nullptr, DM, DFF, WB(WS_WD1T), DM, DFFP, nullptr, nullptr, 0, 0, DM, 0};
        case 3: return WDesc{FI(38), nullptr, DM, DFF, WB(WS_WD2T), DM, DFFP, nullptr, nullptr, 0, 0, DM, 0};
        case 4: return WDesc{FI(8), nullptr, 1216, DM, WB(WS_WINT), NIN, DM, FI(7), FI(7), DM, 2, 1216, 0};
        case 5: return WDesc{FI(10), nullptr, 768, QRANK, WB(WS_WUQT), 1024, QRANK, FI(9), FI(9), QRANK, 3, 768, 0};
        case 6: return WDesc{FI(12), nullptr, 1024, KVRANK, WB(WS_WUKVT), 1024, KVRANK, FI(11), FI(11), KVRANK, 0, 1024, 0};
        case 7: return WDesc{FI(23), nullptr, 512, 512, WB(WS_WGLUT), 512, 512, nullptr, nullptr, 0, 0, 512, 0};
        case 8: return WDesc{FI(27), nullptr, DM, DM, WB(WS_WOT), DM, DM, FI(25), FI(26), 512, 0, DM, 0};
        case 9: return WDesc{FI(30), nullptr, 512, DM, WB(WS_WXQT), 512, DM, FI(28), FI(28), DM, 0, 512, 0};
        case 10: return WDesc{FI(31), nullptr, DM, DM, WB(WS_WXKVT), DM, DM, FI(29), FI(29), DM, 0, DM, 0};
        default: return WDesc{FI(34), nullptr, DM, 512, WB(WS_WXOT), DM, 512, nullptr, nullptr, 0, 0, DM, 0};
    }
#undef FI
#undef WB
}
__device__ __forceinline__ int wmat_tiles(int m) {
    switch (m) { case 0: case 1: return (NUP / 64) * (DM / 64); case 2: case 3: return (DM / 64) * (DFFP / 64); case 4: return (NIN / 64) * (DM / 64); case 5: return 16 * (QRANK / 64);
        case 6: return 16 * (KVRANK / 64); case 7: return 64; case 8: return 256; case 9: return 8 * 16; case 10: return 256; default: return 16 * 8; }
}
constexpr int WTILES_TOTAL = 2 * (NUP / 64) * (DM / 64) + 2 * (DM / 64) * (DFFP / 64) + (NIN / 64) * (DM / 64) + 16 * (QRANK / 64) + 16 * (KVRANK / 64) + 64 + 256 + 128 + 256 + 128;
__device__ __forceinline__ void convert_tile_load(const WDesc& d, int nc, int kc, int vtid, float* tile, bool& valid) {
    const float* src; const int col0 = src_chunk_col(d, nc, src); const int k0 = 64 * kc;
    valid = (col0 >= 0) && (k0 < d.Ksrc);
    if (valid) {
        for (int e = vtid; e < 64 * 64; e += 256) { const int kk = e >> 6, nn = e & 63; const int k = k0 + kk;
            float gg = 1.f; if (d.g) gg = (k < d.gsplit) ? d.g[k] : d.g2[k - d.gsplit];
            tile[kk * 65 + nn] = src[(size_t)k * d.ldw + col0 + nn] * gg; }
    }
}
__device__ __forceinline__ void convert_tile_store(const WDesc& d, int nc, int kc, int vtid, const float* tile, bool valid) {
    const int k0 = 64 * kc;
    for (int e = vtid; e < 64 * 8; e += 256) { const int nn = e >> 3, ch = e & 7;
        u32x4 o = {0u, 0u, 0u, 0u};
        if (valid) { o.x = pk2(tile[(8 * ch + 0) * 65 + nn], tile[(8 * ch + 1) * 65 + nn]); o.y = pk2(tile[(8 * ch + 2) * 65 + nn], tile[(8 * ch + 3) * 65 + nn]);
                     o.z = pk2(tile[(8 * ch + 4) * 65 + nn], tile[(8 * ch + 5) * 65 + nn]); o.w = pk2(tile[(8 * ch + 6) * 65 + nn], tile[(8 * ch + 7) * 65 + nn]); }
        *(u32x4*)(d.dst + (size_t)(64 * nc + nn) * d.K + k0 + 8 * ch) = o; }
}
__device__ __forceinline__ void row_to_bf16(const float* x, bf16_t* out, float* ss4, int row, int lane) {
    const f32x4* xr = (const f32x4*)(x + (size_t)row * DM) + lane; float s = 0.f;
    unsigned long long* o8 = (unsigned long long*)(out + (size_t)row * DM) + lane;
#pragma unroll
    for (int j = 0; j < 4; ++j) { const f32x4 v = xr[64 * j]; s += dot4(v); o8[64 * j] = (unsigned long long)pk2(v[0], v[1]) | ((unsigned long long)pk2(v[2], v[3]) << 32); }
    s = wave_sum(s);
    if (lane < 4) ss4[row * 4 + lane] = lane == 0 ? s : 0.f;
}
__device__ __forceinline__ void rope_entry(const int* pos, float2* tab, int idx) {
    const int t = idx >> 5, i = idx & 31;
    const double inv = exp2(-(double)i / 32.0 * 13.287712379549449);
    double a = (double)pos[t] * inv; a -= 6.283185307179586 * rint(a / 6.283185307179586);
    float s, c; sincosf((float)a, &s, &c); tab[idx] = make_float2(c, s);
}

template <class Epi> __device__ __forceinline__ void gemm_simple_vb(int pn, int by, int vtid, const bf16_t* A, const bf16_t* Bt, int lda, int ldb, int K, int kmid, const Epi& epi) {
    const int lane = vtid & 63, w = vtid >> 6, fr = lane & 15, fq = lane >> 4, m0 = 64 * by + 16 * w;
    f32x4 acc[16];
#pragma unroll
    for (int f = 0; f < 16; ++f) acc[f] = (f32x4){0.f, 0.f, 0.f, 0.f};
    const bf16_t* ap = A + (size_t)(m0 + fr) * lda + 8 * fq;
    const bf16_t* bp = Bt + (size_t)(256 * pn + fr) * ldb + 8 * fq;
    for (int k0 = 0; k0 < K; k0 += 32) {
        if (k0 == kmid) epi.mid(acc, m0 + fr);
        const bf16x8 a = *(const bf16x8*)(ap + k0);
#pragma unroll
        for (int f = 0; f < 16; ++f) { const bf16x8 b = *(const bf16x8*)(bp + (size_t)(16 * f) * ldb + k0); acc[f] = __builtin_amdgcn_mfma_f32_16x16x32_bf16(b, a, acc[f], 0, 0, 0); }
    }
    epi(acc, m0 + fr, pn, fq);
}
__device__ __forceinline__ float rs_from4(const float* ss4, int row, float invc) { const f32x4 s = *(const f32x4*)(ss4 + 4 * row); return rsqrtf(((s[0] + s[1]) + (s[2] + s[3])) * invc + EPS); }

struct EpiUp {
    const float* ss; bf16_t* H;
    __device__ void mid(f32x4 (&)[16], int) const {}
    __device__ void operator()(f32x4 (&acc)[16], int row, int pn, int fq) const {
        const float rs = rs_from4(ss, row, 1.f / DM);
#pragma unroll
        for (int f = 0; f < 8; ++f) { f32x4 o;
#pragma unroll
            for (int i = 0; i < 4; ++i) { const float g = acc[f][i] * rs, u = acc[f + 8][i] * rs; o[i] = g / (1.f + __expf(-g)) * u; }
            st_bf4(H + (size_t)row * DFFP + 128 * pn + 16 * f + 4 * fq, o); }
    }
};
struct EpiRes {
    const float* resid; float* out; bf16_t* xb; float* ssout; float alpha; float pad;
    __device__ void mid(f32x4 (&)[16], int) const {}
    __device__ void operator()(f32x4 (&acc)[16], int row, int pn, int fq) const {
        float s = 0.f;
#pragma unroll
        for (int f = 0; f < 16; ++f) { const size_t off = (size_t)row * DM + 256 * pn + 16 * f + 4 * fq; const f32x4 v = *(const f32x4*)(resid + off) + acc[f] * alpha;
            *(f32x4*)(out + off) = v; if (xb) { st_bf4(xb + off, v); s += dot4(v); } }
        if (ssout) { s = quad_row_sum(s); if (fq == 0) ssout[row * 4 + pn] = s; }
    }
};
struct EpiWo {
    const float* ssy; float* out; bf16_t* xb; float* ssout;
    __device__ void rsv(int row, float& rm, float& rsm) const { const f32x4 a = *(const f32x4*)(ssy + 8 * row), b = *(const f32x4*)(ssy + 8 * row + 4);
        rm = rsqrtf(((a[0] + a[1]) + (a[2] + a[3])) * (1.f / 512) + EPS); rsm = rsqrtf((b[0] + b[1]) * (1.f / 512) + EPS); }
    __device__ void mid(f32x4 (&acc)[16], int row) const { float rm, rsm; rsv(row, rm, rsm); const float r = rm / rsm;
#pragma unroll
        for (int f = 0; f < 16; ++f) acc[f] = acc[f] * r; }
    __device__ void operator()(f32x4 (&acc)[16], int row, int pn, int fq) const {
        float rm, rsm; rsv(row, rm, rsm); float s = 0.f;
#pragma unroll
        for (int f = 0; f < 16; ++f) { const size_t off = (size_t)row * DM + 256 * pn + 16 * f + 4 * fq; const f32x4 v = *(const f32x4*)(out + off) + acc[f] * rsm;
            *(f32x4*)(out + off) = v; st_bf4(xb + off, v); s += dot4(v); }
        s = quad_row_sum(s); if (fq == 0) ssout[row * 4 + pn] = s;
    }
};
struct EpiIn {
    const float* ss; bf16_t* proj; float* ssq; float* sskr; float* sskv;
    __device__ void mid(f32x4 (&)[16], int) const {}
    __device__ void operator()(f32x4 (&acc)[16], int row, int pn, int fq) const {
        const float rs = rs_from4(ss, row, 1.f / DM); float s0 = 0.f, s1 = 0.f;
#pragma unroll
        for (int f = 0; f < 16; ++f) { const f32x4 v = acc[f] * rs; st_bf4(proj + (size_t)row * NIN + 256 * pn + 16 * f + 4 * fq, v);
            if (f < 8) s0 += dot4(v); else if (f < 12) s1 += dot4(v); else s0 += dot4(v); }
        if (pn == 0) { const float s = quad_row_sum(s0 + s1); if (fq == 0) ssq[row * 2] = s; }
        else if (pn == 1) { float a = 0.f, b = 0.f;
#pragma unroll
            for (int f = 0; f < 8; ++f) a += dot4(acc[f] * rs);
            b = s1; a = quad_row_sum(a); b = quad_row_sum(b); if (fq == 0) { ssq[row * 2 + 1] = a; sskr[row] = b; } }
        else if (pn == 2) { const float s = quad_row_sum(s0 + s1); if (fq == 0) sskv[row] = s; }
    }
};
struct EpiQ {
    const float* ssq; const float* gq; const float2* tab; bf16_t* Q;
    __device__ void mid(f32x4 (&)[16], int) const {}
    __device__ void operator()(f32x4 (&acc)[16], int row, int pn, int fq) const {
        const float rs = rsqrtf((ssq[2 * row] + ssq[2 * row + 1]) * (1.f / QRANK) + EPS); float s = 0.f;
#pragma unroll
        for (int f = 0; f < 12; ++f) { acc[f] = acc[f] * rs; s += dot4(acc[f]); }
        s = quad_row_sum(s); const float rh = rsqrtf(s * (1.f / DQK) + EPS) * QSCALE;
        bf16_t* qp = Q + (size_t)row * (NH * DQK) + DQK * pn + 4 * fq;
#pragma unroll
        for (int f = 0; f < 8; ++f) { const f32x4 g = *(const f32x4*)(gq + 16 * f + 4 * fq); st_bf4(qp + 16 * f, acc[f] * g * rh); }
#pragma unroll
        for (int f = 8; f < 10; ++f) { const f32x4 g1 = *(const f32x4*)(gq + 16 * f + 4 * fq), g2 = *(const f32x4*)(gq + 16 * (f + 2) + 4 * fq);
            f32x4 o1, o2;
#pragma unroll
            for (int i = 0; i < 4; ++i) { const float2 cs = tab[(size_t)row * 32 + 16 * (f - 8) + 4 * fq + i]; const float x1 = acc[f][i] * g1[i] * rh, x2 = acc[f + 2][i] * g2[i] * rh;
                o1[i] = x1 * cs.x - x2 * cs.y; o2[i] = x2 * cs.x + x1 * cs.y; }
            st_bf4(qp + 16 * f, o1); st_bf4(qp + 16 * (f + 2), o2); }
    }
};
struct EpiKV {
    const float* sskv; const float* sskr; const float* gk; const float2* tab; const bf16_t* proj; bf16_t* K; bf16_t* Vt;
    __device__ void mid(f32x4 (&)[16], int) const {}
    __device__ void operator()(f32x4 (&acc)[16], int row, int pn, int fq) const {
        const float rs = rsqrtf(sskv[row] * (1.f / KVRANK) + EPS); float s = 0.f;
#pragma unroll
        for (int f = 0; f < 16; ++f) acc[f] = acc[f] * rs;
#pragma unroll
        for (int f = 0; f < 8; ++f) s += dot4(acc[f]);
        s = quad_row_sum(s); const float rk = rsqrtf((s + sskr[row]) * (1.f / DQK) + EPS);
        bf16_t* kp = K + (size_t)row * (NH * DQK) + DQK * pn;
#pragma unroll
        for (int f = 0; f < 8; ++f) { const f32x4 g = *(const f32x4*)(gk + 16 * f + 4 * fq); st_bf4(kp + 16 * f + 4 * fq, acc[f] * g * rk); }
        const int b = row / SEQ, t = row % SEQ;
#pragma unroll
        for (int f = 8; f < 16; ++f)
#pragma unroll
            for (int i = 0; i < 4; ++i) { const int d = 16 * (f - 8) + 4 * fq + i; Vt[((size_t)(b * NH + pn) * DV + d) * SEQ + t] = (bf16_t)f2bf(acc[f][i]); }
        const bf16_t* kr = proj + (size_t)row * NIN + PKR;
        const bf16x8 a1 = *(const bf16x8*)(kr + 8 * fq), a2 = *(const bf16x8*)(kr + 32 + 8 * fq);
        float o1[8], o2[8];
#pragma unroll
        for (int j = 0; j < 8; ++j) { const int idx = 8 * fq + j; const float2 cs = tab[(size_t)row * 32 + idx];
            const float x1 = bf2f((unsigned short)a1[j]) * gk[128 + idx] * rk, x2 = bf2f((unsigned short)a2[j]) * gk[160 + idx] * rk;
            o1[j] = x1 * cs.x - x2 * cs.y; o2[j] = x2 * cs.x + x1 * cs.y; }
        u32x4 w1 = {pk2(o1[0], o1[1]), pk2(o1[2], o1[3]), pk2(o1[4], o1[5]), pk2(o1[6], o1[7])}, w2 = {pk2(o2[0], o2[1]), pk2(o2[2], o2[3]), pk2(o2[4], o2[5]), pk2(o2[6], o2[7])};
        *(u32x4*)(kp + 128 + 8 * fq) = w1; *(u32x4*)(kp + 160 + 8 * fq) = w2;
    }
};
struct EpiGlu {
    const bf16_t* G; const float* bias; bf16_t* ycat; float* ssy;
    __device__ void mid(f32x4 (&)[16], int) const {}
    __device__ void operator()(f32x4 (&acc)[16], int row, int pn, int fq) const {
        float s = 0.f;
#pragma unroll
        for (int f = 0; f < 16; ++f) { const int col = 256 * pn + 16 * f + 4 * fq; const bf16x4 gb = *(const bf16x4*)(G + (size_t)row * SSMW + col); const f32x4 bv = *(const f32x4*)(bias + col); f32x4 o;
#pragma unroll
            for (int i = 0; i < 4; ++i) { const float g = bf2f((unsigned short)gb[i]); o[i] = g / (1.f + __expf(-(acc[f][i] + bv[i]))); }
            st_bf4(ycat + (size_t)row * DM + 512 + col, o); s += dot4(o); }
        s = quad_row_sum(s); if (fq == 0) ssy[row * 8 + 4 + pn] = s;
    }
};
struct EpiXQ {
    const float* ss; const float* gq; bf16_t* XQ;
    __device__ void mid(f32x4 (&)[16], int) const {}
    __device__ void operator()(f32x4 (&acc)[16], int row, int pn, int fq) const {
        const float rs = rs_from4(ss, row, 1.f / DM); float s0 = 0.f, s1 = 0.f;
#pragma unroll
        for (int f = 0; f < 16; ++f) { acc[f] = acc[f] * rs; if (f < 8) s0 += dot4(acc[f]); else s1 += dot4(acc[f]); }
        s0 = quad_row_sum(s0); s1 = quad_row_sum(s1); const float r0 = rsqrtf(s0 * (1.f / 128) + EPS) * XSCALE, r1 = rsqrtf(s1 * (1.f / 128) + EPS) * XSCALE;
#pragma unroll
        for (int f = 0; f < 16; ++f) { const f32x4 g = *(const f32x4*)(gq + 16 * (f & 7) + 4 * fq); st_bf4(XQ + (size_t)row * 512 + 256 * pn + 16 * f + 4 * fq, acc[f] * g * (f < 8 ? r0 : r1)); }
    }
};
struct EpiMemKV {
    const float* ss; const float* gk; bf16_t* XK; bf16_t* XVt;
    __device__ void mid(f32x4 (&)[16], int) const {}
    __device__ void operator()(f32x4 (&acc)[16], int row, int pn, int fq) const {
        const float rs = rs_from4(ss, row, 1.f / DM);
#pragma unroll
        for (int f = 0; f < 16; ++f) acc[f] = acc[f] * rs;
        if (pn < 2) { float s0 = 0.f, s1 = 0.f;
#pragma unroll
            for (int f = 0; f < 16; ++f) { if (f < 8) s0 += dot4(acc[f]); else s1 += dot4(acc[f]); }
            s0 = quad_row_sum(s0); s1 = quad_row_sum(s1); const float r0 = rsqrtf(s0 * (1.f / 128) + EPS), r1 = rsqrtf(s1 * (1.f / 128) + EPS);
#pragma unroll
            for (int f = 0; f < 16; ++f) { const f32x4 g = *(const f32x4*)(gk + 16 * (f & 7) + 4 * fq); st_bf4(XK + (size_t)row * 512 + 256 * pn + 16 * f + 4 * fq, acc[f] * g * (f < 8 ? r0 : r1)); }
        } else { const int b = row / MEML, m = row % MEML;
#pragma unroll
            for (int f = 0; f < 16; ++f)
#pragma unroll
                for (int i = 0; i < 4; ++i) { const int c = 256 * (pn - 2) + 16 * f + 4 * fq + i, h = c >> 7, d = c & 127; XVt[((size_t)(b * NH + h) * 128 + d) * MEML + m] = (bf16_t)f2bf(acc[f][i]); }
        }
    }
};

template <int DK, int DVv, bool CAUSAL> __device__ __forceinline__ void attn_simple_vb(int qblk, int bh, int vtid, const bf16_t* Q, const bf16_t* K, const bf16_t* Vt, bf16_t* O, float* ssout, int ldq, int ldk, int ldo, int ssld, int Sq, int Skv) {
    const int lane = vtid & 63, w = vtid >> 6, c = lane & 31, hi = lane >> 5;
    const int b = bh / NH, h = bh % NH, q0 = 128 * qblk + 32 * w;
    const bf16_t* qp = Q + (size_t)(b * Sq + q0 + c) * ldq + h * DK + 8 * hi;
    f32x16 o[DVv / 32];
#pragma unroll
    for (int d = 0; d < DVv / 32; ++d)
#pragma unroll
        for (int r = 0; r < 16; ++r) o[d][r] = 0.f;
    float m = -1e30f, l = 0.f;
    const int ntile = CAUSAL ? (q0 / 32 + 1) : (Skv / 32);
    const bf16_t* kbase = K + (size_t)(b * Skv) * ldk + h * DK + 8 * hi;
    const bf16_t* vbase = Vt + (size_t)bh * DVv * Skv;
    for (int tt = 0; tt < ntile; ++tt) {
        const int key0 = 32 * tt;
        f32x16 p;
#pragma unroll
        for (int r = 0; r < 16; ++r) p[r] = 0.f;
        const bf16_t* kp = kbase + (size_t)(key0 + c) * ldk;
#pragma unroll
        for (int s = 0; s < DK / 16; ++s) { const bf16x8 kf = *(const bf16x8*)(kp + 16 * s); const bf16x8 qf = *(const bf16x8*)(qp + 16 * s); p = __builtin_amdgcn_mfma_f32_32x32x16_bf16(kf, qf, p, 0, 0, 0); }
        if (CAUSAL && tt == ntile - 1) {
#pragma unroll
            for (int r = 0; r < 16; ++r) { const int key = key0 + (r & 3) + 8 * (r >> 2) + 4 * hi; if (key > q0 + c) p[r] = -INFINITY; }
        }
        float tm = p[0];
#pragma unroll
        for (int r = 1; r < 16; ++r) tm = fmaxf(tm, p[r]);
        tm = fmaxf(tm, __shfl_xor(tm, 32));
        const float mn = fmaxf(m, tm), alpha = exp2f(m - mn); m = mn;
        float ps = 0.f;
#pragma unroll
        for (int r = 0; r < 16; ++r) { p[r] = exp2f(p[r] - mn); ps += p[r]; }
        l = l * alpha + ps;
        bf16x8 pf[2];
#pragma unroll
        for (int s = 0; s < 2; ++s)
#pragma unroll
            for (int j = 0; j < 8; ++j) pf[s][j] = (short)f2bf(p[8 * s + j]);
#pragma unroll
        for (int d = 0; d < DVv / 32; ++d) {
#pragma unroll
            for (int r = 0; r < 16; ++r) o[d][r] *= alpha;
            const bf16_t* vp = vbase + (size_t)(32 * d + c) * Skv + key0 + 4 * hi;
#pragma unroll
            for (int s = 0; s < 2; ++s) { const bf16x4 v0 = *(const bf16x4*)(vp + 16 * s), v1 = *(const bf16x4*)(vp + 16 * s + 8);
                const bf16x8 vf = {v0[0], v0[1], v0[2], v0[3], v1[0], v1[1], v1[2], v1[3]};
                o[d] = __builtin_amdgcn_mfma_f32_32x32x16_bf16(vf, pf[s], o[d], 0, 0, 0); }
        }
    }
    l += __shfl_xor(l, 32); const float il = 1.f / l; float ss = 0.f;
    bf16_t* op = O + (size_t)(b * Sq + q0 + c) * ldo + h * DVv;
#pragma unroll
    for (int d = 0; d < DVv / 32; ++d)
#pragma unroll
        for (int g = 0; g < 4; ++g) { f32x4 v = {o[d][4 * g] * il, o[d][4 * g + 1] * il, o[d][4 * g + 2] * il, o[d][4 * g + 3] * il}; ss += dot4(v); st_bf4(op + 32 * d + 8 * g + 4 * hi, v); }
    if (ssout) { ss += __shfl_xor(ss, 32); if (hi == 0) ssout[(size_t)(b * Sq + q0 + c) * ssld + h] = ss; }
}

__device__ __forceinline__ void ssm_seq_wave(int bg, int p, const bf16_t* proj, const float* a_re, const float* a_im, const float* log_dt, const float* b_re, const float* b_im, const float* c_re, const float* c_im, const float* dd, bf16_t* G) {
    const int b = bg / SG, g = bg % SG;
    const float lr = a_re[g * SP + p], li = a_im[g * SP + p], dt = expf(log_dt[g]);
    const float decay = expf(lr * dt); float sn, cs; sincosf(li * dt, &sn, &cs);
    const float ar = decay * cs, ai = decay * sn, den = lr * lr + li * li, nr = ar - 1.f;
    const float cr = (nr * lr + ai * li) / den, ci = (ai * lr - nr * li) / den;
    float bbr[16], bbi[16], ccr[16], cci[16];
#pragma unroll
    for (int h = 0; h < 16; ++h) { const float br = b_re[(g * SP + p) * 16 + h], bi = b_im[(g * SP + p) * 16 + h]; bbr[h] = cr * br - ci * bi; bbi[h] = cr * bi + ci * br;
        ccr[h] = c_re[(g * 16 + h) * SP + p]; cci[h] = c_im[(g * 16 + h) * SP + p]; }
    const float dmy = dd[g * 16 + (p & 15)];
    float xr = 0.f, xi = 0.f;
    for (int t = 0; t < SEQ; ++t) {
        const bf16_t* up = proj + (size_t)(b * SEQ + t) * NIN + PU + g * 16;
        const bf16x8 u0 = *(const bf16x8*)up, u1 = *(const bf16x8*)(up + 8);
        float u[16];
#pragma unroll
        for (int h = 0; h < 8; ++h) { u[h] = bf2f((unsigned short)u0[h]); u[8 + h] = bf2f((unsigned short)u1[h]); }
        float bur = 0.f, bui = 0.f;
#pragma unroll
        for (int h = 0; h < 16; ++h) { bur += bbr[h] * u[h]; bui += bbi[h] * u[h]; }
        const float nxr = ar * xr - ai * xi + bur, nxi = ar * xi + ai * xr + bui; xr = nxr; xi = nxi;
        float ymine = 0.f;
#pragma unroll
        for (int h = 0; h < 16; ++h) { float v = wave_sum(xr * ccr[h] - xi * cci[h]); if ((p & 15) == h) ymine = v + dmy * u[h]; }
        if (p < 16) { const float y = ymine; const float gl = 0.5f * y * (1.f + tanhf(0.7978845608028654f * (y + 0.044715f * y * y * y)));
            G[(size_t)(b * SEQ + t) * SSMW + g * 16 + p] = (bf16_t)f2bf(gl); }
    }
}
constexpr int NWAVES = 8, NTHREADS = NWAVES * 64;
constexpr int RING_BYTES = 131072, LDSCTL_OFF = RING_BYTES, MISC_OFF = LDSCTL_OFF + 320, LDS_BYTES = 147456;
constexpr size_t CTL_ZERO_BYTES = 64 * 1024;
constexpr int CW_BAR = 1024;
#define RLX_AGENT __ATOMIC_RELAXED, __HIP_MEMORY_SCOPE_AGENT
#define XB_TMO      128
#define XB_XCNT(j)  (256  + 64 * (j))
#define XB_XSUB(j)  (1280 + 64 * (j))
#define XB_XGEN(j)  (2304 + 64 * (j))
#define XB_TOP      3328
#define XB_TOPGEN   3392
#define XCD_BAR_WORDS 3456
#define XB_SPIN_CAP (1u << 24)
static_assert((CW_BAR + XCD_BAR_WORDS) * 4 <= (int)CTL_ZERO_BYTES, "barrier words inside the memset region");
__device__ __forceinline__ unsigned xb_ld(unsigned* p)              { return __hip_atomic_load(p, __ATOMIC_RELAXED, __HIP_MEMORY_SCOPE_AGENT); }
__device__ __forceinline__ unsigned xb_add(unsigned* p, unsigned v) { return __hip_atomic_fetch_add(p, v, __ATOMIC_RELAXED, __HIP_MEMORY_SCOPE_AGENT); }
__device__ __forceinline__ unsigned xb_xcc_id() { return (unsigned)__builtin_amdgcn_s_getreg((3 << 11) | 20) & 0xFu; }
#define XB_SPIN(cond, bar) do { unsigned _sp = 0; while (cond) { __builtin_amdgcn_s_sleep(1); \
    if ((++_sp & 255u) == 0u) { if (xb_ld(&(bar)[XB_TMO])) break; if (_sp > XB_SPIN_CAP) { atomicAdd(&(bar)[XB_TMO], 1u); break; } } } } while (0)
struct XcdBarrier { unsigned* bar; unsigned x; volatile LAS unsigned* st; };
__device__ __forceinline__ XcdBarrier xcd_barrier_post(unsigned* bar, volatile LAS unsigned* st) {
    XcdBarrier b; b.bar = bar; b.x = xb_xcc_id(); b.st = st;
    if (threadIdx.x == 0) (void)xb_add(&bar[XB_XCNT(b.x)], 1u);
    return b;
}
__device__ __forceinline__ void xcd_barrier_complete(unsigned* bar, unsigned x, unsigned& nloc, unsigned& nx) {
    const unsigned G = gridDim.x * gridDim.y * gridDim.z;
    unsigned sum, cnt, mine, sp = 0u;
    for (;;) {
        sum = 0u; cnt = 0u; mine = 0u;
#pragma unroll
        for (unsigned j = 0; j < 16; ++j) { const unsigned c = xb_ld(&bar[XB_XCNT(j)]); sum += c; cnt += (c > 0u) ? 1u : 0u; mine = (j == x) ? c : mine; }
        if (sum == G) break;
        __builtin_amdgcn_s_sleep(1);
        if ((++sp & 255u) == 0u) { if (xb_ld(&bar[XB_TMO])) break; if (sp > XB_SPIN_CAP) { atomicAdd(&bar[XB_TMO], 1u); break; } }
    }
    nloc = mine > 0u ? mine : 1u; nx = cnt > 0u ? cnt : 1u;
}
__device__ __forceinline__ void xcd_barrier(const XcdBarrier& b) {
    asm volatile("s_waitcnt vmcnt(0)" ::: "memory");
    __syncthreads();
    if (threadIdx.x == 0) {
        unsigned* bar = b.bar;
        __builtin_amdgcn_s_waitcnt(0);
        unsigned nloc = b.st[0], nx = b.st[1];
        if (nloc == 0u) { xcd_barrier_complete(bar, b.x, nloc, nx); b.st[0] = nloc; b.st[1] = nx; }
        const unsigned old = xb_add(&bar[XB_XSUB(b.x)], 1u);
        const unsigned gen = old / nloc;
        if (old + 1u == (gen + 1u) * nloc) {
            __builtin_amdgcn_fence(__ATOMIC_RELEASE, "agent");
            asm volatile("s_waitcnt vmcnt(0)" ::: "memory");
            const unsigned og = xb_add(&bar[XB_TOP], 1u);
            const unsigned tg = og / nx;
            if (og + 1u == (tg + 1u) * nx) xb_add(&bar[XB_TOPGEN], 1u);
            else XB_SPIN(xb_ld(&bar[XB_TOPGEN]) == tg, bar);
            __builtin_amdgcn_fence(__ATOMIC_ACQUIRE, "agent");
            xb_add(&bar[XB_XGEN(b.x)], 1u);
            asm volatile("s_waitcnt vmcnt(0)" ::: "memory");
        } else {
            XB_SPIN(xb_ld(&bar[XB_XGEN(b.x)]) == gen, bar);
            __builtin_amdgcn_fence(__ATOMIC_ACQUIRE, "agent");
            asm volatile("s_waitcnt vmcnt(0)" ::: "memory");
        }
    }
    __syncthreads();
}

#define FI(i) ((const float*)karg(i))
#define KOUT() ((float*)karg(39))
#define KWS() ((unsigned char*)karg(40))
#define B16(off) ((bf16_t*)(ws + (off)))
#define F32(off) ((float*)(ws + (off)))
#define PHASE_IDS() int tid = threadIdx.x; asm volatile("" : "+v"(tid)); const int lane = tid & 63, wave = __builtin_amdgcn_readfirstlane(tid >> 6), half = tid >> 8, vtid = tid & 255; \
    const int G = gridDim.x, bid = blockIdx.x; unsigned char* ws = KWS(); (void)lane; (void)wave; (void)half; (void)vtid; (void)G; (void)bid; (void)ws
#define FOR_VB(vb, n) for (int vb = 2 * bid + half; vb < (n); vb += 2 * G)
__global__ void __launch_bounds__(NTHREADS, 2) fwd_megakernel(Params P) {
    extern __shared__ __attribute__((aligned(16))) unsigned char lds[];
    { const int tid0 = threadIdx.x; for (int u = tid0; u < (LDS_BYTES - LDSCTL_OFF) / 4; u += NTHREADS) ((unsigned*)(lds + LDSCTL_OFF))[u] = 0u; }
    __syncthreads();
    XcdBarrier bar = xcd_barrier_post((unsigned*)(KWS() + WS_CTL) + CW_BAR, (volatile LAS unsigned*)(lds + MISC_OFF) + 8);
#define GRID_BAR() xcd_barrier(bar)

    { PHASE_IDS();
        float* tile = (float*)(lds + half * 17408);
        const int iters = (WTILES_TOTAL + 2 * G - 1) / (2 * G);
        for (int it = 0; it < iters; ++it) {
            int vb = 2 * (it * G + bid) + half; const bool have = vb < WTILES_TOTAL; bool valid = false; WDesc d{}; int nc = 0, kc = 0;
            if (have) { int m = 0; for (; m < NWMAT - 1; ++m) { const int nt = wmat_tiles(m); if (vb < nt) break; vb -= nt; }
                d = get_wdesc(ws, m); const int nchunks = d.N / 64; nc = vb % nchunks; kc = vb / nchunks; convert_tile_load(d, nc, kc, vtid, tile, valid); }
            __syncthreads();
            if (have) convert_tile_store(d, nc, kc, vtid, tile, valid);
            __syncthreads();
        }
        const int gw = bid * NWAVES + wave, NGW = G * NWAVES;
        { const float* x = FI(0); for (int r = gw; r < T; r += NGW) row_to_bf16(x, B16(WS_XB), F32(WS_SS), r, lane); }
        { const float* mem = FI(1); for (int r = gw; r < TM; r += NGW) row_to_bf16(mem, B16(WS_MEMB), F32(WS_SSMEM), r, lane); }
        { const int* pos = (const int*)karg(2); for (int i = bid * NTHREADS + tid; i < T * 32; i += G * NTHREADS) rope_entry(pos, (float2*)(ws + WS_ROPE), i); }
    }
    GRID_BAR();
    { PHASE_IDS();
      { const EpiMemKV e{F32(WS_SSMEM), FI(33), B16(WS_XK), B16(WS_XVT)};
        FOR_VB(vb, 4 * (TM / 64)) gemm_simple_vb(vb % 4, vb / 4, vtid, B16(WS_MEMB), B16(WS_WXKVT), DM, DM, DM, -1, e); }
      { const EpiUp e{F32(WS_SS), B16(WS_H)};
        FOR_VB(vb, (NUP / 256) * (T / 64)) gemm_simple_vb(vb % (NUP / 256), vb / (NUP / 256), vtid, B16(WS_XB), B16(WS_W1T), DM, DM, DM, -1, e); } }
    GRID_BAR();
    { PHASE_IDS(); const EpiRes e{FI(0), KOUT(), B16(WS_XB), F32(WS_SS), 0.5f, 0.f};
      FOR_VB(vb, 4 * (T / 64)) gemm_simple_vb(vb % 4, vb / 4, vtid, B16(WS_H), B16(WS_WD1T), DFFP, DFFP, DFFP, -1, e); }
    GRID_BAR();
    { PHASE_IDS(); const EpiIn e{F32(WS_SS), B16(WS_PROJ), F32(WS_SSQ), F32(WS_SSKR), F32(WS_SSKV)};
      FOR_VB(vb, 5 * (T / 64)) gemm_simple_vb(vb % 5, vb / 5, vtid, B16(WS_XB), B16(WS_WINT), DM, DM, DM, -1, e); }
    GRID_BAR();
    { PHASE_IDS(); const float2* tab = (const float2*)(ws + WS_ROPE);
      { const EpiQ e{F32(WS_SSQ), FI(13), tab, B16(WS_Q)};
        FOR_VB(vb, 4 * (T / 64)) gemm_simple_vb(vb % 4, vb / 4, vtid, B16(WS_PROJ) + PQ, B16(WS_WUQT), NIN, QRANK, QRANK, -1, e); }
      { const EpiKV e{F32(WS_SSKV), F32(WS_SSKR), FI(14), tab, B16(WS_PROJ), B16(WS_K), B16(WS_VT)};
        FOR_VB(vb, 4 * (T / 64)) gemm_simple_vb(vb % 4, vb / 4, vtid, B16(WS_PROJ) + PKV, B16(WS_WUKVT), NIN, KVRANK, KVRANK, -1, e); } }
    GRID_BAR();
    { PHASE_IDS();
      FOR_VB(vb, (SEQ / 128) * BATCH * NH) attn_simple_vb<DQK, DV, true>((SEQ / 128 - 1) - vb % (SEQ / 128), vb / (SEQ / 128), vtid, B16(WS_Q), B16(WS_K), B16(WS_VT), B16(WS_YCAT), F32(WS_SSY), NH * DQK, NH * DQK, DM, 8, SEQ, SEQ); }
    { PHASE_IDS();
      if (wave == 0) for (int bg = bid; bg < BATCH * SG; bg += G) ssm_seq_wave(bg, lane, B16(WS_PROJ), FI(15), FI(16), FI(17), FI(18), FI(19), FI(20), FI(21), FI(22), B16(WS_G)); }
    GRID_BAR();
    { PHASE_IDS(); const EpiGlu e{B16(WS_G), FI(24), B16(WS_YCAT), F32(WS_SSY)};
      FOR_VB(vb, 2 * (T / 64)) gemm_simple_vb(vb % 2, vb / 2, vtid, B16(WS_G), B16(WS_WGLUT), SSMW, SSMW, SSMW, -1, e); }
    GRID_BAR();
    { PHASE_IDS(); const EpiWo e{F32(WS_SSY), KOUT(), B16(WS_XB), F32(WS_SS)};
      FOR_VB(vb, 4 * (T / 64)) gemm_simple_vb(vb % 4, vb / 4, vtid, B16(WS_YCAT), B16(WS_WOT), DM, DM, DM, 512, e); }
    GRID_BAR();
    { PHASE_IDS(); const EpiXQ e{F32(WS_SS), FI(32), B16(WS_XQ)};
      FOR_VB(vb, 2 * (T / 64)) gemm_simple_vb(vb % 2, vb / 2, vtid, B16(WS_XB), B16(WS_WXQT), DM, DM, DM, -1, e); }
    GRID_BAR();
    { PHASE_IDS();
      FOR_VB(vb, (SEQ / 128) * BATCH * NH) attn_simple_vb<128, 128, false>(vb % (SEQ / 128), vb / (SEQ / 128), vtid, B16(WS_XQ), B16(WS_XK), B16(WS_XVT), B16(WS_XO), (float*)nullptr, 512, 512, 512, 0, SEQ, MEML); }
    GRID_BAR();
    { PHASE_IDS(); float* out = KOUT(); const EpiRes e{out, out, B16(WS_XB), F32(WS_SS), 1.0f, 0.f};
      FOR_VB(vb, 4 * (T / 64)) gemm_simple_vb(vb % 4, vb / 4, vtid, B16(WS_XO), B16(WS_WXOT), 512, 512, 512, -1, e); }
    GRID_BAR();
    { PHASE_IDS(); const EpiUp e{F32(WS_SS), B16(WS_H)};
      FOR_VB(vb, (NUP / 256) * (T / 64)) gemm_simple_vb(vb % (NUP / 256), vb / (NUP / 256), vtid, B16(WS_XB), B16(WS_W2T), DM, DM, DM, -1, e); }
    GRID_BAR();
    { PHASE_IDS(); float* out = KOUT(); const EpiRes e{out, out, nullptr, nullptr, 0.5f, 0.f};
      FOR_VB(vb, 4 * (T / 64)) gemm_simple_vb(vb % 4, vb / 4, vtid, B16(WS_H), B16(WS_WD2T), DFFP, DFFP, DFFP, -1, e); }
}

extern "C" void kernel_launch(void* const* d_in, const int* in_sizes, int n_in, void* d_out, int out_size, void* d_ws, size_t ws_size, hipStream_t stream) {
    static int grid = 0;
    if (grid == 0) {
        if (n_in != 39 || out_size != T * DM || ws_size < WS_END) { fprintf(stderr, "kernel_launch: unexpected shapes (n_in %d out %d ws %zu)\n", n_in, out_size, ws_size); grid = -1; return; }
        int dev = 0, cus = 0, per_cu = 0;
        if (hipGetDevice(&dev) != hipSuccess || hipDeviceGetAttribute(&cus, hipDeviceAttributeMultiprocessorCount, dev) != hipSuccess) { grid = -1; return; }
        if (hipFuncSetAttribute((const void*)fwd_megakernel, hipFuncAttributeMaxDynamicSharedMemorySize, LDS_BYTES) != hipSuccess) { fprintf(stderr, "kernel_launch: hipFuncSetAttribute failed\n"); grid = -1; return; }
        if (hipOccupancyMaxActiveBlocksPerMultiprocessor(&per_cu, (const void*)fwd_megakernel, NTHREADS, LDS_BYTES) != hipSuccess || per_cu < 1) { fprintf(stderr, "kernel_launch: occupancy query says %d\n", per_cu); }
        (void)hipGetLastError();
        grid = cus;
    }
    if (grid < 0) return;
    (void)hipMemsetAsync((char*)d_ws + WS_CTL, 0, CTL_ZERO_BYTES, stream);
    Params p{};
    for (int i = 0; i < 39; ++i) p.in[i] = d_in[i];
    p.out = (float*)d_out; p.ws = (unsigned char*)d_ws;
    hipLaunchKernelGGL(fwd_megakernel, dim3(grid), dim3(NTHREADS), LDS_BYTES, stream, p);
}
```

```cpp
#include <hip/hip_runtime.h>
#include <cstdint>
#include <cstdio>

typedef unsigned short bf16_t;
typedef short bf16x8 __attribute__((ext_vector_type(8)));
typedef short bf16x4 __attribute__((ext_vector_type(4)));
typedef float f32x4 __attribute__((ext_vector_type(4)));
typedef float f32x16 __attribute__((ext_vector_type(16)));
typedef unsigned u32x2 __attribute__((ext_vector_type(2)));
typedef unsigned u32x4 __attribute__((ext_vector_type(4)));

constexpr int BATCH = 4, SEQ = 4096, DM = 1024, T = BATCH * SEQ, MEML = 256, TM = BATCH * MEML;
constexpr int DFF = 2752, DFFP = 2816, NUP = 2 * DFFP;
constexpr int NIN = 1280;
constexpr int PQ = 0, PKR = 384, PKV = 512, PU = 768;
constexpr int QRANK = 384, KVRANK = 256, NH = 4, DQK = 192, DNOPE = 128, DROPE = 64, DV = 128;
constexpr int SSMW = 512, SG = 32, SP = 64;
constexpr float EPS = 1e-6f;
constexpr float LOG2E = 1.4426950408889634f;
constexpr float QSCALE = 0.07216878364870322f * LOG2E;
constexpr float XSCALE = 0.08838834764831845f * LOG2E;

constexpr size_t MiB = 1u << 20;
constexpr size_t WS_CTL = 0;
constexpr size_t WS_W1T = 1 * MiB;
constexpr size_t WS_WD1T = 12 * MiB;
constexpr size_t WS_W2T = 18 * MiB;
constexpr size_t WS_WD2T = 29 * MiB;
constexpr size_t WS_WINT = 35 * MiB;
constexpr size_t WS_WUQT = 38 * MiB;
constexpr size_t WS_WUKVT = 39 * MiB;
constexpr size_t WS_WGLUT = 40 * MiB;
constexpr size_t WS_WOT = 41 * MiB;
constexpr size_t WS_WXQT = 43 * MiB;
constexpr size_t WS_WXKVT = 44 * MiB;
constexpr size_t WS_WXOT = 46 * MiB;
constexpr size_t WS_ROPE = 63 * MiB;
constexpr size_t WS_SS = 67 * MiB;
constexpr size_t WS_SSQ = WS_SS + 256 * 1024;
constexpr size_t WS_SSKR = WS_SSQ + 128 * 1024;
constexpr size_t WS_SSKV = WS_SSKR + 64 * 1024;
constexpr size_t WS_SSY = 68 * MiB;
constexpr size_t WS_SSMEM = WS_SSY + 512 * 1024;
constexpr size_t WS_MEMB = 69 * MiB;
constexpr size_t WS_XK = 71 * MiB;
constexpr size_t WS_XVT = 72 * MiB;
constexpr size_t WS_XV = 73 * MiB;
constexpr size_t WS_XB = 74 * MiB;
constexpr size_t WS_G = WS_XB;
constexpr size_t WS_H = 106 * MiB;
constexpr size_t WS_CQ = WS_H;
constexpr size_t WS_CKV = WS_H + 12 * MiB;
constexpr size_t WS_U = WS_H + 20 * MiB;
constexpr size_t WS_KR = WS_H + 36 * MiB;
constexpr size_t WS_Q = WS_H + 40 * MiB;
constexpr size_t WS_K = WS_H + 64 * MiB;
constexpr size_t WS_XQ = WS_Q;
constexpr size_t WS_XO = WS_K;
constexpr size_t WS_VT = 194 * MiB;
constexpr size_t WS_V = 47 * MiB;
constexpr size_t WS_YCAT = 210 * MiB;
constexpr size_t WS_END = 256 * MiB;

__device__ __forceinline__ unsigned f2bf(float f) { unsigned u = __builtin_bit_cast(unsigned, f); return (u + 0x7fffu + ((u >> 16) & 1u)) >> 16; }
__device__ __forceinline__ unsigned pk2(float lo, float hi) { return f2bf(lo) | (f2bf(hi) << 16); }
__device__ __forceinline__ float bf2f(unsigned short b) { return __builtin_bit_cast(float, (unsigned)b << 16); }
__device__ __forceinline__ float wave_sum(float v) {
#pragma unroll
    for (int o = 1; o < 64; o <<= 1) v += __shfl_xor(v, o);
    return v;
}
__device__ __forceinline__ float quad_row_sum(float v) { v += __shfl_xor(v, 16); v += __shfl_xor(v, 32); return v; }
__device__ __forceinline__ void st_bf4(bf16_t* p, f32x4 v) { u32x2 w; w.x = pk2(v[0], v[1]); w.y = pk2(v[2], v[3]); *(u32x2*)p = w; }
__device__ __forceinline__ float dot4(f32x4 v) { return (v[0] * v[0] + v[1] * v[1]) + (v[2] * v[2] + v[3] * v[3]); }

#define LAS __attribute__((address_space(3)))
#define GAS __attribute__((address_space(1)))
struct Params { const void* in[39]; float* out; unsigned char* ws; };
__device__ __forceinline__ const void* karg(int i) {
    unsigned long long p;
    asm volatile("s_load_dwordx2 %0, %1, %2\n\ts_waitcnt lgkmcnt(0)" : "=s"(p) : "s"(__builtin_amdgcn_kernarg_segment_ptr()), "i"(8 * i) : "memory");
    return (const void*)(const GAS void*)p;
}

struct WDesc { const float* W; const float* W2; int ldw; int Ksrc; bf16_t* dst; int N; int K; const float* g; const float* g2; int gsplit; int mode; int ncols_src; int pad; };
__device__ __forceinline__ int src_chunk_col(const WDesc& d, int c, const float*& src) {
    src = d.W;
    switch (d.mode) {
        case 0: return (32 * c < d.ncols_src) ? 32 * c : -1;
        case 1: { const int pn = c >> 3, q = c & 7; const int col = 128 * pn + 32 * (q & 3); if (q >= 4) src = d.W2; return col < d.ncols_src ? col : -1; }
        case 2: { if (c < 12) return 32 * c; if (c < 14) return 640 + 32 * (c - 12); if (c < 16) return -1; if (c < 24) return 384 + 32 * (c - 16); return 704 + 32 * (c - 24); }
        case 3: { const int h = c >> 3, q = c & 7; if (q < 3) return 192 * h + 32 * q; if (q == 3) return 192 * h + 128; if (q == 4) return 192 * h + 96; if (q == 7) return 192 * h + 160; return -1; }
    }
    return -1;
}
constexpr int NWMAT = 12;
__device__ __forceinline__ WDesc get_wdesc(unsigned char* ws, int m) {
#define FI(i) ((const float*)karg(i))
#define WB(off) ((bf16_t*)(ws + (off)))
    switch (m) {
        case 0: return WDesc{FI(4), FI(5), DFF, DM, WB(WS_W1T), NUP, DM, FI(3), FI(3), DM, 1, DFF, 0};
        case 1: return WDesc{FI(36), FI(37), DFF, DM, WB(WS_W2T), NUP, DM, FI(35), FI(35), DM, 1, DFF, 0};
        case 2: return WDesc{FI(6), nullptr, DM, DFF, WB(WS_WD1T), DM, DFFP, nullptr, nullptr, 0, 0, DM, 0};
        case 3: return WDesc{FI(38), nullptr, DM, DFF, WB(WS_WD2T), DM, DFFP, nullptr, nullptr, 0, 0, DM, 0};
        case 4: return WDesc{FI(8), nullptr, 1216, DM, WB(WS_WINT), NIN, DM, FI(7), FI(7), DM, 2, 1216, 0};
        case 5: return WDesc{FI(10), nullptr, 768, QRANK, WB(WS_WUQT), 1024, QRANK, FI(9), FI(9), QRANK, 3, 768, 0};
        case 6: return WDesc{FI(12), nullptr, 1024, KVRANK, WB(WS_WUKVT), 1024, KVRANK, FI(11), FI(11), KVRANK, 0, 1024, 0};
        case 7: return WDesc{FI(23), nullptr, 512, 512, WB(WS_WGLUT), 512, 512, nullptr, nullptr, 0, 0, 512, 0};
        case 8: return WDesc{FI(27), nullptr, DM, DM, WB(WS_WOT), DM, DM, FI(25), FI(26), 512, 0, DM, 0};
        case 9: return WDesc{FI(30), nullptr, 512, DM, WB(WS_WXQT), 512, DM, FI(28), FI(28), DM, 0, 512, 0};
        case 10: return WDesc{FI(31), nullptr, DM, DM, WB(WS_WXKVT), DM, DM, FI(29), FI(29), DM, 0, DM, 0};
        default: return WDesc{FI(34), nullptr, DM, 512, WB(WS_WXOT), DM, 512, nullptr, nullptr, 0, 0, DM, 0};
    }
#undef FI
#undef WB
}
__device__ __forceinline__ int wmat_tiles(int m) {
    switch (m) { case 0: case 1: return (NUP / 64) * (DM / 64); case 2: case 3: return (DM / 64) * (DFFP / 64); case 4: return (NIN / 64) * (DM / 64); case 5: return 16 * (QRANK / 64);
        case 6: return 16 * (KVRANK / 64); case 7: return 64; case 8: return 256; case 9: return 8 * 16; case 10: return 256; default: return 16 * 8; }
}
constexpr int WTILES_TOTAL = 2 * (NUP / 64) * (DM / 64) + 2 * (DM / 64) * (DFFP / 64) + (NIN / 64) * (DM / 64) + 16 * (QRANK / 64) + 16 * (KVRANK / 64) + 64 + 256 + 128 + 256 + 128;
__device__ __forceinline__ void convert_tile_load(const WDesc& d, int nc, int kc, int vtid, float* tile, int& valid) {
    const float* src0; const float* src1; const int c0 = src_chunk_col(d, 2 * nc, src0), c1 = src_chunk_col(d, 2 * nc + 1, src1); const int k0 = 64 * kc;
    valid = (k0 < d.Ksrc) ? ((c0 >= 0 ? 1 : 0) | (c1 >= 0 ? 2 : 0)) : 0;
    if (valid) {
        for (int e = vtid; e < 64 * 64; e += 256) { const int kk = e >> 6, nn = e & 63; const int k = k0 + kk; const int sub = nn >> 5; const int cc = sub ? c1 : c0; const float* src = sub ? src1 : src0;
            float gg = 1.f; if (d.g) gg = (k < d.gsplit) ? d.g[k] : d.g2[k - d.gsplit];
            tile[kk * 65 + nn] = (cc >= 0) ? src[(size_t)k * d.ldw + cc + (nn & 31)] * gg : 0.f; }
    }
}
__device__ __forceinline__ void convert_tile_store(const WDesc& d, int nc, int kc, int vtid, const float* tile, int valid) {
    const int k0 = 64 * kc;
    for (int e = vtid; e < 64 * 8; e += 256) { const int nn = e >> 3, ch = e & 7;
        u32x4 o = {0u, 0u, 0u, 0u};
        if (valid) { o.x = pk2(tile[(8 * ch + 0) * 65 + nn], tile[(8 * ch + 1) * 65 + nn]); o.y = pk2(tile[(8 * ch + 2) * 65 + nn], tile[(8 * ch + 3) * 65 + nn]);
                     o.z = pk2(tile[(8 * ch + 4) * 65 + nn], tile[(8 * ch + 5) * 65 + nn]); o.w = pk2(tile[(8 * ch + 6) * 65 + nn], tile[(8 * ch + 7) * 65 + nn]); }
        *(u32x4*)(d.dst + (size_t)(64 * nc + nn) * d.K + k0 + 8 * ch) = o; }
}
__device__ __forceinline__ void row_to_bf16(const float* x, bf16_t* out, float* ss4, int row, int lane) {
    const f32x4* xr = (const f32x4*)(x + (size_t)row * DM) + lane; float s = 0.f;
    unsigned long long* o8 = (unsigned long long*)(out + (size_t)row * DM) + lane;
#pragma unroll
    for (int j = 0; j < 4; ++j) { const f32x4 v = xr[64 * j]; s += dot4(v); o8[64 * j] = (unsigned long long)pk2(v[0], v[1]) | ((unsigned long long)pk2(v[2], v[3]) << 32); }
    s = wave_sum(s);
    if (lane < 4) ss4[row * 4 + lane] = lane == 0 ? s : 0.f;
}
__device__ __forceinline__ void rope_entry(const int* pos, float2* tab, int idx) {
    const int t = idx >> 5, i = idx & 31;
    const double inv = exp2(-(double)i / 32.0 * 13.287712379549449);
    double a = (double)pos[t] * inv; a -= 6.283185307179586 * rint(a / 6.283185307179586);
    float s, c; sincosf((float)a, &s, &c); tab[idx] = make_float2(c, s);
}

__device__ __forceinline__ float rs_from4(const float* ss4, int row, float invc) { const f32x4 s = *(const f32x4*)(ss4 + 4 * row); return rsqrtf(((s[0] + s[1]) + (s[2] + s[3])) * invc + EPS); }

namespace pg8 {
#define PG8_LAS __attribute__((address_space(3)))
constexpr int BM = 256, BK = 64, HALF = 128, HTB = HALF * BK * 2, STAGE_BYTES = 8 * HTB, NXCD = 8, WGM = 8;
__host__ __device__ __forceinline__ int lds_byte(int r, int c) { const int st = (r >> 4) * 2 + (c >> 5), rr = r & 15, cc = c & 31, ob = rr * 64 + cc * 2; return st * 1024 + (ob ^ (((ob >> 9) & 1) << 5)); }
__host__ __device__ __forceinline__ void stage_rc(int b, int& R, int& C) { const int st = b / 1024, sb = b % 1024, swz = sb ^ (((sb >> 9) & 1) << 5); R = (st >> 1) * 16 + swz / 64; C = (st & 1) * 32 + (swz % 64) / 2; }
__host__ __device__ __forceinline__ int perm32(int rho) { const int n = rho >> 4, i = rho & 15; return 8 * (i >> 2) + 4 * n + (i & 3); }
struct Unit { int pm, pn; };
struct Gemm { const bf16_t* A; const bf16_t* Bt; int lda; int K; int M, N; };
struct StaticOrder {
    int nM, nN, nwg, G, c;
    __device__ void init(int M, int N, int G_, int c_) { nM = M / BM; nN = N / BM; nwg = nM * nN; G = G_; c = c_; }
    __device__ bool next(int i, Unit& u) const {
        const long L = (long)i * G + c; if (c < 0 || L >= nwg) return false;
        int wgid = (int)L; { const int q = nwg / NXCD, r = nwg % NXCD, xcd = wgid % NXCD, off = wgid / NXCD; wgid = (xcd < r ? xcd * (q + 1) : r * (q + 1) + (xcd - r) * q) + off; }
        const int nig = WGM * nN, gid = wgid / nig, fm = gid * WGM, gsz = (nM - fm) < WGM ? (nM - fm) : WGM;
        u.pm = fm + ((wgid % nig) % gsz); u.pn = (wgid % nig) / gsz; return true;
    }
};
template <class Epi>
__device__ __forceinline__ void gemm_phase(int tid, PG8_LAS unsigned char* lds, PG8_LAS float* scr, const Gemm g, const StaticOrder& S, const Epi& E) {
    const int wid = __builtin_amdgcn_readfirstlane(tid >> 6), lane = tid & 63, wr = wid >> 2, wc = wid & 3, fr = lane & 15, fq = lane >> 4;
    const int K = g.K, nt = K / BK;
    unsigned voffA[2], voffB[2];
#pragma unroll
    for (int i = 0; i < 2; ++i) { int R, C; stage_rc(tid * 16 + i * 8192, R, C); const int Rb = Epi::PERM ? ((R & ~31) + perm32(R & 31)) : R;
        voffA[i] = (unsigned)(R * g.lda + C) * 2u; voffB[i] = (unsigned)(Rb * K + C) * 2u; }
    const size_t kstep = (size_t)(BK * 2);
    const size_t hstepA = (size_t)HALF * g.lda * 2, hstepB = (size_t)HALF * K * 2;
    const size_t tstepA = 2 * hstepA, tstepB = 2 * hstepB;
    const unsigned ldsw = (unsigned)wid * 1024u;
    const int aoff = lds_byte(wr * 64 + fr, fq * 8), boff = lds_byte(wc * 32 + fr, fq * 8);
#define PG8_SA(b, h) (((b) * 2 + (h)) * HTB)
#define PG8_SB(b, h) ((4 + (b) * 2 + (h)) * HTB)
#define PG8_STAGE(bufoff, gbase, voff) do { _Pragma("unroll") for (int _i = 0; _i < 2; ++_i) \
        __builtin_amdgcn_global_load_lds((const unsigned*)((const char*)(gbase) + (voff)[_i]), (PG8_LAS unsigned*)(lds + (bufoff) + ldsw + _i * 8192), 16, 0, 0); } while (0)
#define PG8_LDA(dst, b, h) do { _Pragma("unroll") for (int m = 0; m < 4; ++m) _Pragma("unroll") for (int k = 0; k < 2; ++k) dst[m][k] = *(const PG8_LAS bf16x8*)(lds + PG8_SA(b, h) + aoff + m * 2048 + k * 1024); } while (0)
#define PG8_LDB(dst, b, h) do { _Pragma("unroll") for (int n = 0; n < 2; ++n) _Pragma("unroll") for (int k = 0; k < 2; ++k) dst[n][k] = *(const PG8_LAS bf16x8*)(lds + PG8_SB(b, h) + boff + n * 2048 + k * 1024); } while (0)
#define PG8_MMA(ai, bj, At, Bt) do { __builtin_amdgcn_s_setprio(1); _Pragma("unroll") for (int m = 0; m < 4; ++m) _Pragma("unroll") for (int n = 0; n < 2; ++n) _Pragma("unroll") for (int k = 0; k < 2; ++k) \
        acc[ai][bj][m][n] = __builtin_amdgcn_mfma_f32_16x16x32_bf16(Bt[n][k], At[m][k], acc[ai][bj][m][n], 0, 0, 0); __builtin_amdgcn_s_setprio(0); } while (0)
#define PG8_WAIT_V(n) asm volatile("s_waitcnt vmcnt(" #n ")" ::: "memory")
#define PG8_WAIT_L(n) asm volatile("s_waitcnt lgkmcnt(" #n ")" ::: "memory")
#define PG8_BAR __builtin_amdgcn_s_barrier()
#define PG8_SCHED __builtin_amdgcn_sched_barrier(0)
    Unit cur, nxt; int ui = 0;
    if (!S.next(0, cur)) return;
    f32x4 acc[2][2][4][2];
#pragma unroll
    for (int a = 0; a < 2; ++a)
#pragma unroll
        for (int b = 0; b < 2; ++b)
#pragma unroll
            for (int m = 0; m < 4; ++m)
#pragma unroll
                for (int n = 0; n < 2; ++n) acc[a][b][m][n] = (f32x4){0.f, 0.f, 0.f, 0.f};
    bf16x8 At[4][2], B0[2][2], B1[2][2];
    const char* cA = (const char*)g.A + (size_t)cur.pm * tstepA; const char* cB = (const char*)g.Bt + (size_t)cur.pn * tstepB;
    PG8_STAGE(PG8_SB(0, 0), cB, voffB); PG8_STAGE(PG8_SB(0, 1), cB + hstepB, voffB); PG8_STAGE(PG8_SA(0, 0), cA, voffA); PG8_STAGE(PG8_SA(0, 1), cA + hstepA, voffA);
    if (wr == 1) PG8_BAR;
    PG8_WAIT_V(2); PG8_BAR;
    PG8_STAGE(PG8_SB(1, 0), cB + kstep, voffB); PG8_STAGE(PG8_SA(1, 0), cA + kstep, voffA); PG8_STAGE(PG8_SB(1, 1), cB + hstepB + kstep, voffB);
    PG8_WAIT_V(6); PG8_BAR;
    for (;;) {
        const bool has_next = S.next(ui + 1, nxt);
        const char* nA = has_next ? (const char*)g.A + (size_t)nxt.pm * tstepA : cA; const char* nB = has_next ? (const char*)g.Bt + (size_t)nxt.pn * tstepB : cB;
#pragma unroll 1
        for (int t = 0; t < nt; t += 2) {
            const bool last = (t == nt - 2);
            const char* a1 = cA + (size_t)(t + 1) * kstep;
            const char* a2 = last ? nA : cA + (size_t)(t + 2) * kstep; const char* b2 = last ? nB : cB + (size_t)(t + 2) * kstep;
            const char* a3 = a2 + kstep; const char* b3 = b2 + kstep;
            if constexpr (Epi::HAS_MID) { if (t == E.tmid) { int t2 = tid; asm volatile("" : "+v"(t2)); E.mid(acc, cur, wr, t2 & 15); } }
            PG8_LDB(B0, 0, 0); PG8_LDB(B1, 0, 1); PG8_SCHED; PG8_LDA(At, 0, 0); PG8_STAGE(PG8_SA(1, 1), a1 + hstepA, voffA);
            PG8_WAIT_V(8); PG8_WAIT_L(0); PG8_BAR; PG8_MMA(0, 0, At, B0); PG8_MMA(0, 1, At, B1); PG8_BAR; PG8_SCHED;
            PG8_LDA(At, 0, 1); PG8_STAGE(PG8_SB(0, 0), b2, voffB); PG8_STAGE(PG8_SB(0, 1), b2 + hstepB, voffB); PG8_STAGE(PG8_SA(0, 0), a2, voffA);
            PG8_WAIT_V(8); PG8_WAIT_L(0); PG8_BAR; PG8_MMA(1, 0, At, B0); PG8_MMA(1, 1, At, B1); PG8_BAR; PG8_SCHED;
            PG8_LDB(B0, 1, 0); PG8_LDB(B1, 1, 1); PG8_SCHED; PG8_LDA(At, 1, 0); PG8_STAGE(PG8_SA(0, 1), a2 + hstepA, voffA);
            PG8_WAIT_V(8); PG8_WAIT_L(0); PG8_BAR; PG8_MMA(0, 0, At, B0); PG8_MMA(0, 1, At, B1); PG8_BAR; PG8_SCHED;
            PG8_LDA(At, 1, 1); PG8_STAGE(PG8_SB(1, 0), b3, voffB); PG8_STAGE(PG8_SB(1, 1), b3 + hstepB, voffB); PG8_STAGE(PG8_SA(1, 0), a3, voffA);
            PG8_WAIT_V(8); PG8_WAIT_L(0); PG8_BAR; PG8_MMA(1, 0, At, B0); PG8_MMA(1, 1, At, B1); PG8_BAR; PG8_SCHED;
        }
        if (wr == 0) PG8_BAR;
        { int t2 = tid; asm volatile("" : "+v"(t2)); const int efr = t2 & 15, efq = (t2 >> 4) & 3;
          E(acc, cur, wr, wc, efr, efq, scr); }
        if (!has_next) break;
#pragma unroll
        for (int a = 0; a < 2; ++a)
#pragma unroll
            for (int b = 0; b < 2; ++b)
#pragma unroll
                for (int m = 0; m < 4; ++m)
#pragma unroll
                    for (int n = 0; n < 2; ++n) acc[a][b][m][n] = (f32x4){0.f, 0.f, 0.f, 0.f};
        cur = nxt; cA = nA; cB = nB; ++ui;
        if (wr == 1) PG8_BAR;
    }
    PG8_WAIT_V(0);
    PG8_BAR;
#undef PG8_SA
#undef PG8_SB
#undef PG8_STAGE
#undef PG8_LDA
#undef PG8_LDB
#undef PG8_MMA
#undef PG8_WAIT_V
#undef PG8_WAIT_L
#undef PG8_BAR
#undef PG8_SCHED
}
}

typedef f32x4 Acc[2][2][4][2];
#define PROW(ai, m) (u.pm * 256 + (ai) * 128 + wr * 64 + (m) * 16 + fr)
#define EPI_FOR_AM _Pragma("unroll") for (int ai = 0; ai < 2; ++ai) _Pragma("unroll") for (int m = 0; m < 4; ++m)
#define EPI_FENCE asm volatile("" ::: "memory")
__device__ __forceinline__ u32x4 pack8(f32x4 a, f32x4 b) { u32x4 w; w.x = pk2(a[0], a[1]); w.y = pk2(a[2], a[3]); w.z = pk2(b[0], b[1]); w.w = pk2(b[2], b[3]); return w; }
template <int NV> __device__ __forceinline__ void xch_rows(float (&v)[2][4][NV], LAS float* scr, int wr, int wc, int fr, int fq) {
    EPI_FOR_AM {
#pragma unroll
        for (int k = 0; k < NV; ++k) { const float t = quad_row_sum(v[ai][m][k]); if (fq == 0) scr[((ai * 128 + wr * 64 + m * 16 + fr) * 4 + wc) * NV + k] = t; } }
    asm volatile("s_waitcnt lgkmcnt(0)" ::: "memory"); __builtin_amdgcn_s_barrier(); asm volatile("" ::: "memory");
    EPI_FOR_AM { const LAS float* p = scr + (ai * 128 + wr * 64 + m * 16 + fr) * 4 * NV;
#pragma unroll
        for (int k = 0; k < NV; ++k) v[ai][m][k] = (p[k] + p[NV + k]) + (p[2 * NV + k] + p[3 * NV + k]); }
}
__device__ __forceinline__ float silu_mul(float g, float u) { return g / (1.f + __expf(-g)) * u; }

#define EB16(off) ((bf16_t*)(ws + (off)))
#define EF32(off) ((float*)(ws + (off)))
#define EFI(i) ((const float*)karg(i))
template <int FFN> struct PEpiUp {
    static constexpr bool PERM = true, HAS_MID = false; int tmid; unsigned char* ws;
    __device__ __forceinline__ void operator()(Acc& acc, const pg8::Unit& u, int wr, int wc, int fr, int fq, LAS float*) const {
        const float* ss = EF32(WS_SS); bf16_t* H = EB16(WS_H);
        EPI_FOR_AM { const int r = PROW(ai, m); const float rs = rs_from4(ss, r, 1.f / DM); f32x4 h0, h1;
#pragma unroll
            for (int i = 0; i < 4; ++i) { h0[i] = silu_mul(acc[ai][0][m][0][i] * rs, acc[ai][1][m][0][i] * rs); h1[i] = silu_mul(acc[ai][0][m][1][i] * rs, acc[ai][1][m][1][i] * rs); }
            *(u32x4*)(H + (size_t)r * DFFP + 128 * u.pn + 32 * wc + 8 * fq) = pack8(h0, h1); }
    }
};
template <int MODE> struct PEpiRes {
    static constexpr bool PERM = false, HAS_MID = false; int tmid; unsigned char* ws;
    __device__ __forceinline__ void operator()(Acc& acc, const pg8::Unit& u, int wr, int wc, int fr, int fq, LAS float* scr) const {
        float* out = (float*)karg(39); const float* resid = (MODE == 0) ? EFI(0) : out; bf16_t* xb = EB16(WS_XB); float* ssout = EF32(WS_SS); const float alpha = (MODE == 1) ? 1.f : 0.5f;
        float part[2][4][1];
        EPI_FOR_AM { const int r = PROW(ai, m); float s = 0.f;
#pragma unroll
            for (int bj = 0; bj < 2; ++bj)
#pragma unroll
                for (int n = 0; n < 2; ++n) { const size_t off = (size_t)r * DM + 256 * u.pn + 128 * bj + 32 * wc + 16 * n + 4 * fq; const f32x4 v = *(const f32x4*)(resid + off) + acc[ai][bj][m][n] * alpha;
                    *(f32x4*)(out + off) = v; if (MODE != 2) { st_bf4(xb + off, v); s += dot4(v); } }
            part[ai][m][0] = s; EPI_FENCE; }
        if (MODE != 2) { xch_rows<1>(part, scr, wr, wc, fr, fq); if (wc == 0 && fq == 0) EPI_FOR_AM ssout[PROW(ai, m) * 4 + u.pn] = part[ai][m][0]; }
    }
};
struct PEpiWo {
    static constexpr bool PERM = false, HAS_MID = true; int tmid; unsigned char* ws;
    __device__ __forceinline__ void rsv(int row, float& rm, float& rsm) const { const float* ssy = EF32(WS_SSY); const f32x4 a = *(const f32x4*)(ssy + 8 * row), b = *(const f32x4*)(ssy + 8 * row + 4);
        rm = rsqrtf(((a[0] + a[1]) + (a[2] + a[3])) * (1.f / 512) + EPS); rsm = rsqrtf((b[0] + b[1]) * (1.f / 512) + EPS); }
    __device__ __forceinline__ void mid(Acc& acc, const pg8::Unit& u, int wr, int fr) const {
        EPI_FOR_AM { float rm, rsm; rsv(PROW(ai, m), rm, rsm); const float q = rm / rsm;
#pragma unroll
            for (int bj = 0; bj < 2; ++bj)
#pragma unroll
                for (int n = 0; n < 2; ++n) acc[ai][bj][m][n] = acc[ai][bj][m][n] * q; }
    }
    __device__ __forceinline__ void operator()(Acc& acc, const pg8::Unit& u, int wr, int wc, int fr, int fq, LAS float* scr) const {
        float* out = (float*)karg(39); bf16_t* xb = EB16(WS_XB); float* ssout = EF32(WS_SS);
        float part[2][4][1];
        EPI_FOR_AM { const int r = PROW(ai, m); float rm, rsm; rsv(r, rm, rsm); float s = 0.f;
#pragma unroll
            for (int bj = 0; bj < 2; ++bj)
#pragma unroll
                for (int n = 0; n < 2; ++n) { const size_t off = (size_t)r * DM + 256 * u.pn + 128 * bj + 32 * wc + 16 * n + 4 * fq; const f32x4 v = *(const f32x4*)(out + off) + acc[ai][bj][m][n] * rsm;
                    *(f32x4*)(out + off) = v; st_bf4(xb + off, v); s += dot4(v); }
            part[ai][m][0] = s; EPI_FENCE; }
        xch_rows<1>(part, scr, wr, wc, fr, fq); if (wc == 0 && fq == 0) EPI_FOR_AM ssout[PROW(ai, m) * 4 + u.pn] = part[ai][m][0];
    }
};
struct PEpiIn {
    static constexpr bool PERM = true, HAS_MID = false; int tmid; unsigned char* ws;
    __device__ __forceinline__ void operator()(Acc& acc, const pg8::Unit& u, int wr, int wc, int fr, int fq, LAS float* scr) const {
        const float* ss = EF32(WS_SS); float* ssq = EF32(WS_SSQ); float* sskr = EF32(WS_SSKR); float* sskv = EF32(WS_SSKV);
        float part[2][4][2];
        EPI_FOR_AM { const int r = PROW(ai, m); const float rs = rs_from4(ss, r, 1.f / DM);
#pragma unroll
            for (int bj = 0; bj < 2; ++bj) { const f32x4 v0 = acc[ai][bj][m][0] * rs, v1 = acc[ai][bj][m][1] * rs; const int c = 128 * bj + 32 * wc + 8 * fq; bf16_t* dst = nullptr;
                if (u.pn == 0) dst = EB16(WS_CQ) + (size_t)r * QRANK + c;
                else if (u.pn == 1) { if (bj == 0) dst = EB16(WS_CQ) + (size_t)r * QRANK + 256 + c; else if (wc < 2) dst = EB16(WS_KR) + (size_t)r * 64 + (c - 128); }
                else if (u.pn == 2) dst = EB16(WS_CKV) + (size_t)r * KVRANK + c;
                else dst = EB16(WS_U) + (size_t)r * SSMW + 256 * (u.pn - 3) + c;
                if (dst) *(u32x4*)dst = pack8(v0, v1);
                part[ai][m][bj] = dot4(v0) + dot4(v1); } }
        if (u.pn < 3) {
            if (u.pn == 1 && wc >= 2) EPI_FOR_AM part[ai][m][1] = 0.f;
            xch_rows<2>(part, scr, wr, wc, fr, fq);
            if (wc == 0 && fq == 0) EPI_FOR_AM { const int r = PROW(ai, m);
                if (u.pn == 0) ssq[2 * r] = part[ai][m][0] + part[ai][m][1];
                else if (u.pn == 1) { ssq[2 * r + 1] = part[ai][m][0]; sskr[r] = part[ai][m][1]; }
                else sskv[r] = part[ai][m][0] + part[ai][m][1]; } }
    }
};
struct PEpiQ {
    static constexpr bool PERM = true, HAS_MID = false; int tmid; unsigned char* ws;
    __device__ __forceinline__ void operator()(Acc& acc, const pg8::Unit& u, int wr, int wc, int fr, int fq, LAS float* scr) const {
        const float* ssq = EF32(WS_SSQ); bf16_t* Q = EB16(WS_Q); const float2* tab = (const float2*)(ws + WS_ROPE);
        float part[2][4][1];
        EPI_FOR_AM { const int r = PROW(ai, m); const float rs = rsqrtf((ssq[2 * r] + ssq[2 * r + 1]) * (1.f / QRANK) + EPS); float s = 0.f;
#pragma unroll
            for (int bj = 0; bj < 2; ++bj)
#pragma unroll
                for (int n = 0; n < 2; ++n) { acc[ai][bj][m][n] = acc[ai][bj][m][n] * rs; s += dot4(acc[ai][bj][m][n]); }
            part[ai][m][0] = s; }
        xch_rows<1>(part, scr, wr, wc, fr, fq);
        const float* gq = EFI(13);
        EPI_FOR_AM { const int r = PROW(ai, m); const float rh = rsqrtf(part[ai][m][0] * (1.f / DQK) + EPS) * QSCALE;
            bf16_t* qp = Q + (size_t)r * (NH * DQK) + DQK * u.pn;
            if (wc < 3) { const f32x4 g0 = *(const f32x4*)(gq + 32 * wc + 8 * fq), g1 = *(const f32x4*)(gq + 32 * wc + 8 * fq + 4);
                *(u32x4*)(qp + 32 * wc + 8 * fq) = pack8(acc[ai][0][m][0] * g0 * rh, acc[ai][0][m][1] * g1 * rh);
                if (wc == 0) { const f32x4 h0 = *(const f32x4*)(gq + 96 + 8 * fq), h1 = *(const f32x4*)(gq + 96 + 8 * fq + 4);
                    *(u32x4*)(qp + 96 + 8 * fq) = pack8(acc[ai][1][m][0] * h0 * rh, acc[ai][1][m][1] * h1 * rh); }
            } else { f32x4 o1[2], o2[2];
#pragma unroll
                for (int n = 0; n < 2; ++n) { const f32x4 g1 = *(const f32x4*)(gq + 128 + 8 * fq + 4 * n), g2 = *(const f32x4*)(gq + 160 + 8 * fq + 4 * n);
#pragma unroll
                    for (int i = 0; i < 4; ++i) { const float2 cs = tab[(size_t)r * 32 + 8 * fq + 4 * n + i]; const float x1 = acc[ai][0][m][n][i] * g1[i] * rh, x2 = acc[ai][1][m][n][i] * g2[i] * rh;
                        o1[n][i] = x1 * cs.x - x2 * cs.y; o2[n][i] = x2 * cs.x + x1 * cs.y; } }
                *(u32x4*)(qp + 128 + 8 * fq) = pack8(o1[0], o1[1]); *(u32x4*)(qp + 160 + 8 * fq) = pack8(o2[0], o2[1]); } EPI_FENCE; }
    }
};
template <bool WITH_VT> struct PEpiKV {
    static constexpr bool PERM = true, HAS_MID = false; int tmid; unsigned char* ws;
    __device__ __forceinline__ void operator()(Acc& acc, const pg8::Unit& u, int wr, int wc, int fr, int fq, LAS float* scr) const {
        const float* sskv = EF32(WS_SSKV); const float* sskr = EF32(WS_SSKR); const float2* tab = (const float2*)(ws + WS_ROPE); const bf16_t* krb = EB16(WS_KR); bf16_t* K = EB16(WS_K); bf16_t* V = EB16(WS_V); bf16_t* Vt = EB16(WS_VT);
        float part[2][4][1];
        EPI_FOR_AM { const int r = PROW(ai, m); const float rs = rsqrtf(sskv[r] * (1.f / KVRANK) + EPS);
#pragma unroll
            for (int bj = 0; bj < 2; ++bj)
#pragma unroll
                for (int n = 0; n < 2; ++n) acc[ai][bj][m][n] = acc[ai][bj][m][n] * rs;
            part[ai][m][0] = dot4(acc[ai][0][m][0]) + dot4(acc[ai][0][m][1]); }
        xch_rows<1>(part, scr, wr, wc, fr, fq);
        const float* gk = EFI(14);
        EPI_FOR_AM { const int r = PROW(ai, m); const float rk = rsqrtf((part[ai][m][0] + sskr[r]) * (1.f / DQK) + EPS);
            bf16_t* kp = K + (size_t)r * (NH * DQK) + DQK * u.pn;
            const f32x4 g0 = *(const f32x4*)(gk + 32 * wc + 8 * fq), g1 = *(const f32x4*)(gk + 32 * wc + 8 * fq + 4);
            *(u32x4*)(kp + 32 * wc + 8 * fq) = pack8(acc[ai][0][m][0] * g0 * rk, acc[ai][0][m][1] * g1 * rk);
            *(u32x4*)(V + (size_t)r * 512 + 128 * u.pn + 32 * wc + 8 * fq) = pack8(acc[ai][1][m][0], acc[ai][1][m][1]);
            if (WITH_VT) { const int b = r / SEQ, t = r % SEQ;
#pragma unroll
                for (int n = 0; n < 2; ++n)
#pragma unroll
                    for (int i = 0; i < 4; ++i) Vt[((size_t)(b * NH + u.pn) * DV + 32 * wc + 8 * fq + 4 * n + i) * SEQ + t] = (bf16_t)f2bf(acc[ai][1][m][n][i]); }
            const int idx = 8 * wc + 2 * fq; const bf16_t* kr = krb + (size_t)r * 64;
            const unsigned a1 = *(const unsigned*)(kr + idx), a2 = *(const unsigned*)(kr + 32 + idx); const f32x4 cs = *(const f32x4*)((const float*)tab + ((size_t)r * 32 + idx) * 2);
            const float x1a = bf2f((unsigned short)(a1 & 0xffff)) * gk[128 + idx] * rk, x1b = bf2f((unsigned short)(a1 >> 16)) * gk[129 + idx] * rk;
            const float x2a = bf2f((unsigned short)(a2 & 0xffff)) * gk[160 + idx] * rk, x2b = bf2f((unsigned short)(a2 >> 16)) * gk[161 + idx] * rk;
            *(unsigned*)(kp + 128 + idx) = pk2(x1a * cs[0] - x2a * cs[1], x1b * cs[2] - x2b * cs[3]);
            *(unsigned*)(kp + 160 + idx) = pk2(x2a * cs[0] + x1a * cs[1], x2b * cs[2] + x1b * cs[3]); EPI_FENCE; }
    }
};
struct PEpiGlu {
    static constexpr bool PERM = true, HAS_MID = false; int tmid; unsigned char* ws;
    __device__ __forceinline__ void operator()(Acc& acc, const pg8::Unit& u, int wr, int wc, int fr, int fq, LAS float* scr) const {
        const bf16_t* G = EB16(WS_G); const float* bias = EFI(24); bf16_t* ycat = EB16(WS_YCAT); float* ssy = EF32(WS_SSY);
        float part[2][4][1];
        EPI_FOR_AM { const int r = PROW(ai, m); float s = 0.f;
#pragma unroll
            for (int bj = 0; bj < 2; ++bj) { const int col = 256 * u.pn + 128 * bj + 32 * wc + 8 * fq; const bf16x8 gb = *(const bf16x8*)(G + (size_t)r * SSMW + col); f32x4 o[2];
#pragma unroll
                for (int n = 0; n < 2; ++n) { const f32x4 bv = *(const f32x4*)(bias + col + 4 * n);
#pragma unroll
                    for (int i = 0; i < 4; ++i) { const float g = bf2f((unsigned short)gb[4 * n + i]); o[n][i] = g / (1.f + __expf(-(acc[ai][bj][m][n][i] + bv[i]))); } s += dot4(o[n]); }
                *(u32x4*)(ycat + (size_t)r * DM + 512 + col) = pack8(o[0], o[1]); }
            part[ai][m][0] = s; }
        xch_rows<1>(part, scr, wr, wc, fr, fq); if (wc == 0 && fq == 0) EPI_FOR_AM ssy[PROW(ai, m) * 8 + 4 + u.pn] = part[ai][m][0];
    }
};
struct PEpiXQ {
    static constexpr bool PERM = true, HAS_MID = false; int tmid; unsigned char* ws;
    __device__ __forceinline__ void operator()(Acc& acc, const pg8::Unit& u, int wr, int wc, int fr, int fq, LAS float* scr) const {
        const float* ss = EF32(WS_SS); bf16_t* XQ = EB16(WS_XQ);
        float part[2][4][2];
        EPI_FOR_AM { const int r = PROW(ai, m); const float rs = rs_from4(ss, r, 1.f / DM);
#pragma unroll
            for (int bj = 0; bj < 2; ++bj) { acc[ai][bj][m][0] = acc[ai][bj][m][0] * rs; acc[ai][bj][m][1] = acc[ai][bj][m][1] * rs; part[ai][m][bj] = dot4(acc[ai][bj][m][0]) + dot4(acc[ai][bj][m][1]); } }
        xch_rows<2>(part, scr, wr, wc, fr, fq);
        const float* gq = EFI(32);
        const f32x4 g0 = *(const f32x4*)(gq + 32 * wc + 8 * fq), g1 = *(const f32x4*)(gq + 32 * wc + 8 * fq + 4);
        EPI_FOR_AM { const int r = PROW(ai, m);
#pragma unroll
            for (int bj = 0; bj < 2; ++bj) { const float rh = rsqrtf(part[ai][m][bj] * (1.f / 128) + EPS) * XSCALE;
                *(u32x4*)(XQ + (size_t)r * 512 + 256 * u.pn + 128 * bj + 32 * wc + 8 * fq) = pack8(acc[ai][bj][m][0] * g0 * rh, acc[ai][bj][m][1] * g1 * rh); } }
    }
};
template <bool WITH_VT> struct PEpiMemKV {
    static constexpr bool PERM = true, HAS_MID = false; int tmid; unsigned char* ws;
    __device__ __forceinline__ void operator()(Acc& acc, const pg8::Unit& u, int wr, int wc, int fr, int fq, LAS float* scr) const {
        const float* ss = EF32(WS_SSMEM); bf16_t* XK = EB16(WS_XK); bf16_t* XV = EB16(WS_XV); bf16_t* XVt = EB16(WS_XVT);
        float part[2][4][2];
        EPI_FOR_AM { const int r = PROW(ai, m); const float rs = rs_from4(ss, r, 1.f / DM);
#pragma unroll
            for (int bj = 0; bj < 2; ++bj) { acc[ai][bj][m][0] = acc[ai][bj][m][0] * rs; acc[ai][bj][m][1] = acc[ai][bj][m][1] * rs; part[ai][m][bj] = dot4(acc[ai][bj][m][0]) + dot4(acc[ai][bj][m][1]); } }
        if (u.pn < 2) {
            xch_rows<2>(part, scr, wr, wc, fr, fq);
            const float* gk = EFI(33);
            const f32x4 g0 = *(const f32x4*)(gk + 32 * wc + 8 * fq), g1 = *(const f32x4*)(gk + 32 * wc + 8 * fq + 4);
            EPI_FOR_AM { const int r = PROW(ai, m);
#pragma unroll
                for (int bj = 0; bj < 2; ++bj) { const float rh = rsqrtf(part[ai][m][bj] * (1.f / 128) + EPS);
                    *(u32x4*)(XK + (size_t)r * 512 + 256 * u.pn + 128 * bj + 32 * wc + 8 * fq) = pack8(acc[ai][bj][m][0] * g0 * rh, acc[ai][bj][m][1] * g1 * rh); } }
        } else {
            EPI_FOR_AM { const int r = PROW(ai, m), b = r / MEML, mm = r % MEML;
#pragma unroll
                for (int bj = 0; bj < 2; ++bj) { const int c0 = 256 * (u.pn - 2) + 128 * bj + 32 * wc + 8 * fq;
                    *(u32x4*)(XV + (size_t)r * 512 + c0) = pack8(acc[ai][bj][m][0], acc[ai][bj][m][1]);
                    if (WITH_VT) {
#pragma unroll
                        for (int n = 0; n < 2; ++n)
#pragma unroll
                            for (int i = 0; i < 4; ++i) { const int c = c0 + 4 * n + i, h = c >> 7, d = c & 127; XVt[((size_t)(b * NH + h) * 128 + d) * MEML + mm] = (bf16_t)f2bf(acc[ai][bj][m][n][i]); } } } }
        }
    }
};
template <int DK, int DVv, bool CAUSAL> __device__ __forceinline__ void attn_simple_vb(int qblk, int bh, int vtid, const bf16_t* Q, const bf16_t* K, const bf16_t* Vt, bf16_t* O, float* ssout, int ldq, int ldk, int ldo, int ssld, int Sq, int Skv) {
    const int lane = vtid & 63, w = vtid >> 6, c = lane & 31, hi = lane >> 5;
    const int b = bh / NH, h = bh % NH, q0 = 128 * qblk + 32 * w;
    const bf16_t* qp = Q + (size_t)(b * Sq + q0 + c) * ldq + h * DK + 8 * hi;
    f32x16 o[DVv / 32];
#pragma unroll
    for (int d = 0; d < DVv / 32; ++d)
#pragma unroll
        for (int r = 0; r < 16; ++r) o[d][r] = 0.f;
    float m = -1e30f, l = 0.f;
    const int ntile = CAUSAL ? (q0 / 32 + 1) : (Skv / 32);
    const bf16_t* kbase = K + (size_t)(b * Skv) * ldk + h * DK + 8 * hi;
    const bf16_t* vbase = Vt + (size_t)bh * DVv * Skv;
    for (int tt = 0; tt < ntile; ++tt) {
        const int key0 = 32 * tt;
        f32x16 p;
#pragma unroll
        for (int r = 0; r < 16; ++r) p[r] = 0.f;
        const bf16_t* kp = kbase + (size_t)(key0 + c) * ldk;
#pragma unroll
        for (int s = 0; s < DK / 16; ++s) { const bf16x8 kf = *(const bf16x8*)(kp + 16 * s); const bf16x8 qf = *(const bf16x8*)(qp + 16 * s); p = __builtin_amdgcn_mfma_f32_32x32x16_bf16(kf, qf, p, 0, 0, 0); }
        if (CAUSAL && tt == ntile - 1) {
#pragma unroll
            for (int r = 0; r < 16; ++r) { const int key = key0 + (r & 3) + 8 * (r >> 2) + 4 * hi; if (key > q0 + c) p[r] = -INFINITY; }
        }
        float tm = p[0];
#pragma unroll
        for (int r = 1; r < 16; ++r) tm = fmaxf(tm, p[r]);
        tm = fmaxf(tm, __shfl_xor(tm, 32));
        const float mn = fmaxf(m, tm), alpha = exp2f(m - mn); m = mn;
        float ps = 0.f;
#pragma unroll
        for (int r = 0; r < 16; ++r) { p[r] = exp2f(p[r] - mn); ps += p[r]; }
        l = l * alpha + ps;
        bf16x8 pf[2];
#pragma unroll
        for (int s = 0; s < 2; ++s)
#pragma unroll
            for (int j = 0; j < 8; ++j) pf[s][j] = (short)f2bf(p[8 * s + j]);
#pragma unroll
        for (int d = 0; d < DVv / 32; ++d) {
#pragma unroll
            for (int r = 0; r < 16; ++r) o[d][r] *= alpha;
            const bf16_t* vp = vbase + (size_t)(32 * d + c) * Skv + key0 + 4 * hi;
#pragma unroll
            for (int s = 0; s < 2; ++s) { const bf16x4 v0 = *(const bf16x4*)(vp + 16 * s), v1 = *(const bf16x4*)(vp + 16 * s + 8);
                const bf16x8 vf = {v0[0], v0[1], v0[2], v0[3], v1[0], v1[1], v1[2], v1[3]};
                o[d] = __builtin_amdgcn_mfma_f32_32x32x16_bf16(vf, pf[s], o[d], 0, 0, 0); }
        }
    }
    l += __shfl_xor(l, 32); const float il = 1.f / l; float ss = 0.f;
    bf16_t* op = O + (size_t)(b * Sq + q0 + c) * ldo + h * DVv;
#pragma unroll
    for (int d = 0; d < DVv / 32; ++d)
#pragma unroll
        for (int g = 0; g < 4; ++g) { f32x4 v = {o[d][4 * g] * il, o[d][4 * g + 1] * il, o[d][4 * g + 2] * il, o[d][4 * g + 3] * il}; ss += dot4(v); st_bf4(op + 32 * d + 8 * g + 4 * hi, v); }
    if (ssout) { ss += __shfl_xor(ss, 32); if (hi == 0) ssout[(size_t)(b * Sq + q0 + c) * ssld + h] = ss; }
}

__device__ __forceinline__ void ssm_seq_wave(int bg, int p, const bf16_t* proj, const float* a_re, const float* a_im, const float* log_dt, const float* b_re, const float* b_im, const float* c_re, const float* c_im, const float* dd, bf16_t* G) {
    const int b = bg / SG, g = bg % SG;
    const float lr = a_re[g * SP + p], li = a_im[g * SP + p], dt = expf(log_dt[g]);
    const float decay = expf(lr * dt); float sn, cs; sincosf(li * dt, &sn, &cs);
    const float ar = decay * cs, ai = decay * sn, den = lr * lr + li * li, nr = ar - 1.f;
    const float cr = (nr * lr + ai * li) / den, ci = (ai * lr - nr * li) / den;
    float bbr[16], bbi[16], ccr[16], cci[16];
#pragma unroll
    for (int h = 0; h < 16; ++h) { const float br = b_re[(g * SP + p) * 16 + h], bi = b_im[(g * SP + p) * 16 + h]; bbr[h] = cr * br - ci * bi; bbi[h] = cr * bi + ci * br;
        ccr[h] = c_re[(g * 16 + h) * SP + p]; cci[h] = c_im[(g * 16 + h) * SP + p]; }
    const float dmy = dd[g * 16 + (p & 15)];
    float xr = 0.f, xi = 0.f;
    for (int t = 0; t < SEQ; ++t) {
        const bf16_t* up = proj + (size_t)(b * SEQ + t) * SSMW + g * 16;
        const bf16x8 u0 = *(const bf16x8*)up, u1 = *(const bf16x8*)(up + 8);
        float u[16];
#pragma unroll
        for (int h = 0; h < 8; ++h) { u[h] = bf2f((unsigned short)u0[h]); u[8 + h] = bf2f((unsigned short)u1[h]); }
        float bur = 0.f, bui = 0.f;
#pragma unroll
        for (int h = 0; h < 16; ++h) { bur += bbr[h] * u[h]; bui += bbi[h] * u[h]; }
        const float nxr = ar * xr - ai * xi + bur, nxi = ar * xi + ai * xr + bui; xr = nxr; xi = nxi;
        float ymine = 0.f;
#pragma unroll
        for (int h = 0; h < 16; ++h) { float v = wave_sum(xr * ccr[h] - xi * cci[h]); if ((p & 15) == h) ymine = v + dmy * u[h]; }
        if (p < 16) { const float y = ymine; const float gl = 0.5f * y * (1.f + tanhf(0.7978845608028654f * (y + 0.044715f * y * y * y)));
            G[(size_t)(b * SEQ + t) * SSMW + g * 16 + p] = (bf16_t)f2bf(gl); }
    }
}
constexpr int NWAVES = 8, NTHREADS = NWAVES * 64;
constexpr int RING_BYTES = 131072, LDSCTL_OFF = RING_BYTES, MISC_OFF = LDSCTL_OFF + 320, SCR_OFF = RING_BYTES + 1024, LDS_BYTES = 147456;
constexpr size_t CTL_ZERO_BYTES = 64 * 1024;
constexpr int CW_BAR = 1024;
#define RLX_AGENT __ATOMIC_RELAXED, __HIP_MEMORY_SCOPE_AGENT
#define XB_TMO      128
#define XB_XCNT(j)  (256  + 64 * (j))
#define XB_XSUB(j)  (1280 + 64 * (j))
#define XB_XGEN(j)  (2304 + 64 * (j))
#define XB_TOP      3328
#define XB_TOPGEN   3392
#define XCD_BAR_WORDS 3456
#define XB_SPIN_CAP (1u << 24)
static_assert((CW_BAR + XCD_BAR_WORDS) * 4 <= (int)CTL_ZERO_BYTES, "barrier words inside the memset region");
__device__ __forceinline__ unsigned xb_ld(unsigned* p)              { return __hip_atomic_load(p, __ATOMIC_RELAXED, __HIP_MEMORY_SCOPE_AGENT); }
__device__ __forceinline__ unsigned xb_add(unsigned* p, unsigned v) { return __hip_atomic_fetch_add(p, v, __ATOMIC_RELAXED, __HIP_MEMORY_SCOPE_AGENT); }
__device__ __forceinline__ unsigned xb_xcc_id() { return (unsigned)__builtin_amdgcn_s_getreg((3 << 11) | 20) & 0xFu; }
#define XB_SPIN(cond, bar) do { unsigned _sp = 0; while (cond) { __builtin_amdgcn_s_sleep(1); \
    if ((++_sp & 255u) == 0u) { if (xb_ld(&(bar)[XB_TMO])) break; if (_sp > XB_SPIN_CAP) { atomicAdd(&(bar)[XB_TMO], 1u); break; } } } } while (0)
struct XcdBarrier { unsigned* bar; unsigned x; volatile LAS unsigned* st; };
__device__ __forceinline__ XcdBarrier xcd_barrier_post(unsigned* bar, volatile LAS unsigned* st) {
    XcdBarrier b; b.bar = bar; b.x = xb_xcc_id(); b.st = st;
    if (threadIdx.x == 0) (void)xb_add(&bar[XB_XCNT(b.x)], 1u);
    return b;
}
__device__ __forceinline__ void xcd_barrier_complete(unsigned* bar, unsigned x, unsigned& nloc, unsigned& nx) {
    const unsigned G = gridDim.x * gridDim.y * gridDim.z;
    unsigned sum, cnt, mine, sp = 0u;
    for (;;) {
        sum = 0u; cnt = 0u; mine = 0u;
#pragma unroll
        for (unsigned j = 0; j < 16; ++j) { const unsigned c = xb_ld(&bar[XB_XCNT(j)]); sum += c; cnt += (c > 0u) ? 1u : 0u; mine = (j == x) ? c : mine; }
        if (sum == G) break;
        __builtin_amdgcn_s_sleep(1);
        if ((++sp & 255u) == 0u) { if (xb_ld(&bar[XB_TMO])) break; if (sp > XB_SPIN_CAP) { atomicAdd(&bar[XB_TMO], 1u); break; } }
    }
    nloc = mine > 0u ? mine : 1u; nx = cnt > 0u ? cnt : 1u;
}
__device__ __forceinline__ void xcd_barrier(const XcdBarrier& b) {
    asm volatile("s_waitcnt vmcnt(0)" ::: "memory");
    __syncthreads();
    if (threadIdx.x == 0) {
        unsigned* bar = b.bar;
        __builtin_amdgcn_s_waitcnt(0);
        unsigned nloc = b.st[0], nx = b.st[1];
        if (nloc == 0u) { xcd_barrier_complete(bar, b.x, nloc, nx); b.st[0] = nloc; b.st[1] = nx; }
        const unsigned old = xb_add(&bar[XB_XSUB(b.x)], 1u);
        const unsigned gen = old / nloc;
        if (old + 1u == (gen + 1u) * nloc) {
            __builtin_amdgcn_fence(__ATOMIC_RELEASE, "agent");
            asm volatile("s_waitcnt vmcnt(0)" ::: "memory");
            const unsigned og = xb_add(&bar[XB_TOP], 1u);
            const unsigned tg = og / nx;
            if (og + 1u == (tg + 1u) * nx) xb_add(&bar[XB_TOPGEN], 1u);
            else XB_SPIN(xb_ld(&bar[XB_TOPGEN]) == tg, bar);
            __builtin_amdgcn_fence(__ATOMIC_ACQUIRE, "agent");
            xb_add(&bar[XB_XGEN(b.x)], 1u);
            asm volatile("s_waitcnt vmcnt(0)" ::: "memory");
        } else {
            XB_SPIN(xb_ld(&bar[XB_XGEN(b.x)]) == gen, bar);
            __builtin_amdgcn_fence(__ATOMIC_ACQUIRE, "agent");
            asm volatile("s_waitcnt vmcnt(0)" ::: "memory");
        }
    }
    __syncthreads();
}

#define FI(i) ((const float*)karg(i))
#define KOUT() ((float*)karg(39))
#define KWS() ((unsigned char*)karg(40))
#define B16(off) ((bf16_t*)(ws + (off)))
#define F32(off) ((float*)(ws + (off)))
#define PHASE_IDS() int tid = threadIdx.x; asm volatile("" : "+v"(tid)); const int lane = tid & 63, wave = __builtin_amdgcn_readfirstlane(tid >> 6), half = tid >> 8, vtid = tid & 255; \
    const int G = gridDim.x, bid = blockIdx.x; unsigned char* ws = KWS(); (void)lane; (void)wave; (void)half; (void)vtid; (void)G; (void)bid; (void)ws
#define FOR_VB(vb, n) for (int vb = 2 * bid + half; vb < (n); vb += 2 * G)
#define RING ((LAS unsigned char*)lds)
#define SCR ((LAS float*)(lds + SCR_OFF))
__global__ void __launch_bounds__(NTHREADS, 2) fwd_megakernel(Params P) {
    extern __shared__ __attribute__((aligned(16))) unsigned char lds[];
    { const int tid0 = threadIdx.x; for (int u = tid0; u < (LDS_BYTES - LDSCTL_OFF) / 4; u += NTHREADS) ((unsigned*)(lds + LDSCTL_OFF))[u] = 0u; }
    __syncthreads();
    XcdBarrier bar = xcd_barrier_post((unsigned*)(KWS() + WS_CTL) + CW_BAR, (volatile LAS unsigned*)(lds + MISC_OFF) + 8);
#define GRID_BAR() xcd_barrier(bar)

    { PHASE_IDS();
        float* tile = (float*)(lds + half * 17408);
        const int iters = (WTILES_TOTAL + 2 * G - 1) / (2 * G);
        for (int it = 0; it < iters; ++it) {
            int vb = 2 * (it * G + bid) + half; const bool have = vb < WTILES_TOTAL; int valid = 0; WDesc d{}; int nc = 0, kc = 0;
            if (have) { int m = 0; for (; m < NWMAT - 1; ++m) { const int nt = wmat_tiles(m); if (vb < nt) break; vb -= nt; }
                d = get_wdesc(ws, m); const int nchunks = d.N / 64; nc = vb % nchunks; kc = vb / nchunks; convert_tile_load(d, nc, kc, vtid, tile, valid); }
            __syncthreads();
            if (have) convert_tile_store(d, nc, kc, vtid, tile, valid);
            __syncthreads();
        }
        const int gw = bid * NWAVES + wave, NGW = G * NWAVES;
        { const float* x = FI(0); for (int r = gw; r < T; r += NGW) row_to_bf16(x, B16(WS_XB), F32(WS_SS), r, lane); }
        { const float* mem = FI(1); for (int r = gw; r < TM; r += NGW) row_to_bf16(mem, B16(WS_MEMB), F32(WS_SSMEM), r, lane); }
        { const int* pos = (const int*)karg(2); for (int i = bid * NTHREADS + tid; i < T * 32; i += G * NTHREADS) rope_entry(pos, (float2*)(ws + WS_ROPE), i); }
    }
    GRID_BAR();
    { PHASE_IDS(); pg8::Gemm g{B16(WS_XB), B16(WS_W1T), DM, DM, T, NUP}; pg8::StaticOrder S; S.init(T, NUP, G, bid);
      const PEpiUp<1> e{0, ws}; pg8::gemm_phase(tid, RING, SCR, g, S, e); }
    GRID_BAR();
    { PHASE_IDS(); pg8::Gemm g{B16(WS_H), B16(WS_WD1T), DFFP, DFFP, T, DM}; pg8::StaticOrder S; S.init(T, DM, G, bid);
      const PEpiRes<0> e{0, ws}; pg8::gemm_phase(tid, RING, SCR, g, S, e); }
    GRID_BAR();
    { PHASE_IDS(); pg8::Gemm g{B16(WS_XB), B16(WS_WINT), DM, DM, T, NIN}; pg8::StaticOrder S; S.init(T, NIN, G, bid);
      const PEpiIn e{0, ws}; pg8::gemm_phase(tid, RING, SCR, g, S, e); }
    { PHASE_IDS(); pg8::Gemm g{B16(WS_MEMB), B16(WS_WXKVT), DM, DM, TM, DM}; pg8::StaticOrder S; S.init(TM, DM, G, (bid >= 64 && bid < 80) ? bid - 64 : -1); S.G = 16;
      const PEpiMemKV<true> e{0, ws}; pg8::gemm_phase(tid, RING, SCR, g, S, e); }
    GRID_BAR();
    { PHASE_IDS(); pg8::Gemm g{B16(WS_CQ), B16(WS_WUQT), QRANK, QRANK, T, 1024}; pg8::StaticOrder S; S.init(T, 1024, G, bid);
      const PEpiQ e{0, ws}; pg8::gemm_phase(tid, RING, SCR, g, S, e); }
    { PHASE_IDS(); pg8::Gemm g{B16(WS_CKV), B16(WS_WUKVT), KVRANK, KVRANK, T, 1024}; pg8::StaticOrder S; S.init(T, 1024, G, bid);
      const PEpiKV<true> e{0, ws}; pg8::gemm_phase(tid, RING, SCR, g, S, e); }
    GRID_BAR();
    { PHASE_IDS();
      FOR_VB(vb, (SEQ / 128) * BATCH * NH) attn_simple_vb<DQK, DV, true>((SEQ / 128 - 1) - vb % (SEQ / 128), vb / (SEQ / 128), vtid, B16(WS_Q), B16(WS_K), B16(WS_VT), B16(WS_YCAT), F32(WS_SSY), NH * DQK, NH * DQK, DM, 8, SEQ, SEQ); }
    { PHASE_IDS();
      if (wave == 0) for (int bg = bid; bg < BATCH * SG; bg += G) ssm_seq_wave(bg, lane, B16(WS_U), FI(15), FI(16), FI(17), FI(18), FI(19), FI(20), FI(21), FI(22), B16(WS_G)); }
    GRID_BAR();
    { PHASE_IDS(); pg8::Gemm g{B16(WS_G), B16(WS_WGLUT), SSMW, SSMW, T, SSMW}; pg8::StaticOrder S; S.init(T, SSMW, G, bid);
      const PEpiGlu e{0, ws}; pg8::gemm_phase(tid, RING, SCR, g, S, e); }
    GRID_BAR();
    { PHASE_IDS(); pg8::Gemm g{B16(WS_YCAT), B16(WS_WOT), DM, DM, T, DM}; pg8::StaticOrder S; S.init(T, DM, G, bid);
      const PEpiWo e{8, ws}; pg8::gemm_phase(tid, RING, SCR, g, S, e); }
    GRID_BAR();
    { PHASE_IDS(); pg8::Gemm g{B16(WS_XB), B16(WS_WXQT), DM, DM, T, 512}; pg8::StaticOrder S; S.init(T, 512, G, bid);
      const PEpiXQ e{0, ws}; pg8::gemm_phase(tid, RING, SCR, g, S, e); }
    GRID_BAR();
    { PHASE_IDS();
      FOR_VB(vb, (SEQ / 128) * BATCH * NH) attn_simple_vb<128, 128, false>(vb % (SEQ / 128), vb / (SEQ / 128), vtid, B16(WS_XQ), B16(WS_XK), B16(WS_XVT), B16(WS_XO), (float*)nullptr, 512, 512, 512, 0, SEQ, MEML); }
    GRID_BAR();
    { PHASE_IDS(); pg8::Gemm g{B16(WS_XO), B16(WS_WXOT), 512, 512, T, DM}; pg8::StaticOrder S; S.init(T, DM, G, bid);
      const PEpiRes<1> e{0, ws}; pg8::gemm_phase(tid, RING, SCR, g, S, e); }
    GRID_BAR();
    { PHASE_IDS(); pg8::Gemm g{B16(WS_XB), B16(WS_W2T), DM, DM, T, NUP}; pg8::StaticOrder S; S.init(T, NUP, G, bid);
      const PEpiUp<1> e{0, ws}; pg8::gemm_phase(tid, RING, SCR, g, S, e); }
    GRID_BAR();
    { PHASE_IDS(); pg8::Gemm g{B16(WS_H), B16(WS_WD2T), DFFP, DFFP, T, DM}; pg8::StaticOrder S; S.init(T, DM, G, bid);
      const PEpiRes<2> e{0, ws}; pg8::gemm_phase(tid, RING, SCR, g, S, e); }
}

extern "C" void kernel_launch(void* const* d_in, const int* in_sizes, int n_in, void* d_out, int out_size, void* d_ws, size_t ws_size, hipStream_t stream) {
    static int grid = 0;
    if (grid == 0) {
        if (n_in != 39 || out_size != T * DM || ws_size < WS_END) { fprintf(stderr, "kernel_launch: unexpected shapes (n_in %d out %d ws %zu)\n", n_in, out_size, ws_size); grid = -1; return; }
        int dev = 0, cus = 0, per_cu = 0;
        if (hipGetDevice(&dev) != hipSuccess || hipDeviceGetAttribute(&cus, hipDeviceAttributeMultiprocessorCount, dev) != hipSuccess) { grid = -1; return; }
        if (hipFuncSetAttribute((const void*)fwd_megakernel, hipFuncAttributeMaxDynamicSharedMemorySize, LDS_BYTES) != hipSuccess) { fprintf(stderr, "kernel_launch: hipFuncSetAttribute failed\n"); grid = -1; return; }
        if (hipOccupancyMaxActiveBlocksPerMultiprocessor(&per_cu, (const void*)fwd_megakernel, NTHREADS, LDS_BYTES) != hipSuccess || per_cu < 1) { fprintf(stderr, "kernel_launch: occupancy query says %d\n", per_cu); }
        (void)hipGetLastError();
        grid = cus;
    }
    if (grid < 0) return;
    (void)hipMemsetAsync((char*)d_ws + WS_CTL, 0, CTL_ZERO_BYTES, stream);
    Params p{};
    for (int i = 0; i < 39; ++i) p.in[i] = d_in[i];
    p.out = (float*)d_out; p.ws = (unsigned char*)d_ws;
    hipLaunchKernelGGL(fwd_megakernel, dim3(grid), dim3(NTHREADS), LDS_BYTES, stream, p);
}
```

```cpp
#include <hip/hip_runtime.h>
#include <cstdint>
#include <cstdio>

typedef unsigned short bf16_t;
typedef short bf16x8 __attribute__((ext_vector_type(8)));
typedef short bf16x4 __attribute__((ext_vector_type(4)));
typedef float f32x4 __attribute__((ext_vector_type(4)));
typedef float f32x16 __attribute__((ext_vector_type(16)));
typedef unsigned u32x2 __attribute__((ext_vector_type(2)));
typedef unsigned u32x4 __attribute__((ext_vector_type(4)));

constexpr int BATCH = 4, SEQ = 4096, DM = 1024, T = BATCH * SEQ, MEML = 256, TM = BATCH * MEML;
constexpr int DFF = 2752, DFFP = 2816, NUP = 2 * DFFP;
constexpr int NIN = 1280;
constexpr int PQ = 0, PKR = 384, PKV = 512, PU = 768;
constexpr int QRANK = 384, KVRANK = 256, NH = 4, DQK = 192, DNOPE = 128, DROPE = 64, DV = 128;
constexpr int SSMW = 512, SG = 32, SP = 64;
constexpr float EPS = 1e-6f;
constexpr float LOG2E = 1.4426950408889634f;
constexpr float QSCALE = 0.07216878364870322f * LOG2E;
constexpr float XSCALE = 0.08838834764831845f * LOG2E;

constexpr size_t MiB = 1u << 20;
constexpr size_t WS_CTL = 0;
constexpr size_t WS_W1T = 1 * MiB;
constexpr size_t WS_WD1T = 12 * MiB;
constexpr size_t WS_W2T = 18 * MiB;
constexpr size_t WS_WD2T = 29 * MiB;
constexpr size_t WS_WINT = 35 * MiB;
constexpr size_t WS_WUQT = 38 * MiB;
constexpr size_t WS_WUKVT = 39 * MiB;
constexpr size_t WS_WGLUT = 40 * MiB;
constexpr size_t WS_WOT = 41 * MiB;
constexpr size_t WS_WXQT = 43 * MiB;
constexpr size_t WS_WXKVT = 44 * MiB;
constexpr size_t WS_WXOT = 46 * MiB;
constexpr size_t WS_ROPE = 63 * MiB;
constexpr size_t WS_SS = 67 * MiB;
constexpr size_t WS_SSQ = WS_SS + 256 * 1024;
constexpr size_t WS_SSKR = WS_SSQ + 128 * 1024;
constexpr size_t WS_SSKV = WS_SSKR + 64 * 1024;
constexpr size_t WS_SSY = 68 * MiB;
constexpr size_t WS_SSMEM = WS_SSY + 512 * 1024;
constexpr size_t WS_MEMB = 69 * MiB;
constexpr size_t WS_XK = 71 * MiB;
constexpr size_t WS_XVT = 72 * MiB;
constexpr size_t WS_XV = 73 * MiB;
constexpr size_t WS_XB = 74 * MiB;
constexpr size_t WS_G = WS_XB;
constexpr size_t WS_H = 106 * MiB;
constexpr size_t WS_CQ = WS_H;
constexpr size_t WS_CKV = WS_H + 12 * MiB;
constexpr size_t WS_U = WS_H + 20 * MiB;
constexpr size_t WS_KR = WS_H + 36 * MiB;
constexpr size_t WS_Q = WS_H + 40 * MiB;
constexpr size_t WS_K = WS_H + 64 * MiB;
constexpr size_t WS_XQ = WS_Q;
constexpr size_t WS_XO = WS_K;
constexpr size_t WS_KT = 194 * MiB;
constexpr size_t WS_BST = 195 * MiB;
constexpr size_t WS_CMT = 199 * MiB;
constexpr size_t WS_VT = 203 * MiB;
constexpr size_t WS_V = 47 * MiB;
constexpr size_t WS_YCAT = 210 * MiB;
constexpr size_t WS_END = 256 * MiB;

__device__ __forceinline__ unsigned f2bf(float f) { unsigned u = __builtin_bit_cast(unsigned, f); return (u + 0x7fffu + ((u >> 16) & 1u)) >> 16; }
__device__ __forceinline__ unsigned pk2(float lo, float hi) { return f2bf(lo) | (f2bf(hi) << 16); }
__device__ __forceinline__ float bf2f(unsigned short b) { return __builtin_bit_cast(float, (unsigned)b << 16); }
__device__ __forceinline__ float wave_sum(float v) {
#pragma unroll
    for (int o = 1; o < 64; o <<= 1) v += __shfl_xor(v, o);
    return v;
}
__device__ __forceinline__ float quad_row_sum(float v) { v += __shfl_xor(v, 16); v += __shfl_xor(v, 32); return v; }
__device__ __forceinline__ void st_bf4(bf16_t* p, f32x4 v) { u32x2 w; w.x = pk2(v[0], v[1]); w.y = pk2(v[2], v[3]); *(u32x2*)p = w; }
__device__ __forceinline__ float dot4(f32x4 v) { return (v[0] * v[0] + v[1] * v[1]) + (v[2] * v[2] + v[3] * v[3]); }

#define LAS __attribute__((address_space(3)))
#define GAS __attribute__((address_space(1)))
struct Params { const void* in[39]; float* out; unsigned char* ws; };
__device__ __forceinline__ const void* karg(int i) {
    unsigned long long p;
    asm volatile("s_load_dwordx2 %0, %1, %2\n\ts_waitcnt lgkmcnt(0)" : "=s"(p) : "s"(__builtin_amdgcn_kernarg_segment_ptr()), "i"(8 * i) : "memory");
    return (const void*)(const GAS void*)p;
}

struct WDesc { const float* W; const float* W2; int ldw; int Ksrc; bf16_t* dst; int N; int K; const float* g; const float* g2; int gsplit; int mode; int ncols_src; int pad; };
__device__ __forceinline__ int src_chunk_col(const WDesc& d, int c, const float*& src) {
    src = d.W;
    switch (d.mode) {
        case 0: return (32 * c < d.ncols_src) ? 32 * c : -1;
        case 1: { const int pn = c >> 3, q = c & 7; const int col = 128 * pn + 32 * (q & 3); if (q >= 4) src = d.W2; return col < d.ncols_src ? col : -1; }
        case 2: { if (c < 12) return 32 * c; if (c < 14) return 640 + 32 * (c - 12); if (c < 16) return -1; if (c < 24) return 384 + 32 * (c - 16); return 704 + 32 * (c - 24); }
        case 3: { const int h = c >> 3, q = c & 7; if (q < 3) return 192 * h + 32 * q; if (q == 3) return 192 * h + 128; if (q == 4) return 192 * h + 96; if (q == 7) return 192 * h + 160; return -1; }
    }
    return -1;
}
constexpr int NWMAT = 12;
__device__ __forceinline__ WDesc get_wdesc(unsigned char* ws, int m) {
#define FI(i) ((const float*)karg(i))
#define WB(off) ((bf16_t*)(ws + (off)))
    switch (m) {
        case 0: return WDesc{FI(4), FI(5), DFF, DM, WB(WS_W1T), NUP, DM, FI(3), FI(3), DM, 1, DFF, 0};
        case 1: return WDesc{FI(36), FI(37), DFF, DM, WB(WS_W2T), NUP, DM, FI(35), FI(35), DM, 1, DFF, 0};
        case 2: return WDesc{FI(6), nullptr, DM, DFF, WB(WS_WD1T), DM, DFFP, nullptr, nullptr, 0, 0, DM, 0};
        case 3: return WDesc{FI(38), nullptr, DM, DFF, WB(WS_WD2T), DM, DFFP, nullptr, nullptr, 0, 0, DM, 0};
        case 4: return WDesc{FI(8), nullptr, 1216, DM, WB(WS_WINT), NIN, DM, FI(7), FI(7), DM, 2, 1216, 0};
        case 5: return WDesc{FI(10), nullptr, 768, QRANK, WB(WS_WUQT), 1024, QRANK, FI(9), FI(9), QRANK, 3, 768, 0};
        case 6: return WDesc{FI(12), nullptr, 1024, KVRANK, WB(WS_WUKVT), 1024, KVRANK, FI(11), FI(11), KVRANK, 0, 1024, 0};
        case 7: return WDesc{FI(23), nullptr, 512, 512, WB(WS_WGLUT), 512, 512, nullptr, nullptr, 0, 0, 512, 0};
        case 8: return WDesc{FI(27), nullptr, DM, DM, WB(WS_WOT), DM, DM, FI(25), FI(26), 512, 0, DM, 0};
        case 9: return WDesc{FI(30), nullptr, 512, DM, WB(WS_WXQT), 512, DM, FI(28), FI(28), DM, 0, 512, 0};
        case 10: return WDesc{FI(31), nullptr, DM, DM, WB(WS_WXKVT), DM, DM, FI(29), FI(29), DM, 0, DM, 0};
        default: return WDesc{FI(34), nullptr, DM, 512, WB(WS_WXOT), DM, 512, nullptr, nullptr, 0, 0, DM, 0};
    }
#undef FI
#undef WB
}
__device__ __forceinline__ int wmat_tiles(int m) {
    switch (m) { case 0: case 1: return (NUP / 64) * (DM / 64); case 2: case 3: return (DM / 64) * (DFFP / 64); case 4: return (NIN / 64) * (DM / 64); case 5: return 16 * (QRANK / 64);
        case 6: return 16 * (KVRANK / 64); case 7: return 64; case 8: return 256; case 9: return 8 * 16; case 10: return 256; default: return 16 * 8; }
}
constexpr int WTILES_TOTAL = 2 * (NUP / 64) * (DM / 64) + 2 * (DM / 64) * (DFFP / 64) + (NIN / 64) * (DM / 64) + 16 * (QRANK / 64) + 16 * (KVRANK / 64) + 64 + 256 + 128 + 256 + 128;
__device__ __forceinline__ void convert_tile_load(const WDesc& d, int nc, int kc, int vtid, float* tile, int& valid) {
    const float* src0; const float* src1; const int c0 = src_chunk_col(d, 2 * nc, src0), c1 = src_chunk_col(d, 2 * nc + 1, src1); const int k0 = 64 * kc;
    valid = (k0 < d.Ksrc) ? ((c0 >= 0 ? 1 : 0) | (c1 >= 0 ? 2 : 0)) : 0;
    if (valid) {
        for (int e = vtid; e < 64 * 64; e += 256) { const int kk = e >> 6, nn = e & 63; const int k = k0 + kk; const int sub = nn >> 5; const int cc = sub ? c1 : c0; const float* src = sub ? src1 : src0;
            float gg = 1.f; if (d.g) gg = (k < d.gsplit) ? d.g[k] : d.g2[k - d.gsplit];
            tile[kk * 65 + nn] = (cc >= 0) ? src[(size_t)k * d.ldw + cc + (nn & 31)] * gg : 0.f; }
    }
}
__device__ __forceinline__ void convert_tile_store(const WDesc& d, int nc, int kc, int vtid, const float* tile, int valid) {
    const int k0 = 64 * kc;
    for (int e = vtid; e < 64 * 8; e += 256) { const int nn = e >> 3, ch = e & 7;
        u32x4 o = {0u, 0u, 0u, 0u};
        if (valid) { o.x = pk2(tile[(8 * ch + 0) * 65 + nn], tile[(8 * ch + 1) * 65 + nn]); o.y = pk2(tile[(8 * ch + 2) * 65 + nn], tile[(8 * ch + 3) * 65 + nn]);
                     o.z = pk2(tile[(8 * ch + 4) * 65 + nn], tile[(8 * ch + 5) * 65 + nn]); o.w = pk2(tile[(8 * ch + 6) * 65 + nn], tile[(8 * ch + 7) * 65 + nn]); }
        *(u32x4*)(d.dst + (size_t)(64 * nc + nn) * d.K + k0 + 8 * ch) = o; }
}
__device__ __forceinline__ void row_to_bf16(const float* x, bf16_t* out, float* ss4, int row, int lane) {
    const f32x4* xr = (const f32x4*)(x + (size_t)row * DM) + lane; float s = 0.f;
    unsigned long long* o8 = (unsigned long long*)(out + (size_t)row * DM) + lane;
#pragma unroll
    for (int j = 0; j < 4; ++j) { const f32x4 v = xr[64 * j]; s += dot4(v); o8[64 * j] = (unsigned long long)pk2(v[0], v[1]) | ((unsigned long long)pk2(v[2], v[3]) << 32); }
    s = wave_sum(s);
    if (lane < 4) ss4[row * 4 + lane] = lane == 0 ? s : 0.f;
}
__device__ __forceinline__ void rope_entry(const int* pos, float2* tab, int idx) {
    const int t = idx >> 5, i = idx & 31;
    const double inv = exp2(-(double)i / 32.0 * 13.287712379549449);
    double a = (double)pos[t] * inv; a -= 6.283185307179586 * rint(a / 6.283185307179586);
    float s, c; sincosf((float)a, &s, &c); tab[idx] = make_float2(c, s);
}

__device__ __forceinline__ float rs_from4(const float* ss4, int row, float invc) { const f32x4 s = *(const f32x4*)(ss4 + 4 * row); return rsqrtf(((s[0] + s[1]) + (s[2] + s[3])) * invc + EPS); }

namespace pg8 {
#define PG8_LAS __attribute__((address_space(3)))
constexpr int BM = 256, BK = 64, HALF = 128, HTB = HALF * BK * 2, STAGE_BYTES = 8 * HTB, NXCD = 8, WGM = 8;
__host__ __device__ __forceinline__ int lds_byte(int r, int c) { const int st = (r >> 4) * 2 + (c >> 5), rr = r & 15, cc = c & 31, ob = rr * 64 + cc * 2; return st * 1024 + (ob ^ (((ob >> 9) & 1) << 5)); }
__host__ __device__ __forceinline__ void stage_rc(int b, int& R, int& C) { const int st = b / 1024, sb = b % 1024, swz = sb ^ (((sb >> 9) & 1) << 5); R = (st >> 1) * 16 + swz / 64; C = (st & 1) * 32 + (swz % 64) / 2; }
__host__ __device__ __forceinline__ int perm32(int rho) { const int n = rho >> 4, i = rho & 15; return 8 * (i >> 2) + 4 * n + (i & 3); }
struct Unit { int pm, pn; };
struct Gemm { const bf16_t* A; const bf16_t* Bt; int lda; int K; int M, N; };
struct StaticOrder {
    int nM, nN, nwg, G, c;
    __device__ void init(int M, int N, int G_, int c_) { nM = M / BM; nN = N / BM; nwg = nM * nN; G = G_; c = c_; }
    __device__ bool next(int i, Unit& u) const {
        const long L = (long)i * G + c; if (c < 0 || L >= nwg) return false;
        int wgid = (int)L; { const int q = nwg / NXCD, r = nwg % NXCD, xcd = wgid % NXCD, off = wgid / NXCD; wgid = (xcd < r ? xcd * (q + 1) : r * (q + 1) + (xcd - r) * q) + off; }
        const int nig = WGM * nN, gid = wgid / nig, fm = gid * WGM, gsz = (nM - fm) < WGM ? (nM - fm) : WGM;
        u.pm = fm + ((wgid % nig) % gsz); u.pn = (wgid % nig) / gsz; return true;
    }
};
template <class Epi>
__device__ __forceinline__ void gemm_phase(int tid, PG8_LAS unsigned char* lds, PG8_LAS float* scr, const Gemm g, const StaticOrder& S, const Epi& E) {
    const int wid = __builtin_amdgcn_readfirstlane(tid >> 6), lane = tid & 63, wr = wid >> 2, wc = wid & 3, fr = lane & 15, fq = lane >> 4;
    const int K = g.K, nt = K / BK;
    unsigned voffA[2], voffB[2];
#pragma unroll
    for (int i = 0; i < 2; ++i) { int R, C; stage_rc(tid * 16 + i * 8192, R, C); const int Rb = Epi::PERM ? ((R & ~31) + perm32(R & 31)) : R;
        voffA[i] = (unsigned)(R * g.lda + C) * 2u; voffB[i] = (unsigned)(Rb * K + C) * 2u; }
    const size_t kstep = (size_t)(BK * 2);
    const size_t hstepA = (size_t)HALF * g.lda * 2, hstepB = (size_t)HALF * K * 2;
    const size_t tstepA = 2 * hstepA, tstepB = 2 * hstepB;
    const unsigned ldsw = (unsigned)wid * 1024u;
    const int aoff = lds_byte(wr * 64 + fr, fq * 8), boff = lds_byte(wc * 32 + fr, fq * 8);
#define PG8_SA(b, h) (((b) * 2 + (h)) * HTB)
#define PG8_SB(b, h) ((4 + (b) * 2 + (h)) * HTB)
#define PG8_STAGE(bufoff, gbase, voff) do { _Pragma("unroll") for (int _i = 0; _i < 2; ++_i) \
        __builtin_amdgcn_global_load_lds((const unsigned*)((const char*)(gbase) + (voff)[_i]), (PG8_LAS unsigned*)(lds + (bufoff) + ldsw + _i * 8192), 16, 0, 0); } while (0)
#define PG8_LDA(dst, b, h) do { _Pragma("unroll") for (int m = 0; m < 4; ++m) _Pragma("unroll") for (int k = 0; k < 2; ++k) dst[m][k] = *(const PG8_LAS bf16x8*)(lds + PG8_SA(b, h) + aoff + m * 2048 + k * 1024); } while (0)
#define PG8_LDB(dst, b, h) do { _Pragma("unroll") for (int n = 0; n < 2; ++n) _Pragma("unroll") for (int k = 0; k < 2; ++k) dst[n][k] = *(const PG8_LAS bf16x8*)(lds + PG8_SB(b, h) + boff + n * 2048 + k * 1024); } while (0)
#define PG8_MMA(ai, bj, At, Bt) do { __builtin_amdgcn_s_setprio(1); _Pragma("unroll") for (int m = 0; m < 4; ++m) _Pragma("unroll") for (int n = 0; n < 2; ++n) _Pragma("unroll") for (int k = 0; k < 2; ++k) \
        acc[ai][bj][m][n] = __builtin_amdgcn_mfma_f32_16x16x32_bf16(Bt[n][k], At[m][k], acc[ai][bj][m][n], 0, 0, 0); __builtin_amdgcn_s_setprio(0); } while (0)
#define PG8_WAIT_V(n) asm volatile("s_waitcnt vmcnt(" #n ")" ::: "memory")
#define PG8_WAIT_L(n) asm volatile("s_waitcnt lgkmcnt(" #n ")" ::: "memory")
#define PG8_BAR __builtin_amdgcn_s_barrier()
#define PG8_SCHED __builtin_amdgcn_sched_barrier(0)
    Unit cur, nxt; int ui = 0;
    if (!S.next(0, cur)) return;
    f32x4 acc[2][2][4][2];
#pragma unroll
    for (int a = 0; a < 2; ++a)
#pragma unroll
        for (int b = 0; b < 2; ++b)
#pragma unroll
            for (int m = 0; m < 4; ++m)
#pragma unroll
                for (int n = 0; n < 2; ++n) acc[a][b][m][n] = (f32x4){0.f, 0.f, 0.f, 0.f};
    bf16x8 At[4][2], B0[2][2], B1[2][2];
    const char* cA = (const char*)g.A + (size_t)cur.pm * tstepA; const char* cB = (const char*)g.Bt + (size_t)cur.pn * tstepB;
    PG8_STAGE(PG8_SB(0, 0), cB, voffB); PG8_STAGE(PG8_SB(0, 1), cB + hstepB, voffB); PG8_STAGE(PG8_SA(0, 0), cA, voffA); PG8_STAGE(PG8_SA(0, 1), cA + hstepA, voffA);
    if (wr == 1) PG8_BAR;
    PG8_WAIT_V(2); PG8_BAR;
    PG8_STAGE(PG8_SB(1, 0), cB + kstep, voffB); PG8_STAGE(PG8_SA(1, 0), cA + kstep, voffA); PG8_STAGE(PG8_SB(1, 1), cB + hstepB + kstep, voffB);
    PG8_WAIT_V(6); PG8_BAR;
    for (;;) {
        const bool has_next = S.next(ui + 1, nxt);
        const char* nA = has_next ? (const char*)g.A + (size_t)nxt.pm * tstepA : cA; const char* nB = has_next ? (const char*)g.Bt + (size_t)nxt.pn * tstepB : cB;
#pragma unroll 1
        for (int t = 0; t < nt; t += 2) {
            const bool last = (t == nt - 2);
            const char* a1 = cA + (size_t)(t + 1) * kstep;
            const char* a2 = last ? nA : cA + (size_t)(t + 2) * kstep; const char* b2 = last ? nB : cB + (size_t)(t + 2) * kstep;
            const char* a3 = a2 + kstep; const char* b3 = b2 + kstep;
            if constexpr (Epi::HAS_MID) { if (t == E.tmid) { int t2 = tid; asm volatile("" : "+v"(t2)); E.mid(acc, cur, wr, t2 & 15); } }
            PG8_LDB(B0, 0, 0); PG8_LDB(B1, 0, 1); PG8_SCHED; PG8_LDA(At, 0, 0); PG8_STAGE(PG8_SA(1, 1), a1 + hstepA, voffA);
            PG8_WAIT_V(8); PG8_WAIT_L(0); PG8_BAR; PG8_MMA(0, 0, At, B0); PG8_MMA(0, 1, At, B1); PG8_BAR; PG8_SCHED;
            PG8_LDA(At, 0, 1); PG8_STAGE(PG8_SB(0, 0), b2, voffB); PG8_STAGE(PG8_SB(0, 1), b2 + hstepB, voffB); PG8_STAGE(PG8_SA(0, 0), a2, voffA);
            PG8_WAIT_V(8); PG8_WAIT_L(0); PG8_BAR; PG8_MMA(1, 0, At, B0); PG8_MMA(1, 1, At, B1); PG8_BAR; PG8_SCHED;
            PG8_LDB(B0, 1, 0); PG8_LDB(B1, 1, 1); PG8_SCHED; PG8_LDA(At, 1, 0); PG8_STAGE(PG8_SA(0, 1), a2 + hstepA, voffA);
            PG8_WAIT_V(8); PG8_WAIT_L(0); PG8_BAR; PG8_MMA(0, 0, At, B0); PG8_MMA(0, 1, At, B1); PG8_BAR; PG8_SCHED;
            PG8_LDA(At, 1, 1); PG8_STAGE(PG8_SB(1, 0), b3, voffB); PG8_STAGE(PG8_SB(1, 1), b3 + hstepB, voffB); PG8_STAGE(PG8_SA(1, 0), a3, voffA);
            PG8_WAIT_V(8); PG8_WAIT_L(0); PG8_BAR; PG8_MMA(1, 0, At, B0); PG8_MMA(1, 1, At, B1); PG8_BAR; PG8_SCHED;
        }
        if (wr == 0) PG8_BAR;
        { int t2 = tid; asm volatile("" : "+v"(t2)); const int efr = t2 & 15, efq = (t2 >> 4) & 3;
          E(acc, cur, wr, wc, efr, efq, scr); }
        if (!has_next) break;
#pragma unroll
        for (int a = 0; a < 2; ++a)
#pragma unroll
            for (int b = 0; b < 2; ++b)
#pragma unroll
                for (int m = 0; m < 4; ++m)
#pragma unroll
                    for (int n = 0; n < 2; ++n) acc[a][b][m][n] = (f32x4){0.f, 0.f, 0.f, 0.f};
        cur = nxt; cA = nA; cB = nB; ++ui;
        if (wr == 1) PG8_BAR;
    }
    PG8_WAIT_V(0);
    PG8_BAR;
#undef PG8_SA
#undef PG8_SB
#undef PG8_STAGE
#undef PG8_LDA
#undef PG8_LDB
#undef PG8_MMA
#undef PG8_WAIT_V
#undef PG8_WAIT_L
#undef PG8_BAR
#undef PG8_SCHED
}
}

typedef f32x4 Acc[2][2][4][2];
#define PROW(ai, m) (u.pm * 256 + (ai) * 128 + wr * 64 + (m) * 16 + fr)
#define EPI_FOR_AM _Pragma("unroll") for (int ai = 0; ai < 2; ++ai) _Pragma("unroll") for (int m = 0; m < 4; ++m)
#define EPI_FENCE asm volatile("" ::: "memory")
__device__ __forceinline__ u32x4 pack8(f32x4 a, f32x4 b) { u32x4 w; w.x = pk2(a[0], a[1]); w.y = pk2(a[2], a[3]); w.z = pk2(b[0], b[1]); w.w = pk2(b[2], b[3]); return w; }
template <int NV> __device__ __forceinline__ void xch_rows(float (&v)[2][4][NV], LAS float* scr, int wr, int wc, int fr, int fq) {
    EPI_FOR_AM {
#pragma unroll
        for (int k = 0; k < NV; ++k) { const float t = quad_row_sum(v[ai][m][k]); if (fq == 0) scr[((ai * 128 + wr * 64 + m * 16 + fr) * 4 + wc) * NV + k] = t; } }
    asm volatile("s_waitcnt lgkmcnt(0)" ::: "memory"); __builtin_amdgcn_s_barrier(); asm volatile("" ::: "memory");
    EPI_FOR_AM { const LAS float* p = scr + (ai * 128 + wr * 64 + m * 16 + fr) * 4 * NV;
#pragma unroll
        for (int k = 0; k < NV; ++k) v[ai][m][k] = (p[k] + p[NV + k]) + (p[2 * NV + k] + p[3 * NV + k]); }
}
__device__ __forceinline__ float silu_mul(float g, float u) { return g / (1.f + __expf(-g)) * u; }

#define EB16(off) ((bf16_t*)(ws + (off)))
#define EF32(off) ((float*)(ws + (off)))
#define EFI(i) ((const float*)karg(i))
template <int FFN> struct PEpiUp {
    static constexpr bool PERM = true, HAS_MID = false; int tmid; unsigned char* ws;
    __device__ __forceinline__ void operator()(Acc& acc, const pg8::Unit& u, int wr, int wc, int fr, int fq, LAS float*) const {
        const float* ss = EF32(WS_SS); bf16_t* H = EB16(WS_H);
        EPI_FOR_AM { const int r = PROW(ai, m); const float rs = rs_from4(ss, r, 1.f / DM); f32x4 h0, h1;
#pragma unroll
            for (int i = 0; i < 4; ++i) { h0[i] = silu_mul(acc[ai][0][m][0][i] * rs, acc[ai][1][m][0][i] * rs); h1[i] = silu_mul(acc[ai][0][m][1][i] * rs, acc[ai][1][m][1][i] * rs); }
            *(u32x4*)(H + (size_t)r * DFFP + 128 * u.pn + 32 * wc + 8 * fq) = pack8(h0, h1); }
    }
};
template <int MODE> struct PEpiRes {
    static constexpr bool PERM = false, HAS_MID = false; int tmid; unsigned char* ws;
    __device__ __forceinline__ void operator()(Acc& acc, const pg8::Unit& u, int wr, int wc, int fr, int fq, LAS float* scr) const {
        float* out = (float*)karg(39); const float* resid = (MODE == 0) ? EFI(0) : out; bf16_t* xb = EB16(WS_XB); float* ssout = EF32(WS_SS); const float alpha = (MODE == 1) ? 1.f : 0.5f;
        float part[2][4][1];
        EPI_FOR_AM { const int r = PROW(ai, m); float s = 0.f;
#pragma unroll
            for (int bj = 0; bj < 2; ++bj)
#pragma unroll
                for (int n = 0; n < 2; ++n) { const size_t off = (size_t)r * DM + 256 * u.pn + 128 * bj + 32 * wc + 16 * n + 4 * fq; const f32x4 v = *(const f32x4*)(resid + off) + acc[ai][bj][m][n] * alpha;
                    *(f32x4*)(out + off) = v; if (MODE != 2) { st_bf4(xb + off, v); s += dot4(v); } }
            part[ai][m][0] = s; EPI_FENCE; }
        if (MODE != 2) { xch_rows<1>(part, scr, wr, wc, fr, fq); if (wc == 0 && fq == 0) EPI_FOR_AM ssout[PROW(ai, m) * 4 + u.pn] = part[ai][m][0]; }
    }
};
struct PEpiWo {
    static constexpr bool PERM = false, HAS_MID = true; int tmid; unsigned char* ws;
    __device__ __forceinline__ void rsv(int row, float& rm, float& rsm) const { const float* ssy = EF32(WS_SSY); const f32x4 a = *(const f32x4*)(ssy + 8 * row), b = *(const f32x4*)(ssy + 8 * row + 4);
        rm = rsqrtf(((a[0] + a[1]) + (a[2] + a[3])) * (1.f / 512) + EPS); rsm = rsqrtf((b[0] + b[1]) * (1.f / 512) + EPS); }
    __device__ __forceinline__ void mid(Acc& acc, const pg8::Unit& u, int wr, int fr) const {
        EPI_FOR_AM { float rm, rsm; rsv(PROW(ai, m), rm, rsm); const float q = rm / rsm;
#pragma unroll
            for (int bj = 0; bj < 2; ++bj)
#pragma unroll
                for (int n = 0; n < 2; ++n) acc[ai][bj][m][n] = acc[ai][bj][m][n] * q; }
    }
    __device__ __forceinline__ void operator()(Acc& acc, const pg8::Unit& u, int wr, int wc, int fr, int fq, LAS float* scr) const {
        float* out = (float*)karg(39); bf16_t* xb = EB16(WS_XB); float* ssout = EF32(WS_SS);
        float part[2][4][1];
        EPI_FOR_AM { const int r = PROW(ai, m); float rm, rsm; rsv(r, rm, rsm); float s = 0.f;
#pragma unroll
            for (int bj = 0; bj < 2; ++bj)
#pragma unroll
                for (int n = 0; n < 2; ++n) { const size_t off = (size_t)r * DM + 256 * u.pn + 128 * bj + 32 * wc + 16 * n + 4 * fq; const f32x4 v = *(const f32x4*)(out + off) + acc[ai][bj][m][n] * rsm;
                    *(f32x4*)(out + off) = v; st_bf4(xb + off, v); s += dot4(v); }
            part[ai][m][0] = s; EPI_FENCE; }
        xch_rows<1>(part, scr, wr, wc, fr, fq); if (wc == 0 && fq == 0) EPI_FOR_AM ssout[PROW(ai, m) * 4 + u.pn] = part[ai][m][0];
    }
};
struct PEpiIn {
    static constexpr bool PERM = true, HAS_MID = false; int tmid; unsigned char* ws;
    __device__ __forceinline__ void operator()(Acc& acc, const pg8::Unit& u, int wr, int wc, int fr, int fq, LAS float* scr) const {
        const float* ss = EF32(WS_SS); float* ssq = EF32(WS_SSQ); float* sskr = EF32(WS_SSKR); float* sskv = EF32(WS_SSKV);
        float part[2][4][2];
        EPI_FOR_AM { const int r = PROW(ai, m); const float rs = rs_from4(ss, r, 1.f / DM);
#pragma unroll
            for (int bj = 0; bj < 2; ++bj) { const f32x4 v0 = acc[ai][bj][m][0] * rs, v1 = acc[ai][bj][m][1] * rs; const int c = 128 * bj + 32 * wc + 8 * fq; bf16_t* dst = nullptr;
                if (u.pn == 0) dst = EB16(WS_CQ) + (size_t)r * QRANK + c;
                else if (u.pn == 1) { if (bj == 0) dst = EB16(WS_CQ) + (size_t)r * QRANK + 256 + c; else if (wc < 2) dst = EB16(WS_KR) + (size_t)r * 64 + (c - 128); }
                else if (u.pn == 2) dst = EB16(WS_CKV) + (size_t)r * KVRANK + c;
                else dst = EB16(WS_U) + (size_t)r * SSMW + 256 * (u.pn - 3) + c;
                if (dst) *(u32x4*)dst = pack8(v0, v1);
                part[ai][m][bj] = dot4(v0) + dot4(v1); } }
        if (u.pn < 3) {
            if (u.pn == 1 && wc >= 2) EPI_FOR_AM part[ai][m][1] = 0.f;
            xch_rows<2>(part, scr, wr, wc, fr, fq);
            if (wc == 0 && fq == 0) EPI_FOR_AM { const int r = PROW(ai, m);
                if (u.pn == 0) ssq[2 * r] = part[ai][m][0] + part[ai][m][1];
                else if (u.pn == 1) { ssq[2 * r + 1] = part[ai][m][0]; sskr[r] = part[ai][m][1]; }
                else sskv[r] = part[ai][m][0] + part[ai][m][1]; } }
    }
};
struct PEpiQ {
    static constexpr bool PERM = true, HAS_MID = false; int tmid; unsigned char* ws;
    __device__ __forceinline__ void operator()(Acc& acc, const pg8::Unit& u, int wr, int wc, int fr, int fq, LAS float* scr) const {
        const float* ssq = EF32(WS_SSQ); bf16_t* Q = EB16(WS_Q); const float2* tab = (const float2*)(ws + WS_ROPE);
        float part[2][4][1];
        EPI_FOR_AM { const int r = PROW(ai, m); const float rs = rsqrtf((ssq[2 * r] + ssq[2 * r + 1]) * (1.f / QRANK) + EPS); float s = 0.f;
#pragma unroll
            for (int bj = 0; bj < 2; ++bj)
#pragma unroll
                for (int n = 0; n < 2; ++n) { acc[ai][bj][m][n] = acc[ai][bj][m][n] * rs; s += dot4(acc[ai][bj][m][n]); }
            part[ai][m][0] = s; }
        xch_rows<1>(part, scr, wr, wc, fr, fq);
        const float* gq = EFI(13);
        EPI_FOR_AM { const int r = PROW(ai, m); const float rh = rsqrtf(part[ai][m][0] * (1.f / DQK) + EPS) * QSCALE;
            bf16_t* qp = Q + (size_t)r * (NH * DQK) + DQK * u.pn;
            if (wc < 3) { const f32x4 g0 = *(const f32x4*)(gq + 32 * wc + 8 * fq), g1 = *(const f32x4*)(gq + 32 * wc + 8 * fq + 4);
                *(u32x4*)(qp + 32 * wc + 8 * fq) = pack8(acc[ai][0][m][0] * g0 * rh, acc[ai][0][m][1] * g1 * rh);
                if (wc == 0) { const f32x4 h0 = *(const f32x4*)(gq + 96 + 8 * fq), h1 = *(const f32x4*)(gq + 96 + 8 * fq + 4);
                    *(u32x4*)(qp + 96 + 8 * fq) = pack8(acc[ai][1][m][0] * h0 * rh, acc[ai][1][m][1] * h1 * rh); }
            } else { f32x4 o1[2], o2[2];
#pragma unroll
                for (int n = 0; n < 2; ++n) { const f32x4 g1 = *(const f32x4*)(gq + 128 + 8 * fq + 4 * n), g2 = *(const f32x4*)(gq + 160 + 8 * fq + 4 * n);
#pragma unroll
                    for (int i = 0; i < 4; ++i) { const float2 cs = tab[(size_t)r * 32 + 8 * fq + 4 * n + i]; const float x1 = acc[ai][0][m][n][i] * g1[i] * rh, x2 = acc[ai][1][m][n][i] * g2[i] * rh;
                        o1[n][i] = x1 * cs.x - x2 * cs.y; o2[n][i] = x2 * cs.x + x1 * cs.y; } }
                *(u32x4*)(qp + 128 + 8 * fq) = pack8(o1[0], o1[1]); *(u32x4*)(qp + 160 + 8 * fq) = pack8(o2[0], o2[1]); } EPI_FENCE; }
    }
};
template <bool WITH_VT> struct PEpiKV {
    static constexpr bool PERM = true, HAS_MID = false; int tmid; unsigned char* ws;
    __device__ __forceinline__ void operator()(Acc& acc, const pg8::Unit& u, int wr, int wc, int fr, int fq, LAS float* scr) const {
        const float* sskv = EF32(WS_SSKV); const float* sskr = EF32(WS_SSKR); const float2* tab = (const float2*)(ws + WS_ROPE); const bf16_t* krb = EB16(WS_KR); bf16_t* K = EB16(WS_K); bf16_t* V = EB16(WS_V); bf16_t* Vt = EB16(WS_VT);
        float part[2][4][1];
        EPI_FOR_AM { const int r = PROW(ai, m); const float rs = rsqrtf(sskv[r] * (1.f / KVRANK) + EPS);
#pragma unroll
            for (int bj = 0; bj < 2; ++bj)
#pragma unroll
                for (int n = 0; n < 2; ++n) acc[ai][bj][m][n] = acc[ai][bj][m][n] * rs;
            part[ai][m][0] = dot4(acc[ai][0][m][0]) + dot4(acc[ai][0][m][1]); }
        xch_rows<1>(part, scr, wr, wc, fr, fq);
        const float* gk = EFI(14);
        EPI_FOR_AM { const int r = PROW(ai, m); const float rk = rsqrtf((part[ai][m][0] + sskr[r]) * (1.f / DQK) + EPS);
            bf16_t* kp = K + (size_t)r * (NH * DQK) + DQK * u.pn;
            const f32x4 g0 = *(const f32x4*)(gk + 32 * wc + 8 * fq), g1 = *(const f32x4*)(gk + 32 * wc + 8 * fq + 4);
            *(u32x4*)(kp + 32 * wc + 8 * fq) = pack8(acc[ai][0][m][0] * g0 * rk, acc[ai][0][m][1] * g1 * rk);
            *(u32x4*)(V + (size_t)r * 512 + 128 * u.pn + 32 * wc + 8 * fq) = pack8(acc[ai][1][m][0], acc[ai][1][m][1]);
            if (WITH_VT) { const int b = r / SEQ, t = r % SEQ;
#pragma unroll
                for (int n = 0; n < 2; ++n)
#pragma unroll
                    for (int i = 0; i < 4; ++i) Vt[((size_t)(b * NH + u.pn) * DV + 32 * wc + 8 * fq + 4 * n + i) * SEQ + t] = (bf16_t)f2bf(acc[ai][1][m][n][i]); }
            const int idx = 8 * wc + 2 * fq; const bf16_t* kr = krb + (size_t)r * 64;
            const unsigned a1 = *(const unsigned*)(kr + idx), a2 = *(const unsigned*)(kr + 32 + idx); const f32x4 cs = *(const f32x4*)((const float*)tab + ((size_t)r * 32 + idx) * 2);
            const float x1a = bf2f((unsigned short)(a1 & 0xffff)) * gk[128 + idx] * rk, x1b = bf2f((unsigned short)(a1 >> 16)) * gk[129 + idx] * rk;
            const float x2a = bf2f((unsigned short)(a2 & 0xffff)) * gk[160 + idx] * rk, x2b = bf2f((unsigned short)(a2 >> 16)) * gk[161 + idx] * rk;
            *(unsigned*)(kp + 128 + idx) = pk2(x1a * cs[0] - x2a * cs[1], x1b * cs[2] - x2b * cs[3]);
            *(unsigned*)(kp + 160 + idx) = pk2(x2a * cs[0] + x1a * cs[1], x2b * cs[2] + x1b * cs[3]); EPI_FENCE; }
    }
};
struct PEpiGlu {
    static constexpr bool PERM = true, HAS_MID = false; int tmid; unsigned char* ws;
    __device__ __forceinline__ void operator()(Acc& acc, const pg8::Unit& u, int wr, int wc, int fr, int fq, LAS float* scr) const {
        const bf16_t* G = EB16(WS_G); const float* bias = EFI(24); bf16_t* ycat = EB16(WS_YCAT); float* ssy = EF32(WS_SSY);
        float part[2][4][1];
        EPI_FOR_AM { const int r = PROW(ai, m); float s = 0.f;
#pragma unroll
            for (int bj = 0; bj < 2; ++bj) { const int col = 256 * u.pn + 128 * bj + 32 * wc + 8 * fq; const bf16x8 gb = *(const bf16x8*)(G + (size_t)r * SSMW + col); f32x4 o[2];
#pragma unroll
                for (int n = 0; n < 2; ++n) { const f32x4 bv = *(const f32x4*)(bias + col + 4 * n);
#pragma unroll
                    for (int i = 0; i < 4; ++i) { const float g = bf2f((unsigned short)gb[4 * n + i]); o[n][i] = g / (1.f + __expf(-(acc[ai][bj][m][n][i] + bv[i]))); } s += dot4(o[n]); }
                *(u32x4*)(ycat + (size_t)r * DM + 512 + col) = pack8(o[0], o[1]); }
            part[ai][m][0] = s; }
        xch_rows<1>(part, scr, wr, wc, fr, fq); if (wc == 0 && fq == 0) EPI_FOR_AM ssy[PROW(ai, m) * 8 + 4 + u.pn] = part[ai][m][0];
    }
};
struct PEpiXQ {
    static constexpr bool PERM = true, HAS_MID = false; int tmid; unsigned char* ws;
    __device__ __forceinline__ void operator()(Acc& acc, const pg8::Unit& u, int wr, int wc, int fr, int fq, LAS float* scr) const {
        const float* ss = EF32(WS_SS); bf16_t* XQ = EB16(WS_XQ);
        float part[2][4][2];
        EPI_FOR_AM { const int r = PROW(ai, m); const float rs = rs_from4(ss, r, 1.f / DM);
#pragma unroll
            for (int bj = 0; bj < 2; ++bj) { acc[ai][bj][m][0] = acc[ai][bj][m][0] * rs; acc[ai][bj][m][1] = acc[ai][bj][m][1] * rs; part[ai][m][bj] = dot4(acc[ai][bj][m][0]) + dot4(acc[ai][bj][m][1]); } }
        xch_rows<2>(part, scr, wr, wc, fr, fq);
        const float* gq = EFI(32);
        const f32x4 g0 = *(const f32x4*)(gq + 32 * wc + 8 * fq), g1 = *(const f32x4*)(gq + 32 * wc + 8 * fq + 4);
        EPI_FOR_AM { const int r = PROW(ai, m);
#pragma unroll
            for (int bj = 0; bj < 2; ++bj) { const float rh = rsqrtf(part[ai][m][bj] * (1.f / 128) + EPS) * XSCALE;
                *(u32x4*)(XQ + (size_t)r * 512 + 256 * u.pn + 128 * bj + 32 * wc + 8 * fq) = pack8(acc[ai][bj][m][0] * g0 * rh, acc[ai][bj][m][1] * g1 * rh); } }
    }
};
template <bool WITH_VT> struct PEpiMemKV {
    static constexpr bool PERM = true, HAS_MID = false; int tmid; unsigned char* ws;
    __device__ __forceinline__ void operator()(Acc& acc, const pg8::Unit& u, int wr, int wc, int fr, int fq, LAS float* scr) const {
        const float* ss = EF32(WS_SSMEM); bf16_t* XK = EB16(WS_XK); bf16_t* XV = EB16(WS_XV); bf16_t* XVt = EB16(WS_XVT);
        float part[2][4][2];
        EPI_FOR_AM { const int r = PROW(ai, m); const float rs = rs_from4(ss, r, 1.f / DM);
#pragma unroll
            for (int bj = 0; bj < 2; ++bj) { acc[ai][bj][m][0] = acc[ai][bj][m][0] * rs; acc[ai][bj][m][1] = acc[ai][bj][m][1] * rs; part[ai][m][bj] = dot4(acc[ai][bj][m][0]) + dot4(acc[ai][bj][m][1]); } }
        if (u.pn < 2) {
            xch_rows<2>(part, scr, wr, wc, fr, fq);
            const float* gk = EFI(33);
            const f32x4 g0 = *(const f32x4*)(gk + 32 * wc + 8 * fq), g1 = *(const f32x4*)(gk + 32 * wc + 8 * fq + 4);
            EPI_FOR_AM { const int r = PROW(ai, m);
#pragma unroll
                for (int bj = 0; bj < 2; ++bj) { const float rh = rsqrtf(part[ai][m][bj] * (1.f / 128) + EPS);
                    *(u32x4*)(XK + (size_t)r * 512 + 256 * u.pn + 128 * bj + 32 * wc + 8 * fq) = pack8(acc[ai][bj][m][0] * g0 * rh, acc[ai][bj][m][1] * g1 * rh); } }
        } else {
            EPI_FOR_AM { const int r = PROW(ai, m), b = r / MEML, mm = r % MEML;
#pragma unroll
                for (int bj = 0; bj < 2; ++bj) { const int c0 = 256 * (u.pn - 2) + 128 * bj + 32 * wc + 8 * fq;
                    *(u32x4*)(XV + (size_t)r * 512 + c0) = pack8(acc[ai][bj][m][0], acc[ai][bj][m][1]);
                    if (WITH_VT) {
#pragma unroll
                        for (int n = 0; n < 2; ++n)
#pragma unroll
                            for (int i = 0; i < 4; ++i) { const int c = c0 + 4 * n + i, h = c >> 7, d = c & 127; XVt[((size_t)(b * NH + h) * 128 + d) * MEML + mm] = (bf16_t)f2bf(acc[ai][bj][m][n][i]); } } } }
        }
    }
};
template <int DK, int DVv, bool CAUSAL> __device__ __forceinline__ void attn_simple_vb(int qblk, int bh, int vtid, const bf16_t* Q, const bf16_t* K, const bf16_t* Vt, bf16_t* O, float* ssout, int ldq, int ldk, int ldo, int ssld, int Sq, int Skv) {
    const int lane = vtid & 63, w = vtid >> 6, c = lane & 31, hi = lane >> 5;
    const int b = bh / NH, h = bh % NH, q0 = 128 * qblk + 32 * w;
    const bf16_t* qp = Q + (size_t)(b * Sq + q0 + c) * ldq + h * DK + 8 * hi;
    f32x16 o[DVv / 32];
#pragma unroll
    for (int d = 0; d < DVv / 32; ++d)
#pragma unroll
        for (int r = 0; r < 16; ++r) o[d][r] = 0.f;
    float m = -1e30f, l = 0.f;
    const int ntile = CAUSAL ? (q0 / 32 + 1) : (Skv / 32);
    const bf16_t* kbase = K + (size_t)(b * Skv) * ldk + h * DK + 8 * hi;
    const bf16_t* vbase = Vt + (size_t)bh * DVv * Skv;
    for (int tt = 0; tt < ntile; ++tt) {
        const int key0 = 32 * tt;
        f32x16 p;
#pragma unroll
        for (int r = 0; r < 16; ++r) p[r] = 0.f;
        const bf16_t* kp = kbase + (size_t)(key0 + c) * ldk;
#pragma unroll
        for (int s = 0; s < DK / 16; ++s) { const bf16x8 kf = *(const bf16x8*)(kp + 16 * s); const bf16x8 qf = *(const bf16x8*)(qp + 16 * s); p = __builtin_amdgcn_mfma_f32_32x32x16_bf16(kf, qf, p, 0, 0, 0); }
        if (CAUSAL && tt == ntile - 1) {
#pragma unroll
            for (int r = 0; r < 16; ++r) { const int key = key0 + (r & 3) + 8 * (r >> 2) + 4 * hi; if (key > q0 + c) p[r] = -INFINITY; }
        }
        float tm = p[0];
#pragma unroll
        for (int r = 1; r < 16; ++r) tm = fmaxf(tm, p[r]);
        tm = fmaxf(tm, __shfl_xor(tm, 32));
        const float mn = fmaxf(m, tm), alpha = exp2f(m - mn); m = mn;
        float ps = 0.f;
#pragma unroll
        for (int r = 0; r < 16; ++r) { p[r] = exp2f(p[r] - mn); ps += p[r]; }
        l = l * alpha + ps;
        bf16x8 pf[2];
#pragma unroll
        for (int s = 0; s < 2; ++s)
#pragma unroll
            for (int j = 0; j < 8; ++j) pf[s][j] = (short)f2bf(p[8 * s + j]);
#pragma unroll
        for (int d = 0; d < DVv / 32; ++d) {
#pragma unroll
            for (int r = 0; r < 16; ++r) o[d][r] *= alpha;
            const bf16_t* vp = vbase + (size_t)(32 * d + c) * Skv + key0 + 4 * hi;
#pragma unroll
            for (int s = 0; s < 2; ++s) { const bf16x4 v0 = *(const bf16x4*)(vp + 16 * s), v1 = *(const bf16x4*)(vp + 16 * s + 8);
                const bf16x8 vf = {v0[0], v0[1], v0[2], v0[3], v1[0], v1[1], v1[2], v1[3]};
                o[d] = __builtin_amdgcn_mfma_f32_32x32x16_bf16(vf, pf[s], o[d], 0, 0, 0); }
        }
    }
    l += __shfl_xor(l, 32); const float il = 1.f / l; float ss = 0.f;
    bf16_t* op = O + (size_t)(b * Sq + q0 + c) * ldo + h * DVv;
#pragma unroll
    for (int d = 0; d < DVv / 32; ++d)
#pragma unroll
        for (int g = 0; g < 4; ++g) { f32x4 v = {o[d][4 * g] * il, o[d][4 * g + 1] * il, o[d][4 * g + 2] * il, o[d][4 * g + 3] * il}; ss += dot4(v); st_bf4(op + 32 * d + 8 * g + 4 * hi, v); }
    if (ssout) { ss += __shfl_xor(ss, 32); if (hi == 0) ssout[(size_t)(b * Sq + q0 + c) * ssld + h] = ss; }
}

__device__ __forceinline__ void ssm_seq_wave(int bg, int p, const bf16_t* proj, const float* a_re, const float* a_im, const float* log_dt, const float* b_re, const float* b_im, const float* c_re, const float* c_im, const float* dd, bf16_t* G) {
    const int b = bg / SG, g = bg % SG;
    const float lr = a_re[g * SP + p], li = a_im[g * SP + p], dt = expf(log_dt[g]);
    const float decay = expf(lr * dt); float sn, cs; sincosf(li * dt, &sn, &cs);
    const float ar = decay * cs, ai = decay * sn, den = lr * lr + li * li, nr = ar - 1.f;
    const float cr = (nr * lr + ai * li) / den, ci = (ai * lr - nr * li) / den;
    float bbr[16], bbi[16], ccr[16], cci[16];
#pragma unroll
    for (int h = 0; h < 16; ++h) { const float br = b_re[(g * SP + p) * 16 + h], bi = b_im[(g * SP + p) * 16 + h]; bbr[h] = cr * br - ci * bi; bbi[h] = cr * bi + ci * br;
        ccr[h] = c_re[(g * 16 + h) * SP + p]; cci[h] = c_im[(g * 16 + h) * SP + p]; }
    const float dmy = dd[g * 16 + (p & 15)];
    float xr = 0.f, xi = 0.f;
    for (int t = 0; t < SEQ; ++t) {
        const bf16_t* up = proj + (size_t)(b * SEQ + t) * SSMW + g * 16;
        const bf16x8 u0 = *(const bf16x8*)up, u1 = *(const bf16x8*)(up + 8);
        float u[16];
#pragma unroll
        for (int h = 0; h < 8; ++h) { u[h] = bf2f((unsigned short)u0[h]); u[8 + h] = bf2f((unsigned short)u1[h]); }
        float bur = 0.f, bui = 0.f;
#pragma unroll
        for (int h = 0; h < 16; ++h) { bur += bbr[h] * u[h]; bui += bbi[h] * u[h]; }
        const float nxr = ar * xr - ai * xi + bur, nxi = ar * xi + ai * xr + bui; xr = nxr; xi = nxi;
        float ymine = 0.f;
#pragma unroll
        for (int h = 0; h < 16; ++h) { float v = wave_sum(xr * ccr[h] - xi * cci[h]); if ((p & 15) == h) ymine = v + dmy * u[h]; }
        if (p < 16) { const float y = ymine; const float gl = 0.5f * y * (1.f + tanhf(0.7978845608028654f * (y + 0.044715f * y * y * y)));
            G[(size_t)(b * SEQ + t) * SSMW + g * 16 + p] = (bf16_t)f2bf(gl); }
    }
}
namespace att {
typedef short v4i16_t __attribute__((ext_vector_type(4)));
__device__ __forceinline__ unsigned voff_b(unsigned row, unsigned ch) { return 256u * row + 16u * (ch ^ (((row & 3u) << 2) | ((row >> 2) & 3u))); }
template <int DK> struct Cfg { static constexpr int KB = 64 * DK * 2, VB = 64 * 128 * 2, STG = KB + VB, NPK = KB / 1024, NP = STG / 1024, NPW = NP / 8; };
template <int DK> __device__ __forceinline__ void stage_tile(LAS unsigned char* stg, const bf16_t* Kg, int ldk, const bf16_t* Vg, int ldv, int kt, int wid, int lane) {
    typedef Cfg<DK> C;
#pragma unroll
    for (int i = 0; i < C::NPW; ++i) { const int pi = wid * C::NPW + i;
        const bf16_t* src;
        if (pi < C::NPK) src = Kg + (size_t)(64 * kt + lane) * ldk + 8 * pi;
        else { const unsigned pv = pi - C::NPK, row = 4 * pv + (lane >> 4), chs = lane & 15, ch = chs ^ (((row & 3u) << 2) | ((row >> 2) & 3u)); src = Vg + (size_t)(64 * kt + row) * ldv + 8 * ch; }
        __builtin_amdgcn_global_load_lds((const unsigned*)src, (LAS unsigned*)(stg + pi * 1024), 16, 0, 0); }
}
template <int DK, bool CAUSAL> __device__ __forceinline__ void attn_unit(int tid, LAS unsigned char* ring, const bf16_t* Qg, int ldq, const bf16_t* Kg, int ldk, const bf16_t* Vg, int ldv, bf16_t* Og, int ldo, float* ssout, int ssld, int ntiles, int qpos0) {
    typedef Cfg<DK> C;
    const int lane = tid & 63, wid = __builtin_amdgcn_readfirstlane(tid >> 6), c = lane & 31, hi = lane >> 5;
    stage_tile<DK>(ring, Kg, ldk, Vg, ldv, 0, wid, lane);
    bf16x8 qf[DK / 16];
    { const bf16_t* qp = Qg + (size_t)(32 * wid + c) * ldq + 8 * hi;
#pragma unroll
      for (int s = 0; s < DK / 16; ++s) qf[s] = *(const bf16x8*)(qp + 16 * s); }
    f32x16 o[4];
#pragma unroll
    for (int d = 0; d < 4; ++d)
#pragma unroll
        for (int r = 0; r < 16; ++r) o[d][r] = 0.f;
    float m = -1e30f, l = 0.f;
    const int qrow = qpos0 + 32 * wid + c;
    const unsigned q4 = (lane & 15) >> 2, p4 = lane & 3, blk = (lane >> 4) & 1;
    for (int t = 0; t < ntiles; ++t) {
        LAS unsigned char* stg = ring + (t & 1) * C::STG;
        if (t + 1 < ntiles) { stage_tile<DK>(ring + ((t + 1) & 1) * C::STG, Kg, ldk, Vg, ldv, t + 1, wid, lane); asm volatile("s_waitcnt vmcnt(%0)" :: "n"(C::NPW) : "memory"); }
        else asm volatile("s_waitcnt vmcnt(0)" ::: "memory");
        __builtin_amdgcn_s_barrier(); asm volatile("" ::: "memory");
        const bool skip = CAUSAL && (64 * t > qpos0 + 32 * wid + 31);
        if (!skip) {
            f32x16 p0, p1;
#pragma unroll
            for (int r = 0; r < 16; ++r) { p0[r] = 0.f; p1[r] = 0.f; }
#pragma unroll
            for (int s = 0; s < DK / 16; ++s) { const LAS unsigned char* kp = stg + (2 * s + hi) * 1024 + c * 16;
                const bf16x8 k0 = *(const LAS bf16x8*)kp, k1 = *(const LAS bf16x8*)(kp + 512);
                p0 = __builtin_amdgcn_mfma_f32_32x32x16_bf16(k0, qf[s], p0, 0, 0, 0); p1 = __builtin_amdgcn_mfma_f32_32x32x16_bf16(k1, qf[s], p1, 0, 0, 0); }
            if (CAUSAL && (64 * t + 63 > qpos0 + 32 * wid)) {
#pragma unroll
                for (int r = 0; r < 16; ++r) { const int key = 64 * t + (r & 3) + 8 * (r >> 2) + 4 * hi; if (key > qrow) p0[r] = -INFINITY; if (key + 32 > qrow) p1[r] = -INFINITY; } }
            float tm = fmaxf(p0[0], p1[0]);
#pragma unroll
            for (int r = 1; r < 16; ++r) tm = fmaxf(tm, fmaxf(p0[r], p1[r]));
            tm = fmaxf(tm, __shfl_xor(tm, 32));
            const float mn = fmaxf(m, tm), alpha = __builtin_amdgcn_exp2f(m - mn); m = mn;
            float ps = 0.f;
#pragma unroll
            for (int r = 0; r < 16; ++r) { p0[r] = __builtin_amdgcn_exp2f(p0[r] - mn); p1[r] = __builtin_amdgcn_exp2f(p1[r] - mn); ps += p0[r] + p1[r]; }
            l = l * alpha + ps;
            bf16x8 pf[4];
#pragma unroll
            for (int ks = 0; ks < 4; ++ks) { u32x4 w;
                if (ks < 2) { w.x = pk2(p0[8 * ks], p0[8 * ks + 1]); w.y = pk2(p0[8 * ks + 2], p0[8 * ks + 3]); w.z = pk2(p0[8 * ks + 4], p0[8 * ks + 5]); w.w = pk2(p0[8 * ks + 6], p0[8 * ks + 7]); }
                else { const int b = 8 * (ks - 2); w.x = pk2(p1[b], p1[b + 1]); w.y = pk2(p1[b + 2], p1[b + 3]); w.z = pk2(p1[b + 4], p1[b + 5]); w.w = pk2(p1[b + 6], p1[b + 7]); }
                pf[ks] = __builtin_bit_cast(bf16x8, w); }
            const LAS unsigned char* vt = stg + C::KB;
#pragma unroll
            for (int d0 = 0; d0 < 4; ++d0) {
#pragma unroll
                for (int r = 0; r < 16; ++r) o[d0][r] *= alpha;
#pragma unroll
                for (int ks = 0; ks < 4; ++ks) {
                    const unsigned a0 = voff_b(16 * ks + 4 * hi + q4, 4 * d0 + 2 * blk + (p4 >> 1)) + 8 * (p4 & 1), a1 = voff_b(16 * ks + 8 + 4 * hi + q4, 4 * d0 + 2 * blk + (p4 >> 1)) + 8 * (p4 & 1);
                    const v4i16_t v0 = __builtin_amdgcn_ds_read_tr16_b64_v4i16((LAS v4i16_t*)(vt + a0)), v1 = __builtin_amdgcn_ds_read_tr16_b64_v4i16((LAS v4i16_t*)(vt + a1));
                    const bf16x8 vf = {v0[0], v0[1], v0[2], v0[3], v1[0], v1[1], v1[2], v1[3]};
                    o[d0] = __builtin_amdgcn_mfma_f32_32x32x16_bf16(vf, pf[ks], o[d0], 0, 0, 0); } }
        }
        asm volatile("s_waitcnt lgkmcnt(0)" ::: "memory"); __builtin_amdgcn_s_barrier(); asm volatile("" ::: "memory");
    }
    l += __shfl_xor(l, 32); const float il = 1.f / l; float ss = 0.f;
    bf16_t* op = Og + (size_t)(32 * wid + c) * ldo;
#pragma unroll
    for (int d = 0; d < 4; ++d)
#pragma unroll
        for (int g = 0; g < 4; ++g) { f32x4 v = {o[d][4 * g] * il, o[d][4 * g + 1] * il, o[d][4 * g + 2] * il, o[d][4 * g + 3] * il}; ss += dot4(v); st_bf4(op + 32 * d + 8 * g + 4 * hi, v); }
    if (ssout) { ss += __shfl_xor(ss, 32); if (hi == 0) ssout[(size_t)(32 * wid + c) * ssld] = ss; }
}
}

constexpr int NTHREADS_C = 512;
constexpr int SSM_UL = 0, SSM_UL_STRIDE = 1040, SSM_KTL = 66560, SSM_SL = SSM_KTL + 16384, SSM_XPL = 140288, SSM_XP_STRIDE = 272;
__device__ __forceinline__ void ssm_tables_item(int item, int tid, unsigned char* ldsb, unsigned char* ws) {
    const int g = item >> 2, part = item & 3;
    float2* pw = (float2*)ldsb;
    float2* bb = pw + 64 * 33;
    float2* cc = bb + 64 * 16;
    const float* a_re = EFI(15); const float* a_im = EFI(16); const float* log_dt = EFI(17);
    const double dt = exp((double)log_dt[g]);
    for (int e = tid; e < 64 * 33; e += NTHREADS_C) { const int p = e / 33, n = e % 33; const double lr = a_re[g * SP + p], li = a_im[g * SP + p];
        const double mag = exp(lr * dt * n); double sn, cs; sincos(li * dt * n, &sn, &cs); pw[e] = make_float2((float)(mag * cs), (float)(mag * sn)); }
    { const float* b_re = EFI(18); const float* b_im = EFI(19);
      for (int e = tid; e < 64 * 16; e += NTHREADS_C) { const int p = e >> 4, h = e & 15; const double lr = a_re[g * SP + p], li = a_im[g * SP + p];
        const double mag = exp(lr * dt); double sn, cs; sincos(li * dt, &sn, &cs); const double ar = mag * cs, ai = mag * sn, den = lr * lr + li * li, nr = ar - 1.0;
        const double cr = (nr * lr + ai * li) / den, ci = (ai * lr - nr * li) / den; const double br = b_re[(g * SP + p) * 16 + h], bi = b_im[(g * SP + p) * 16 + h];
        bb[e] = make_float2((float)(cr * br - ci * bi), (float)(cr * bi + ci * br)); } }
    { const float* c_re = EFI(20); const float* c_im = EFI(21);
      for (int e = tid; e < 16 * 64; e += NTHREADS_C) cc[e] = make_float2(c_re[g * 16 * SP + e], c_im[g * 16 * SP + e]); }
    __syncthreads();
    if (part < 2) {
        const int hh = tid & 255, h = hh >> 4, h2 = hh & 15, tau0 = 16 * part + 8 * (tid >> 8);
        float acc[8];
#pragma unroll
        for (int j = 0; j < 8; ++j) acc[j] = 0.f;
        for (int p = 0; p < 64; ++p) { const float2 b = bb[p * 16 + h2], cv = cc[h * 64 + p];
#pragma unroll
            for (int j = 0; j < 8; ++j) { const float2 w = pw[p * 33 + tau0 + j]; const float wr = w.x * b.x - w.y * b.y, wi = w.x * b.y + w.y * b.x; acc[j] += cv.x * wr - cv.y * wi; } }
        if (tau0 == 0 && h == h2) acc[0] += EFI(22)[g * 16 + h];
        bf16_t* KT = EB16(WS_KT) + (size_t)g * 8192;
#pragma unroll
        for (int j = 0; j < 8; ++j) KT[((tau0 + j) * 16 + h) * 16 + h2] = (bf16_t)f2bf(acc[j]);
    } else if (part == 2) {
        bf16_t* BsT = EB16(WS_BST) + (size_t)g * 65536; const int k = tid, s = k >> 4, h2 = k & 15;
        for (int n = 0; n < 128; ++n) { const int p = n & 63; const float2 w = pw[p * 33 + 31 - s], b = bb[p * 16 + h2];
            const float v = (n < 64) ? (w.x * b.x - w.y * b.y) : (w.x * b.y + w.y * b.x); BsT[n * 512 + k] = (bf16_t)f2bf(v); }
    } else {
        bf16_t* CmT = EB16(WS_CMT) + (size_t)g * 65536; const int k = tid & 127, p = k & 63;
        for (int j = 0; j < 128; ++j) { const int n = (tid >> 7) + 4 * j, t = n >> 4, h = n & 15; const float2 w = pw[p * 33 + t + 1], cv = cc[h * 64 + p];
            const float v = (k < 64) ? (cv.x * w.x - cv.y * w.y) : -(cv.x * w.y + cv.y * w.x); CmT[n * 128 + k] = (bf16_t)f2bf(v); }
    }
    __syncthreads();
}
__device__ __forceinline__ float gelu_tanh(float y) { const float z = 0.7978845608028654f * (y + 0.044715f * y * y * y); return y / (1.f + __expf(-2.f * z)); }
__device__ __forceinline__ void ssm_unit(int bg, int tid, LAS unsigned char* L, unsigned char* ws) {
    const int b = bg >> 5, g = bg & 31, lane = tid & 63, wid = __builtin_amdgcn_readfirstlane(tid >> 6), fr = lane & 15, fq = lane >> 4;
    const bf16_t* U = EB16(WS_U) + (size_t)b * SEQ * SSMW + g * 16;
    const bf16_t* BsT = EB16(WS_BST) + (size_t)g * 65536; const bf16_t* CmT = EB16(WS_CMT) + (size_t)g * 65536;
    bf16_t* Gout = EB16(WS_G) + (size_t)b * SEQ * SSMW + g * 16;
    { const u32x4* src = (const u32x4*)(EB16(WS_KT) + (size_t)g * 8192); LAS u32x4* dst = (LAS u32x4*)(L + SSM_KTL); dst[tid] = src[tid]; dst[tid + NTHREADS_C] = src[tid + NTHREADS_C]; }
    float xr = 0.f, xi = 0.f, Ar = 0.f, Ai = 0.f;
    if (wid == 0) { const double lr = EFI(15)[g * SP + lane], li = EFI(16)[g * SP + lane], dt = exp((double)EFI(17)[g]); const double mag = exp(lr * dt * 32.0); double sn, cs; sincos(li * dt * 32.0, &sn, &cs); Ar = (float)(mag * cs); Ai = (float)(mag * sn); }
    const int tl0 = wid, tl1 = 15 - wid, tl2 = 16 + wid, tl3 = 31 - wid;
#define SSM_T(tt) ((tt) == 0 ? tl0 : (tt) == 1 ? tl1 : (tt) == 2 ? tl2 : tl3)
#pragma unroll 1
    for (int hf = 0; hf < 2; ++hf) {
#pragma unroll
        for (int i = 0; i < 4; ++i) { const int row = tid + NTHREADS_C * i; const u32x4* s = (const u32x4*)(U + (size_t)(hf * 2048 + row) * SSMW); LAS unsigned char* d = L + SSM_UL + (row >> 5) * SSM_UL_STRIDE + (row & 31) * 32;
            const u32x4 v0 = s[0], v1 = s[1]; *(LAS u32x4*)d = v0; *(LAS u32x4*)(d + 16) = v1; }
        __syncthreads();
        { f32x4 sacc[4];
#pragma unroll
          for (int mf = 0; mf < 4; ++mf) sacc[mf] = (f32x4){0.f, 0.f, 0.f, 0.f};
#pragma unroll 1
          for (int ks = 0; ks < 16; ++ks) { const bf16x8 bfr = *(const bf16x8*)(BsT + (size_t)(16 * wid + fr) * 512 + 32 * ks + 8 * fq);
#pragma unroll
              for (int mf = 0; mf < 4; ++mf) { const bf16x8 afr = *(const LAS bf16x8*)(L + SSM_UL + (16 * mf + fr) * SSM_UL_STRIDE + (2 * ks + (fq >> 1)) * 32 + (fq & 1) * 16);
                  sacc[mf] = __builtin_amdgcn_mfma_f32_16x16x32_bf16(bfr, afr, sacc[mf], 0, 0, 0); } }
#pragma unroll
          for (int mf = 0; mf < 4; ++mf) *(LAS f32x4*)(L + SSM_SL + ((16 * mf + fr) * 128 + 16 * wid + 4 * fq) * 4) = sacc[mf]; }
        __syncthreads();
        if (wid == 0) { const LAS float* S = (const LAS float*)(L + SSM_SL);
#pragma unroll 2
            for (int c = 0; c < 64; ++c) { LAS bf16_t* xp = (LAS bf16_t*)(L + SSM_XPL + c * SSM_XP_STRIDE); xp[lane] = (bf16_t)f2bf(xr); xp[64 + lane] = (bf16_t)f2bf(xi);
                const float sr = S[c * 128 + lane], si = S[c * 128 + 64 + lane]; const float nr = Ar * xr - Ai * xi + sr, ni = Ar * xi + Ai * xr + si; xr = nr; xi = ni; } }
        f32x4 acc[4][4];
#pragma unroll
        for (int tt = 0; tt < 4; ++tt)
#pragma unroll
            for (int mf = 0; mf < 4; ++mf) acc[tt][mf] = (f32x4){0.f, 0.f, 0.f, 0.f};
#pragma unroll 1
        for (int ks = 0; ks < 16; ++ks) { if (2 * ks > tl3) break;
            bf16x8 afr[4];
#pragma unroll
            for (int mf = 0; mf < 4; ++mf) afr[mf] = *(const LAS bf16x8*)(L + SSM_UL + (16 * mf + fr) * SSM_UL_STRIDE + (2 * ks + (fq >> 1)) * 32 + (fq & 1) * 16);
#pragma unroll
            for (int tt = 0; tt < 4; ++tt) { const int t = SSM_T(tt);
                if (2 * ks <= t) { const int tau = t - 2 * ks - (fq >> 1); bf16x8 bfr = {0, 0, 0, 0, 0, 0, 0, 0};
                    if (tau >= 0) bfr = *(const LAS bf16x8*)(L + SSM_KTL + ((tau * 16 + fr) * 16 + 8 * (fq & 1)) * 2);
#pragma unroll
                    for (int mf = 0; mf < 4; ++mf) acc[tt][mf] = __builtin_amdgcn_mfma_f32_16x16x32_bf16(bfr, afr[mf], acc[tt][mf], 0, 0, 0); } } }
        __syncthreads();
#pragma unroll 1
        for (int ks = 0; ks < 4; ++ks) { bf16x8 afr[4];
#pragma unroll
            for (int mf = 0; mf < 4; ++mf) afr[mf] = *(const LAS bf16x8*)(L + SSM_XPL + (16 * mf + fr) * SSM_XP_STRIDE + (32 * ks + 8 * fq) * 2);
#pragma unroll
            for (int tt = 0; tt < 4; ++tt) { const int t = SSM_T(tt); const bf16x8 bfr = *(const bf16x8*)(CmT + (size_t)(t * 16 + fr) * 128 + 32 * ks + 8 * fq);
#pragma unroll
                for (int mf = 0; mf < 4; ++mf) acc[tt][mf] = __builtin_amdgcn_mfma_f32_16x16x32_bf16(bfr, afr[mf], acc[tt][mf], 0, 0, 0); } }
#pragma unroll
        for (int tt = 0; tt < 4; ++tt) { const int t = SSM_T(tt);
#pragma unroll
            for (int mf = 0; mf < 4; ++mf) { f32x4 v = acc[tt][mf];
#pragma unroll
                for (int i = 0; i < 4; ++i) v[i] = gelu_tanh(v[i]);
                st_bf4(Gout + (size_t)(hf * 2048 + (16 * mf + fr) * 32 + t) * SSMW + 4 * fq, v); } }
        __syncthreads();
    }
#undef SSM_T
}

constexpr int NWAVES = 8, NTHREADS = NWAVES * 64;
constexpr int RING_BYTES = 131072, LDSCTL_OFF = RING_BYTES, MISC_OFF = LDSCTL_OFF + 320, SCR_OFF = RING_BYTES + 1024, LDS_BYTES = 163840;
constexpr size_t CTL_ZERO_BYTES = 64 * 1024;
constexpr int CW_BAR = 1024;
#define RLX_AGENT __ATOMIC_RELAXED, __HIP_MEMORY_SCOPE_AGENT
#define XB_TMO      128
#define XB_XCNT(j)  (256  + 64 * (j))
#define XB_XSUB(j)  (1280 + 64 * (j))
#define XB_XGEN(j)  (2304 + 64 * (j))
#define XB_TOP      3328
#define XB_TOPGEN   3392
#define XCD_BAR_WORDS 3456
#define XB_SPIN_CAP (1u << 24)
static_assert((CW_BAR + XCD_BAR_WORDS) * 4 <= (int)CTL_ZERO_BYTES, "barrier words inside the memset region");
__device__ __forceinline__ unsigned xb_ld(unsigned* p)              { return __hip_atomic_load(p, __ATOMIC_RELAXED, __HIP_MEMORY_SCOPE_AGENT); }
__device__ __forceinline__ unsigned xb_add(unsigned* p, unsigned v) { return __hip_atomic_fetch_add(p, v, __ATOMIC_RELAXED, __HIP_MEMORY_SCOPE_AGENT); }
__device__ __forceinline__ unsigned xb_xcc_id() { return (unsigned)__builtin_amdgcn_s_getreg((3 << 11) | 20) & 0xFu; }
#define XB_SPIN(cond, bar) do { unsigned _sp = 0; while (cond) { __builtin_amdgcn_s_sleep(1); \
    if ((++_sp & 255u) == 0u) { if (xb_ld(&(bar)[XB_TMO])) break; if (_sp > XB_SPIN_CAP) { atomicAdd(&(bar)[XB_TMO], 1u); break; } } } } while (0)
struct XcdBarrier { unsigned* bar; unsigned x; volatile LAS unsigned* st; };
__device__ __forceinline__ XcdBarrier xcd_barrier_post(unsigned* bar, volatile LAS unsigned* st) {
    XcdBarrier b; b.bar = bar; b.x = xb_xcc_id(); b.st = st;
    if (threadIdx.x == 0) (void)xb_add(&bar[XB_XCNT(b.x)], 1u);
    return b;
}
__device__ __forceinline__ void xcd_barrier_complete(unsigned* bar, unsigned x, unsigned& nloc, unsigned& nx) {
    const unsigned G = gridDim.x * gridDim.y * gridDim.z;
    unsigned sum, cnt, mine, sp = 0u;
    for (;;) {
        sum = 0u; cnt = 0u; mine = 0u;
#pragma unroll
        for (unsigned j = 0; j < 16; ++j) { const unsigned c = xb_ld(&bar[XB_XCNT(j)]); sum += c; cnt += (c > 0u) ? 1u : 0u; mine = (j == x) ? c : mine; }
        if (sum == G) break;
        __builtin_amdgcn_s_sleep(1);
        if ((++sp & 255u) == 0u) { if (xb_ld(&bar[XB_TMO])) break; if (sp > XB_SPIN_CAP) { atomicAdd(&bar[XB_TMO], 1u); break; } }
    }
    nloc = mine > 0u ? mine : 1u; nx = cnt > 0u ? cnt : 1u;
}
__device__ __forceinline__ void xcd_barrier(const XcdBarrier& b) {
    asm volatile("s_waitcnt vmcnt(0)" ::: "memory");
    __syncthreads();
    if (threadIdx.x == 0) {
        unsigned* bar = b.bar;
        __builtin_amdgcn_s_waitcnt(0);
        unsigned nloc = b.st[0], nx = b.st[1];
        if (nloc == 0u) { xcd_barrier_complete(bar, b.x, nloc, nx); b.st[0] = nloc; b.st[1] = nx; }
        const unsigned old = xb_add(&bar[XB_XSUB(b.x)], 1u);
        const unsigned gen = old / nloc;
        if (old + 1u == (gen + 1u) * nloc) {
            __builtin_amdgcn_fence(__ATOMIC_RELEASE, "agent");
            asm volatile("s_waitcnt vmcnt(0)" ::: "memory");
            const unsigned og = xb_add(&bar[XB_TOP], 1u);
            const unsigned tg = og / nx;
            if (og + 1u == (tg + 1u) * nx) xb_add(&bar[XB_TOPGEN], 1u);
            else XB_SPIN(xb_ld(&bar[XB_TOPGEN]) == tg, bar);
            __builtin_amdgcn_fence(__ATOMIC_ACQUIRE, "agent");
            xb_add(&bar[XB_XGEN(b.x)], 1u);
            asm volatile("s_waitcnt vmcnt(0)" ::: "memory");
        } else {
            XB_SPIN(xb_ld(&bar[XB_XGEN(b.x)]) == gen, bar);
            __builtin_amdgcn_fence(__ATOMIC_ACQUIRE, "agent");
            asm volatile("s_waitcnt vmcnt(0)" ::: "memory");
        }
    }
    __syncthreads();
}

#define FI(i) ((const float*)karg(i))
#define KOUT() ((float*)karg(39))
#define KWS() ((unsigned char*)karg(40))
#define B16(off) ((bf16_t*)(ws + (off)))
#define F32(off) ((float*)(ws + (off)))
#define PHASE_IDS() int tid = threadIdx.x; asm volatile("" : "+v"(tid)); const int lane = tid & 63, wave = __builtin_amdgcn_readfirstlane(tid >> 6), half = tid >> 8, vtid = tid & 255; \
    const int G = gridDim.x, bid = blockIdx.x; unsigned char* ws = KWS(); (void)lane; (void)wave; (void)half; (void)vtid; (void)G; (void)bid; (void)ws
#define FOR_VB(vb, n) for (int vb = 2 * bid + half; vb < (n); vb += 2 * G)
#define RING ((LAS unsigned char*)lds)
#define SCR ((LAS float*)(lds + SCR_OFF))
__global__ void __launch_bounds__(NTHREADS, 2) fwd_megakernel(Params P) {
    extern __shared__ __attribute__((aligned(16))) unsigned char lds[];
    { const int tid0 = threadIdx.x; for (int u = tid0; u < (LDS_BYTES - LDSCTL_OFF) / 4; u += NTHREADS) ((unsigned*)(lds + LDSCTL_OFF))[u] = 0u; }
    __syncthreads();
    XcdBarrier bar = xcd_barrier_post((unsigned*)(KWS() + WS_CTL) + CW_BAR, (volatile LAS unsigned*)(lds + MISC_OFF) + 8);
#define GRID_BAR() xcd_barrier(bar)

    { PHASE_IDS();
        for (int it = bid; it < 4 * SG; it += G) ssm_tables_item(it, tid, lds, ws);
        float* tile = (float*)(lds + half * 17408);
        const int iters = (WTILES_TOTAL + 2 * G - 1) / (2 * G);
        for (int it = 0; it < iters; ++it) {
            int vb = 2 * (it * G + bid) + half; const bool have = vb < WTILES_TOTAL; int valid = 0; WDesc d{}; int nc = 0, kc = 0;
            if (have) { int m = 0; for (; m < NWMAT - 1; ++m) { const int nt = wmat_tiles(m); if (vb < nt) break; vb -= nt; }
                d = get_wdesc(ws, m); const int nchunks = d.N / 64; nc = vb % nchunks; kc = vb / nchunks; convert_tile_load(d, nc, kc, vtid, tile, valid); }
            __syncthreads();
            if (have) convert_tile_store(d, nc, kc, vtid, tile, valid);
            __syncthreads();
        }
        const int gw = bid * NWAVES + wave, NGW = G * NWAVES;
        { const float* x = FI(0); for (int r = gw; r < T; r += NGW) row_to_bf16(x, B16(WS_XB), F32(WS_SS), r, lane); }
        { const float* mem = FI(1); for (int r = gw; r < TM; r += NGW) row_to_bf16(mem, B16(WS_MEMB), F32(WS_SSMEM), r, lane); }
        { const int* pos = (const int*)karg(2); for (int i = bid * NTHREADS + tid; i < T * 32; i += G * NTHREADS) rope_entry(pos, (float2*)(ws + WS_ROPE), i); }
    }
    GRID_BAR();
    { PHASE_IDS(); pg8::Gemm g{B16(WS_XB), B16(WS_W1T), DM, DM, T, NUP}; pg8::StaticOrder S; S.init(T, NUP, G, bid);
      const PEpiUp<1> e{0, ws}; pg8::gemm_phase(tid, RING, SCR, g, S, e); }
    GRID_BAR();
    { PHASE_IDS(); pg8::Gemm g{B16(WS_H), B16(WS_WD1T), DFFP, DFFP, T, DM}; pg8::StaticOrder S; S.init(T, DM, G, bid);
      const PEpiRes<0> e{0, ws}; pg8::gemm_phase(tid, RING, SCR, g, S, e); }
    GRID_BAR();
    { PHASE_IDS(); pg8::Gemm g{B16(WS_XB), B16(WS_WINT), DM, DM, T, NIN}; pg8::StaticOrder S; S.init(T, NIN, G, bid);
      const PEpiIn e{0, ws}; pg8::gemm_phase(tid, RING, SCR, g, S, e); }
    { PHASE_IDS(); pg8::Gemm g{B16(WS_MEMB), B16(WS_WXKVT), DM, DM, TM, DM}; pg8::StaticOrder S; S.init(TM, DM, G, (bid >= 64 && bid < 80) ? bid - 64 : -1); S.G = 16;
      const PEpiMemKV<false> e{0, ws}; pg8::gemm_phase(tid, RING, SCR, g, S, e); }
    GRID_BAR();
    { PHASE_IDS(); pg8::Gemm g{B16(WS_CQ), B16(WS_WUQT), QRANK, QRANK, T, 1024}; pg8::StaticOrder S; S.init(T, 1024, G, bid);
      const PEpiQ e{0, ws}; pg8::gemm_phase(tid, RING, SCR, g, S, e); }
    { PHASE_IDS(); pg8::Gemm g{B16(WS_CKV), B16(WS_WUKVT), KVRANK, KVRANK, T, 1024}; pg8::StaticOrder S; S.init(T, 1024, G, bid);
      const PEpiKV<false> e{0, ws}; pg8::gemm_phase(tid, RING, SCR, g, S, e); }
    GRID_BAR();
    { PHASE_IDS(); const int vcu = (G % 8 == 0) ? (bid % 8) * (G / 8) + bid / 8 : bid;
      for (int v = vcu; v < 128; v += G) { const int bh = v >> 3, s = v & 7, b = bh / NH, h = bh % NH;
          for (int i = 0; i < 2; ++i) { const int qb = (i == 0) ? 15 - s : s; const size_t row0 = (size_t)b * SEQ + 256 * qb;
            att::attn_unit<DQK, true>(tid, RING, B16(WS_Q) + row0 * (NH * DQK) + DQK * h, NH * DQK, B16(WS_K) + (size_t)b * SEQ * (NH * DQK) + DQK * h, NH * DQK, B16(WS_V) + (size_t)b * SEQ * 512 + DV * h, 512,
                                      B16(WS_YCAT) + row0 * DM + DV * h, DM, F32(WS_SSY) + row0 * 8 + h, 8, 4 * (qb + 1), 256 * qb); } } }
    { PHASE_IDS(); const int vcu = (G % 8 == 0) ? (bid % 8) * (G / 8) + bid / 8 : bid;
      for (int v = (vcu >= 128 ? vcu : vcu + ((128 + G - 1) / G) * G); v < 256; v += G) ssm_unit(v - 128, tid, RING, ws); }
    GRID_BAR();
    { PHASE_IDS(); pg8::Gemm g{B16(WS_G), B16(WS_WGLUT), SSMW, SSMW, T, SSMW}; pg8::StaticOrder S; S.init(T, SSMW, G, bid);
      const PEpiGlu e{0, ws}; pg8::gemm_phase(tid, RING, SCR, g, S, e); }
    GRID_BAR();
    { PHASE_IDS(); pg8::Gemm g{B16(WS_YCAT), B16(WS_WOT), DM, DM, T, DM}; pg8::StaticOrder S; S.init(T, DM, G, bid);
      const PEpiWo e{8, ws}; pg8::gemm_phase(tid, RING, SCR, g, S, e); }
    GRID_BAR();
    { PHASE_IDS(); pg8::Gemm g{B16(WS_XB), B16(WS_WXQT), DM, DM, T, 512}; pg8::StaticOrder S; S.init(T, 512, G, bid);
      const PEpiXQ e{0, ws}; pg8::gemm_phase(tid, RING, SCR, g, S, e); }
    GRID_BAR();
    { PHASE_IDS(); const int vcu = (G % 8 == 0) ? (bid % 8) * (G / 8) + bid / 8 : bid;
      for (int v = vcu; v < 256; v += G) { const int bh = v >> 4, qb = v & 15, b = bh / NH, h = bh % NH; const size_t row0 = (size_t)b * SEQ + 256 * qb;
        att::attn_unit<128, false>(tid, RING, B16(WS_XQ) + row0 * 512 + 128 * h, 512, B16(WS_XK) + (size_t)b * MEML * 512 + 128 * h, 512, B16(WS_XV) + (size_t)b * MEML * 512 + 128 * h, 512,
                                   B16(WS_XO) + row0 * 512 + 128 * h, 512, (float*)nullptr, 0, MEML / 64, 0); } }
    GRID_BAR();
    { PHASE_IDS(); pg8::Gemm g{B16(WS_XO), B16(WS_WXOT), 512, 512, T, DM}; pg8::StaticOrder S; S.init(T, DM, G, bid);
      const PEpiRes<1> e{0, ws}; pg8::gemm_phase(tid, RING, SCR, g, S, e); }
    GRID_BAR();
    { PHASE_IDS(); pg8::Gemm g{B16(WS_XB), B16(WS_W2T), DM, DM, T, NUP}; pg8::StaticOrder S; S.init(T, NUP, G, bid);
      const PEpiUp<1> e{0, ws}; pg8::gemm_phase(tid, RING, SCR, g, S, e); }
    GRID_BAR();
    { PHASE_IDS(); pg8::Gemm g{B16(WS_H), B16(WS_WD2T), DFFP, DFFP, T, DM}; pg8::StaticOrder S; S.init(T, DM, G, bid);
      const PEpiRes<2> e{0, ws}; pg8::gemm_phase(tid, RING, SCR, g, S, e); }
}

extern "C" void kernel_launch(void* const* d_in, const int* in_sizes, int n_in, void* d_out, int out_size, void* d_ws, size_t ws_size, hipStream_t stream) {
    static int grid = 0;
    if (grid == 0) {
        if (n_in != 39 || out_size != T * DM || ws_size < WS_END) { fprintf(stderr, "kernel_launch: unexpected shapes (n_in %d out %d ws %zu)\n", n_in, out_size, ws_size); grid = -1; return; }
        int dev = 0, cus = 0, per_cu = 0;
        if (hipGetDevice(&dev) != hipSuccess || hipDeviceGetAttribute(&cus, hipDeviceAttributeMultiprocessorCount, dev) != hipSuccess) { grid = -1; return; }
        if (hipFuncSetAttribute((const void*)fwd_megakernel, hipFuncAttributeMaxDynamicSharedMemorySize, LDS_BYTES) != hipSuccess) { fprintf(stderr, "kernel_launch: hipFuncSetAttribute failed\n"); grid = -1; return; }
        if (hipOccupancyMaxActiveBlocksPerMultiprocessor(&per_cu, (const void*)fwd_megakernel, NTHREADS, LDS_BYTES) != hipSuccess || per_cu < 1) { fprintf(stderr, "kernel_launch: occupancy query says %d\n", per_cu); }
        (void)hipGetLastError();
        grid = cus;
    }
    if (grid < 0) return;
    (void)hipMemsetAsync((char*)d_ws + WS_CTL, 0, CTL_ZERO_BYTES, stream);
    Params p{};
    for (int i = 0; i < 39; ++i) p.in[i] = d_in[i];
    p.out = (float*)d_out; p.ws = (unsigned char*)d_ws;
    hipLaunchKernelGGL(fwd_megakernel, dim3(grid), dim3(NTHREADS), LDS_BYTES, stream, p);
}
```

```cpp
#include <hip/hip_runtime.h>
#include <cstdint>
#include <cstdio>

typedef unsigned short bf16_t;
typedef short bf16x8 __attribute__((ext_vector_type(8)));
typedef short bf16x4 __attribute__((ext_vector_type(4)));
typedef float f32x4 __attribute__((ext_vector_type(4)));
typedef float f32x16 __attribute__((ext_vector_type(16)));
typedef unsigned u32x2 __attribute__((ext_vector_type(2)));
typedef unsigned u32x4 __attribute__((ext_vector_type(4)));

constexpr int BATCH = 4, SEQ = 4096, DM = 1024, T = BATCH * SEQ, MEML = 256, TM = BATCH * MEML;
constexpr int DFF = 2752, DFFP = 2816, NUP = 2 * DFFP;
constexpr int NIN = 1280;
constexpr int PQ = 0, PKR = 384, PKV = 512, PU = 768;
constexpr int QRANK = 384, KVRANK = 256, NH = 4, DQK = 192, DNOPE = 128, DROPE = 64, DV = 128;
constexpr int SSMW = 512, SG = 32, SP = 64;
constexpr float EPS = 1e-6f;
constexpr float LOG2E = 1.4426950408889634f;
constexpr float QSCALE = 0.07216878364870322f * LOG2E;
constexpr float XSCALE = 0.08838834764831845f * LOG2E;

constexpr size_t MiB = 1u << 20;
constexpr size_t WS_CTL = 0;
constexpr size_t WS_W1T = 1 * MiB;
constexpr size_t WS_WD1T = 12 * MiB;
constexpr size_t WS_W2T = 18 * MiB;
constexpr size_t WS_WD2T = 29 * MiB;
constexpr size_t WS_WINT = 35 * MiB;
constexpr size_t WS_WUQT = 38 * MiB;
constexpr size_t WS_WUKVT = 39 * MiB;
constexpr size_t WS_WGLUT = 40 * MiB;
constexpr size_t WS_WOT = 41 * MiB;
constexpr size_t WS_WXQT = 43 * MiB;
constexpr size_t WS_WXKVT = 44 * MiB;
constexpr size_t WS_WXOT = 46 * MiB;
constexpr size_t WS_ROPE = 63 * MiB;
constexpr size_t WS_SS = 67 * MiB;
constexpr size_t WS_SSQ = WS_SS + 256 * 1024;
constexpr size_t WS_SSKR = WS_SSQ + 128 * 1024;
constexpr size_t WS_SSKV = WS_SSKR + 64 * 1024;
constexpr size_t WS_SSY = 68 * MiB;
constexpr size_t WS_SSMEM = WS_SSY + 512 * 1024;
constexpr size_t WS_MEMB = 69 * MiB;
constexpr size_t WS_XK = 71 * MiB;
constexpr size_t WS_XVT = 72 * MiB;
constexpr size_t WS_XV = 73 * MiB;
constexpr size_t WS_XB = 74 * MiB;
constexpr size_t WS_G = 106 * MiB;
constexpr size_t WS_H = 106 * MiB;
constexpr size_t WS_CQ = WS_H;
constexpr size_t WS_CKV = WS_H + 12 * MiB;
constexpr size_t WS_U = WS_H + 20 * MiB;
constexpr size_t WS_KR = WS_H + 36 * MiB;
constexpr size_t WS_Q = WS_H + 40 * MiB;
constexpr size_t WS_K = WS_H + 64 * MiB;
constexpr size_t WS_XQ = WS_Q;
constexpr size_t WS_XO = WS_K;
constexpr size_t WS_KT = 194 * MiB;
constexpr size_t WS_BST = 195 * MiB;
constexpr size_t WS_CMT = 199 * MiB;
constexpr size_t WS_VT = 203 * MiB;
constexpr size_t WS_V = 47 * MiB;
constexpr size_t WS_YCAT = 210 * MiB;
constexpr size_t WS_END = 256 * MiB;

__device__ __forceinline__ unsigned f2bf(float f) { unsigned u = __builtin_bit_cast(unsigned, f); return (u + 0x7fffu + ((u >> 16) & 1u)) >> 16; }
typedef float f32x2_t __attribute__((ext_vector_type(2))); typedef __bf16 bf16x2_t __attribute__((ext_vector_type(2)));
__device__ __forceinline__ unsigned pk2(float lo, float hi) { f32x2_t v = {lo, hi}; bf16x2_t b = __builtin_convertvector(v, bf16x2_t); return __builtin_bit_cast(unsigned, b); }
__device__ __forceinline__ float bf2f(unsigned short b) { return __builtin_bit_cast(float, (unsigned)b << 16); }
__device__ __forceinline__ float wave_sum(float v) {
#pragma unroll
    for (int o = 1; o < 64; o <<= 1) v += __shfl_xor(v, o);
    return v;
}
__device__ __forceinline__ float quad_row_sum(float v) { v += __shfl_xor(v, 16); v += __shfl_xor(v, 32); return v; }
__device__ __forceinline__ void st_bf4(bf16_t* p, f32x4 v) { u32x2 w; w.x = pk2(v[0], v[1]); w.y = pk2(v[2], v[3]); *(u32x2*)p = w; }
__device__ __forceinline__ float dot4(f32x4 v) { return (v[0] * v[0] + v[1] * v[1]) + (v[2] * v[2] + v[3] * v[3]); }

#define LAS __attribute__((address_space(3)))
#define GAS __attribute__((address_space(1)))
struct Params { const void* in[39]; float* out; unsigned char* ws; };
__device__ __forceinline__ const void* karg(int i) {
    unsigned long long p;
    asm volatile("s_load_dwordx2 %0, %1, %2\n\ts_waitcnt lgkmcnt(0)" : "=s"(p) : "s"(__builtin_amdgcn_kernarg_segment_ptr()), "i"(8 * i) : "memory");
    return (const void*)(const GAS void*)p;
}

struct WDesc { const float* W; const float* W2; int ldw; int Ksrc; bf16_t* dst; int N; int K; const float* g; const float* g2; int gsplit; int mode; int ncols_src; int pad; };
__device__ __forceinline__ int src_chunk_col(const WDesc& d, int c, const float*& src) {
    src = d.W;
    switch (d.mode) {
        case 0: return (32 * c < d.ncols_src) ? 32 * c : -1;
        case 1: { const int pn = c >> 3, q = c & 7; const int col = 128 * pn + 32 * (q & 3); if (q >= 4) src = d.W2; return col < d.ncols_src ? col : -1; }
        case 2: { if (c < 12) return 32 * c; if (c < 14) return 640 + 32 * (c - 12); if (c < 16) return -1; if (c < 24) return 384 + 32 * (c - 16); return 704 + 32 * (c - 24); }
        case 3: { const int h = c >> 3, q = c & 7; if (q < 3) return 192 * h + 32 * q; if (q == 3) return 192 * h + 128; if (q == 4) return 192 * h + 96; if (q == 7) return 192 * h + 160; return -1; }
    }
    return -1;
}
constexpr int NWMAT = 12;
__device__ __forceinline__ WDesc get_wdesc(unsigned char* ws, int m) {
#define FI(i) ((const float*)karg(i))
#define WB(off) ((bf16_t*)(ws + (off)))
    switch (m) {
        case 0: return WDesc{FI(4), FI(5), DFF, DM, WB(WS_W1T), NUP, DM, FI(3), FI(3), DM, 1, DFF, 0};
        case 1: return WDesc{FI(36), FI(37), DFF, DM, WB(WS_W2T), NUP, DM, FI(35), FI(35), DM, 1, DFF, 0};
        case 2: return WDesc{FI(6), nullptr, DM, DFF, WB(WS_WD1T), DM, DFFP, nullptr, nullptr, 0, 0, DM, 0};
        case 3: return WDesc{FI(38), nullptr, DM, DFF, WB(WS_WD2T), DM, DFFP, nullptr, nullptr, 0, 0, DM, 0};
        case 4: return WDesc{FI(8), nullptr, 1216, DM, WB(WS_WINT), NIN, DM, FI(7), FI(7), DM, 2, 1216, 0};
        case 5: return WDesc{FI(10), nullptr, 768, QRANK, WB(WS_WUQT), 1024, QRANK, FI(9), FI(9), QRANK, 3, 768, 0};
        case 6: return WDesc{FI(12), nullptr, 1024, KVRANK, WB(WS_WUKVT), 1024, KVRANK, FI(11), FI(11), KVRANK, 0, 1024, 0};
        case 7: return WDesc{FI(23), nullptr, 512, 512, WB(WS_WGLUT), 512, 512, nullptr, nullptr, 0, 0, 512, 0};
        case 8: return WDesc{FI(27), nullptr, DM, DM, WB(WS_WOT), DM, DM, FI(25), FI(26), 512, 0, DM, 0};
        case 9: return WDesc{FI(30), nullptr, 512, DM, WB(WS_WXQT), 512, DM, FI(28), FI(28), DM, 0, 512, 0};
        case 10: return WDesc{FI(31), nullptr, DM, DM, WB(WS_WXKVT), DM, DM, FI(29), FI(29), DM, 0, DM, 0};
        default: return WDesc{FI(34), nullptr, DM, 512, WB(WS_WXOT), DM, 512, nullptr, nullptr, 0, 0, DM, 0};
    }
#undef FI
#undef WB
}
__device__ __forceinline__ int wmat_tiles(int m) {
    switch (m) { case 0: case 1: return (NUP / 64) * (DM / 64); case 2: case 3: return (DM / 64) * (DFFP / 64); case 4: return (NIN / 64) * (DM / 64); case 5: return 16 * (QRANK / 64);
        case 6: return 16 * (KVRANK / 64); case 7: return 64; case 8: return 256; case 9: return 8 * 16; case 10: return 256; default: return 16 * 8; }
}
constexpr int WTILES_TOTAL = 2 * (NUP / 64) * (DM / 64) + 2 * (DM / 64) * (DFFP / 64) + (NIN / 64) * (DM / 64) + 16 * (QRANK / 64) + 16 * (KVRANK / 64) + 64 + 256 + 128 + 256 + 128;
__device__ __forceinline__ void convert_tile_load(const WDesc& d, int nc, int kc, int vtid, float* tile, int& valid) {
    const float* src0; const float* src1; const int c0 = src_chunk_col(d, 2 * nc, src0), c1 = src_chunk_col(d, 2 * nc + 1, src1); const int k0 = 64 * kc;
    valid = (k0 < d.Ksrc) ? ((c0 >= 0 ? 1 : 0) | (c1 >= 0 ? 2 : 0)) : 0;
    if (valid) {
        for (int e = vtid; e < 64 * 64; e += 256) { const int kk = e >> 6, nn = e & 63; const int k = k0 + kk; const int sub = nn >> 5; const int cc = sub ? c1 : c0; const float* src = sub ? src1 : src0;
            float gg = 1.f; if (d.g) gg = (k < d.gsplit) ? d.g[k] : d.g2[k - d.gsplit];
            tile[kk * 65 + nn] = (cc >= 0) ? src[(size_t)k * d.ldw + cc + (nn & 31)] * gg : 0.f; }
    }
}
__device__ __forceinline__ void convert_tile_store(const WDesc& d, int nc, int kc, int vtid, const float* tile, int valid) {
    const int k0 = 64 * kc;
    for (int e = vtid; e < 64 * 8; e += 256) { const int nn = e >> 3, ch = e & 7;
        u32x4 o = {0u, 0u, 0u, 0u};
        if (valid) { o.x = pk2(tile[(8 * ch + 0) * 65 + nn], tile[(8 * ch + 1) * 65 + nn]); o.y = pk2(tile[(8 * ch + 2) * 65 + nn], tile[(8 * ch + 3) * 65 + nn]);
                     o.z = pk2(tile[(8 * ch + 4) * 65 + nn], tile[(8 * ch + 5) * 65 + nn]); o.w = pk2(tile[(8 * ch + 6) * 65 + nn], tile[(8 * ch + 7) * 65 + nn]); }
        *(u32x4*)(d.dst + (size_t)(64 * nc + nn) * d.K + k0 + 8 * ch) = o; }
}
__device__ __forceinline__ void convert_item_wave(const WDesc& d, int nc, int kc, int lane, LAS float* scr) {
    const float* src; const int col0 = src_chunk_col(d, nc, src); const int k0 = 64 * kc, n0 = 32 * nc; const int c = lane & 7;
    if (col0 < 0 || k0 >= d.Ksrc) {
#pragma unroll
        for (int j = 0; j < 4; ++j) { const int n = (lane >> 3) + 8 * j; *(u32x4*)(d.dst + (size_t)(n0 + n) * d.K + k0 + 8 * c) = (u32x4){0u, 0u, 0u, 0u}; }
        return; }
    const float* sp = src + (size_t)(k0 + (lane >> 3)) * d.ldw + col0 + 4 * c;
    f32x4 v[8]; float gg[8];
#pragma unroll
    for (int i = 0; i < 8; ++i) { v[i] = *(const f32x4*)(sp + (size_t)(8 * i) * d.ldw); const int k = k0 + (lane >> 3) + 8 * i; gg[i] = d.g ? ((k < d.gsplit) ? d.g[k] : d.g2[k - d.gsplit]) : 1.f; }
#pragma unroll
    for (int i = 0; i < 8; ++i) { LAS float* w = scr + ((lane >> 3) + 8 * i) * 33 + 4 * c; w[0] = v[i][0] * gg[i]; w[1] = v[i][1] * gg[i]; w[2] = v[i][2] * gg[i]; w[3] = v[i][3] * gg[i]; }
    asm volatile("s_waitcnt lgkmcnt(0)" ::: "memory");
#pragma unroll
    for (int j = 0; j < 4; ++j) { const int n = (lane >> 3) + 8 * j; const LAS float* s = scr + (8 * c) * 33 + n;
        u32x4 o; o.x = pk2(s[0 * 33], s[1 * 33]); o.y = pk2(s[2 * 33], s[3 * 33]); o.z = pk2(s[4 * 33], s[5 * 33]); o.w = pk2(s[6 * 33], s[7 * 33]);
        *(u32x4*)(d.dst + (size_t)(n0 + n) * d.K + k0 + 8 * c) = o; }
    asm volatile("s_waitcnt lgkmcnt(0)" ::: "memory");
}
constexpr int NCONV_ITEMS = 2 * WTILES_TOTAL, NROW_ITEMS = T / 8, NMEM_ITEMS = TM / 8, NROPE_ITEMS = T * 32 / 512, NP0_ITEMS = NCONV_ITEMS + NROW_ITEMS + NMEM_ITEMS + NROPE_ITEMS;
constexpr int CW_Q0 = 64;
__device__ __forceinline__ void row_to_bf16(const float* x, bf16_t* out, float* ss4, int row, int lane) {
    const f32x4* xr = (const f32x4*)(x + (size_t)row * DM) + lane; float s = 0.f;
    unsigned long long* o8 = (unsigned long long*)(out + (size_t)row * DM) + lane;
#pragma unroll
    for (int j = 0; j < 4; ++j) { const f32x4 v = xr[64 * j]; s += dot4(v); o8[64 * j] = (unsigned long long)pk2(v[0], v[1]) | ((unsigned long long)pk2(v[2], v[3]) << 32); }
    s = wave_sum(s);
    if (lane < 4) ss4[row * 4 + lane] = lane == 0 ? s : 0.f;
}
__device__ __forceinline__ void rope_entry(const int* pos, float2* tab, int idx) {
    const int t = idx >> 5, i = idx & 31;
    const double inv = exp2(-(double)i / 32.0 * 13.287712379549449);
    double a = (double)pos[t] * inv; a -= 6.283185307179586 * rint(a / 6.283185307179586);
    float s, c; sincosf((float)a, &s, &c); tab[idx] = make_float2(c, s);
}

__device__ __forceinline__ float rs_from4(const float* ss4, int row, float invc) { const f32x4 s = *(const f32x4*)(ss4 + 4 * row); return rsqrtf(((s[0] + s[1]) + (s[2] + s[3])) * invc + EPS); }

namespace pg8 {
#define PG8_LAS __attribute__((address_space(3)))
constexpr int BM = 256, BK = 64, HALF = 128, HTB = HALF * BK * 2, STAGE_BYTES = 8 * HTB, NXCD = 8, WGM = 8;
__host__ __device__ __forceinline__ int lds_byte(int r, int c) { const int st = (r >> 4) * 2 + (c >> 5), rr = r & 15, cc = c & 31, ob = rr * 64 + cc * 2; return st * 1024 + (ob ^ (((ob >> 9) & 1) << 5)); }
__host__ __device__ __forceinline__ void stage_rc(int b, int& R, int& C) { const int st = b / 1024, sb = b % 1024, swz = sb ^ (((sb >> 9) & 1) << 5); R = (st >> 1) * 16 + swz / 64; C = (st & 1) * 32 + (swz % 64) / 2; }
__host__ __device__ __forceinline__ int perm32(int rho) { const int n = rho >> 4, i = rho & 15; return 8 * (i >> 2) + 4 * n + (i & 3); }
struct Unit { int pm, pn; };
struct Gemm { const bf16_t* A; const bf16_t* Bt; int lda; int K; int M, N; };
struct StaticOrder {
    int nM, nN, nwg, G, c;
    __device__ void init(int M, int N, int G_, int c_) { nM = M / BM; nN = N / BM; nwg = nM * nN; G = G_; c = c_; }
    __device__ bool next(int i, Unit& u) const {
        const long L = (long)i * G + c; if (c < 0 || L >= nwg) return false;
        int wgid = (int)L; { const int q = nwg / NXCD, r = nwg % NXCD, xcd = wgid % NXCD, off = wgid / NXCD; wgid = (xcd < r ? xcd * (q + 1) : r * (q + 1) + (xcd - r) * q) + off; }
        const int nig = WGM * nN, gid = wgid / nig, fm = gid * WGM, gsz = (nM - fm) < WGM ? (nM - fm) : WGM;
        u.pm = fm + ((wgid % nig) % gsz); u.pn = (wgid % nig) / gsz; return true;
    }
};
template <class Epi>
__device__ __forceinline__ void gemm_phase(int tid, PG8_LAS unsigned char* lds, PG8_LAS float* scr, const Gemm g, const StaticOrder& S, const Epi& E) {
    const int wid = __builtin_amdgcn_readfirstlane(tid >> 6), lane = tid & 63, wr = wid >> 2, wc = wid & 3, fr = lane & 15, fq = lane >> 4;
    const int K = g.K, nt = K / BK;
    unsigned voffA[2], voffB[2];
#pragma unroll
    for (int i = 0; i < 2; ++i) { int R, C; stage_rc(tid * 16 + i * 8192, R, C); const int Rb = Epi::PERM ? ((R & ~31) + perm32(R & 31)) : R;
        voffA[i] = (unsigned)(R * g.lda + C) * 2u; voffB[i] = (unsigned)(Rb * K + C) * 2u; }
    const size_t kstep = (size_t)(BK * 2);
    const size_t hstepA = (size_t)HALF * g.lda * 2, hstepB = (size_t)HALF * K * 2;
    const size_t tstepA = 2 * hstepA, tstepB = 2 * hstepB;
    const unsigned ldsw = (unsigned)wid * 1024u;
    const int aoff = lds_byte(wr * 64 + fr, fq * 8), boff = lds_byte(wc * 32 + fr, fq * 8);
#define PG8_SA(b, h) (((b) * 2 + (h)) * HTB)
#define PG8_SB(b, h) ((4 + (b) * 2 + (h)) * HTB)
#define PG8_STAGE(bufoff, gbase, voff) do { _Pragma("unroll") for (int _i = 0; _i < 2; ++_i) \
        __builtin_amdgcn_global_load_lds((const unsigned*)((const char*)(gbase) + (voff)[_i]), (PG8_LAS unsigned*)(lds + (bufoff) + ldsw + _i * 8192), 16, 0, 0); } while (0)
#define PG8_LDA(dst, b, h) do { _Pragma("unroll") for (int m = 0; m < 4; ++m) _Pragma("unroll") for (int k = 0; k < 2; ++k) dst[m][k] = *(const PG8_LAS bf16x8*)(lds + PG8_SA(b, h) + aoff + m * 2048 + k * 1024); } while (0)
#define PG8_LDB(dst, b, h) do { _Pragma("unroll") for (int n = 0; n < 2; ++n) _Pragma("unroll") for (int k = 0; k < 2; ++k) dst[n][k] = *(const PG8_LAS bf16x8*)(lds + PG8_SB(b, h) + boff + n * 2048 + k * 1024); } while (0)
#define PG8_MMA(ai, bj, At, Bt) do { __builtin_amdgcn_s_setprio(1); _Pragma("unroll") for (int m = 0; m < 4; ++m) _Pragma("unroll") for (int n = 0; n < 2; ++n) _Pragma("unroll") for (int k = 0; k < 2; ++k) \
        acc[ai][bj][m][n] = __builtin_amdgcn_mfma_f32_16x16x32_bf16(Bt[n][k], At[m][k], acc[ai][bj][m][n], 0, 0, 0); __builtin_amdgcn_s_setprio(0); } while (0)
#define PG8_WAIT_V(n) asm volatile("s_waitcnt vmcnt(" #n ")" ::: "memory")
#define PG8_WAIT_L(n) asm volatile("s_waitcnt lgkmcnt(" #n ")" ::: "memory")
#define PG8_BAR __builtin_amdgcn_s_barrier()
#define PG8_SCHED __builtin_amdgcn_sched_barrier(0)
    Unit cur, nxt; int ui = 0;
    if (!S.next(0, cur)) return;
    f32x4 acc[2][2][4][2];
#pragma unroll
    for (int a = 0; a < 2; ++a)
#pragma unroll
        for (int b = 0; b < 2; ++b)
#pragma unroll
            for (int m = 0; m < 4; ++m)
#pragma unroll
                for (int n = 0; n < 2; ++n) acc[a][b][m][n] = (f32x4){0.f, 0.f, 0.f, 0.f};
    bf16x8 At[4][2], B0[2][2], B1[2][2];
    const char* cA = (const char*)g.A + (size_t)cur.pm * tstepA; const char* cB = (const char*)g.Bt + (size_t)cur.pn * tstepB;
    PG8_STAGE(PG8_SB(0, 0), cB, voffB); PG8_STAGE(PG8_SB(0, 1), cB + hstepB, voffB); PG8_STAGE(PG8_SA(0, 0), cA, voffA); PG8_STAGE(PG8_SA(0, 1), cA + hstepA, voffA);
    if (wr == 1) PG8_BAR;
    PG8_WAIT_V(2); PG8_BAR;
    PG8_STAGE(PG8_SB(1, 0), cB + kstep, voffB); PG8_STAGE(PG8_SA(1, 0), cA + kstep, voffA); PG8_STAGE(PG8_SB(1, 1), cB + hstepB + kstep, voffB);
    PG8_WAIT_V(6); PG8_BAR;
    for (;;) {
        const bool has_next = S.next(ui + 1, nxt);
        const char* nA = has_next ? (const char*)g.A + (size_t)nxt.pm * tstepA : cA; const char* nB = has_next ? (const char*)g.Bt + (size_t)nxt.pn * tstepB : cB;
#pragma unroll 1
        for (int t = 0; t < nt; t += 2) {
            const bool last = (t == nt - 2);
            const char* a1 = cA + (size_t)(t + 1) * kstep;
            const char* a2 = last ? nA : cA + (size_t)(t + 2) * kstep; const char* b2 = last ? nB : cB + (size_t)(t + 2) * kstep;
            const char* a3 = a2 + kstep; const char* b3 = b2 + kstep;
            if constexpr (Epi::HAS_MID) { if (t == E.tmid) { int t2 = tid; asm volatile("" : "+v"(t2)); E.mid(acc, cur, wr, t2 & 15); } }
            PG8_LDB(B0, 0, 0); PG8_LDB(B1, 0, 1); PG8_SCHED; PG8_LDA(At, 0, 0); PG8_STAGE(PG8_SA(1, 1), a1 + hstepA, voffA);
            PG8_WAIT_V(8); PG8_WAIT_L(0); PG8_BAR; PG8_MMA(0, 0, At, B0); PG8_MMA(0, 1, At, B1); PG8_BAR; PG8_SCHED;
            PG8_LDA(At, 0, 1); PG8_STAGE(PG8_SB(0, 0), b2, voffB); PG8_STAGE(PG8_SB(0, 1), b2 + hstepB, voffB); PG8_STAGE(PG8_SA(0, 0), a2, voffA);
            PG8_WAIT_V(8); PG8_WAIT_L(0); PG8_BAR; PG8_MMA(1, 0, At, B0); PG8_MMA(1, 1, At, B1); PG8_BAR; PG8_SCHED;
            PG8_LDB(B0, 1, 0); PG8_LDB(B1, 1, 1); PG8_SCHED; PG8_LDA(At, 1, 0); PG8_STAGE(PG8_SA(0, 1), a2 + hstepA, voffA);
            PG8_WAIT_V(8); PG8_WAIT_L(0); PG8_BAR; PG8_MMA(0, 0, At, B0); PG8_MMA(0, 1, At, B1); PG8_BAR; PG8_SCHED;
            PG8_LDA(At, 1, 1); PG8_STAGE(PG8_SB(1, 0), b3, voffB); PG8_STAGE(PG8_SB(1, 1), b3 + hstepB, voffB); PG8_STAGE(PG8_SA(1, 0), a3, voffA);
            PG8_WAIT_V(8); PG8_WAIT_L(0); PG8_BAR; PG8_MMA(1, 0, At, B0); PG8_MMA(1, 1, At, B1); PG8_BAR; PG8_SCHED;
        }
        if (wr == 0) PG8_BAR;
        { int t2 = tid; asm volatile("" : "+v"(t2)); const int efr = t2 & 15, efq = (t2 >> 4) & 3;
          E(acc, cur, wr, wc, efr, efq, scr); }
        if (!has_next) break;
#pragma unroll
        for (int a = 0; a < 2; ++a)
#pragma unroll
            for (int b = 0; b < 2; ++b)
#pragma unroll
                for (int m = 0; m < 4; ++m)
#pragma unroll
                    for (int n = 0; n < 2; ++n) acc[a][b][m][n] = (f32x4){0.f, 0.f, 0.f, 0.f};
        cur = nxt; cA = nA; cB = nB; ++ui;
        if (wr == 1) PG8_BAR;
    }
    PG8_WAIT_V(0);
    PG8_BAR;
#undef PG8_SA
#undef PG8_SB
#undef PG8_STAGE
#undef PG8_LDA
#undef PG8_LDB
#undef PG8_MMA
#undef PG8_WAIT_V
#undef PG8_WAIT_L
#undef PG8_BAR
#undef PG8_SCHED
}
}

typedef f32x4 Acc[2][2][4][2];
#define PROW(ai, m) (u.pm * 256 + (ai) * 128 + wr * 64 + (m) * 16 + fr)
#define EPI_FOR_AM _Pragma("unroll") for (int ai = 0; ai < 2; ++ai) _Pragma("unroll") for (int m = 0; m < 4; ++m)
#define EPI_FENCE asm volatile("" ::: "memory")
__device__ __forceinline__ u32x4 pack8(f32x4 a, f32x4 b) { u32x4 w; w.x = pk2(a[0], a[1]); w.y = pk2(a[2], a[3]); w.z = pk2(b[0], b[1]); w.w = pk2(b[2], b[3]); return w; }
template <int NV> __device__ __forceinline__ void xch_rows(float (&v)[2][4][NV], LAS float* scr, int wr, int wc, int fr, int fq) {
    EPI_FOR_AM {
#pragma unroll
        for (int k = 0; k < NV; ++k) { const float t = quad_row_sum(v[ai][m][k]); if (fq == 0) scr[((ai * 128 + wr * 64 + m * 16 + fr) * 4 + wc) * NV + k] = t; } }
    asm volatile("s_waitcnt lgkmcnt(0)" ::: "memory"); __builtin_amdgcn_s_barrier(); asm volatile("" ::: "memory");
    EPI_FOR_AM { const LAS float* p = scr + (ai * 128 + wr * 64 + m * 16 + fr) * 4 * NV;
#pragma unroll
        for (int k = 0; k < NV; ++k) v[ai][m][k] = (p[k] + p[NV + k]) + (p[2 * NV + k] + p[3 * NV + k]); }
}
__device__ __forceinline__ float silu_mul(float g, float u) { return g / (1.f + __expf(-g)) * u; }

#define EB16(off) ((bf16_t*)(ws + (off)))
#define EF32(off) ((float*)(ws + (off)))
#define EFI(i) ((const float*)karg(i))
template <int FFN> struct PEpiUp {
    static constexpr bool PERM = true, HAS_MID = false; int tmid; unsigned char* ws;
    __device__ __forceinline__ void operator()(Acc& acc, const pg8::Unit& u, int wr, int wc, int fr, int fq, LAS float*) const {
        const float* ss = EF32(WS_SS); bf16_t* H = EB16(WS_H);
        EPI_FOR_AM { const int r = PROW(ai, m); const float rs = rs_from4(ss, r, 1.f / DM); f32x4 h0, h1;
#pragma unroll
            for (int i = 0; i < 4; ++i) { h0[i] = silu_mul(acc[ai][0][m][0][i] * rs, acc[ai][1][m][0][i] * rs); h1[i] = silu_mul(acc[ai][0][m][1][i] * rs, acc[ai][1][m][1][i] * rs); }
            *(u32x4*)(H + (size_t)r * DFFP + 128 * u.pn + 32 * wc + 8 * fq) = pack8(h0, h1); }
    }
};
__device__ __forceinline__ void unpack8(u32x4 w, f32x4& a, f32x4& b) { a[0] = __builtin_bit_cast(float, w.x << 16); a[1] = __builtin_bit_cast(float, w.x & 0xffff0000u); a[2] = __builtin_bit_cast(float, w.y << 16); a[3] = __builtin_bit_cast(float, w.y & 0xffff0000u);
    b[0] = __builtin_bit_cast(float, w.z << 16); b[1] = __builtin_bit_cast(float, w.z & 0xffff0000u); b[2] = __builtin_bit_cast(float, w.w << 16); b[3] = __builtin_bit_cast(float, w.w & 0xffff0000u); }
template <int MODE> struct PEpiRes {
    static constexpr bool PERM = true, HAS_MID = false; int tmid; unsigned char* ws;
    __device__ __forceinline__ void operator()(Acc& acc, const pg8::Unit& u, int wr, int wc, int fr, int fq, LAS float* scr) const {
        bf16_t* xb = EB16(WS_XB); float* ssout = EF32(WS_SS); const float alpha = (MODE == 1) ? 1.f : 0.5f;
        float part[2][4][1];
        EPI_FOR_AM { const int r = PROW(ai, m); float s = 0.f;
#pragma unroll
            for (int bj = 0; bj < 2; ++bj) { const size_t off = (size_t)r * DM + 256 * u.pn + 128 * bj + 32 * wc + 8 * fq; f32x4 r0, r1;
                if (MODE == 0) { const float* x = EFI(0); r0 = *(const f32x4*)(x + off); r1 = *(const f32x4*)(x + off + 4); } else unpack8(*(const u32x4*)(xb + off), r0, r1);
                const f32x4 v0 = r0 + acc[ai][bj][m][0] * alpha, v1 = r1 + acc[ai][bj][m][1] * alpha;
                if (MODE == 2) { float* out = (float*)karg(39); *(f32x4*)(out + off) = v0; *(f32x4*)(out + off + 4) = v1; }
                else { *(u32x4*)(xb + off) = pack8(v0, v1); s += dot4(v0) + dot4(v1); } }
            part[ai][m][0] = s; EPI_FENCE; }
        if (MODE != 2) { xch_rows<1>(part, scr, wr, wc, fr, fq); if (wc == 0 && fq == 0) EPI_FOR_AM ssout[PROW(ai, m) * 4 + u.pn] = part[ai][m][0]; }
    }
};
struct PEpiWo {
    static constexpr bool PERM = true, HAS_MID = true; int tmid; unsigned char* ws;
    __device__ __forceinline__ void rsv(int row, float& rm, float& rsm) const { const float* ssy = EF32(WS_SSY); const f32x4 a = *(const f32x4*)(ssy + 8 * row), b = *(const f32x4*)(ssy + 8 * row + 4);
        rm = rsqrtf(((a[0] + a[1]) + (a[2] + a[3])) * (1.f / 512) + EPS); rsm = rsqrtf((b[0] + b[1]) * (1.f / 512) + EPS); }
    __device__ __forceinline__ void mid(Acc& acc, const pg8::Unit& u, int wr, int fr) const {
        EPI_FOR_AM { float rm, rsm; rsv(PROW(ai, m), rm, rsm); const float q = rm / rsm;
#pragma unroll
            for (int bj = 0; bj < 2; ++bj)
#pragma unroll
                for (int n = 0; n < 2; ++n) acc[ai][bj][m][n] = acc[ai][bj][m][n] * q; }
    }
    __device__ __forceinline__ void operator()(Acc& acc, const pg8::Unit& u, int wr, int wc, int fr, int fq, LAS float* scr) const {
        bf16_t* xb = EB16(WS_XB); float* ssout = EF32(WS_SS);
        float part[2][4][1];
        EPI_FOR_AM { const int r = PROW(ai, m); float rm, rsm; rsv(r, rm, rsm); float s = 0.f;
#pragma unroll
            for (int bj = 0; bj < 2; ++bj) { const size_t off = (size_t)r * DM + 256 * u.pn + 128 * bj + 32 * wc + 8 * fq; f32x4 r0, r1; unpack8(*(const u32x4*)(xb + off), r0, r1);
                const f32x4 v0 = r0 + acc[ai][bj][m][0] * rsm, v1 = r1 + acc[ai][bj][m][1] * rsm; *(u32x4*)(xb + off) = pack8(v0, v1); s += dot4(v0) + dot4(v1); }
            part[ai][m][0] = s; EPI_FENCE; }
        xch_rows<1>(part, scr, wr, wc, fr, fq); if (wc == 0 && fq == 0) EPI_FOR_AM ssout[PROW(ai, m) * 4 + u.pn] = part[ai][m][0];
    }
};
struct PEpiIn {
    static constexpr bool PERM = true, HAS_MID = false; int tmid; unsigned char* ws;
    __device__ __forceinline__ void operator()(Acc& acc, const pg8::Unit& u, int wr, int wc, int fr, int fq, LAS float* scr) const {
        const float* ss = EF32(WS_SS); float* ssq = EF32(WS_SSQ); float* sskr = EF32(WS_SSKR); float* sskv = EF32(WS_SSKV);
        float part[2][4][2];
        EPI_FOR_AM { const int r = PROW(ai, m); const float rs = rs_from4(ss, r, 1.f / DM);
#pragma unroll
            for (int bj = 0; bj < 2; ++bj) { const f32x4 v0 = acc[ai][bj][m][0] * rs, v1 = acc[ai][bj][m][1] * rs; const int c = 128 * bj + 32 * wc + 8 * fq; bf16_t* dst = nullptr;
                if (u.pn == 0) dst = EB16(WS_CQ) + (size_t)r * QRANK + c;
                else if (u.pn == 1) { if (bj == 0) dst = EB16(WS_CQ) + (size_t)r * QRANK + 256 + c; else if (wc < 2) dst = EB16(WS_KR) + (size_t)r * 64 + (c - 128); }
                else if (u.pn == 2) dst = EB16(WS_CKV) + (size_t)r * KVRANK + c;
                else dst = EB16(WS_U) + (size_t)r * SSMW + 256 * (u.pn - 3) + c;
                if (dst) *(u32x4*)dst = pack8(v0, v1);
                part[ai][m][bj] = dot4(v0) + dot4(v1); } }
        if (u.pn < 3) {
            if (u.pn == 1 && wc >= 2) EPI_FOR_AM part[ai][m][1] = 0.f;
            xch_rows<2>(part, scr, wr, wc, fr, fq);
            if (wc == 0 && fq == 0) EPI_FOR_AM { const int r = PROW(ai, m);
                if (u.pn == 0) ssq[2 * r] = part[ai][m][0] + part[ai][m][1];
                else if (u.pn == 1) { ssq[2 * r + 1] = part[ai][m][0]; sskr[r] = part[ai][m][1]; }
                else sskv[r] = part[ai][m][0] + part[ai][m][1]; } }
    }
};
struct PEpiQ {
    static constexpr bool PERM = true, HAS_MID = false; int tmid; unsigned char* ws;
    __device__ __forceinline__ void operator()(Acc& acc, const pg8::Unit& u, int wr, int wc, int fr, int fq, LAS float* scr) const {
        const float* ssq = EF32(WS_SSQ); bf16_t* Q = EB16(WS_Q); const float2* tab = (const float2*)(ws + WS_ROPE);
        float part[2][4][1];
        EPI_FOR_AM { const int r = PROW(ai, m); const float rs = rsqrtf((ssq[2 * r] + ssq[2 * r + 1]) * (1.f / QRANK) + EPS); float s = 0.f;
#pragma unroll
            for (int bj = 0; bj < 2; ++bj)
#pragma unroll
                for (int n = 0; n < 2; ++n) { acc[ai][bj][m][n] = acc[ai][bj][m][n] * rs; s += dot4(acc[ai][bj][m][n]); }
            part[ai][m][0] = s; }
        xch_rows<1>(part, scr, wr, wc, fr, fq);
        const float* gq = EFI(13);
        EPI_FOR_AM { const int r = PROW(ai, m); const float rh = rsqrtf(part[ai][m][0] * (1.f / DQK) + EPS) * QSCALE;
            bf16_t* qp = Q + (size_t)r * (NH * DQK) + DQK * u.pn;
            if (wc < 3) { const f32x4 g0 = *(const f32x4*)(gq + 32 * wc + 8 * fq), g1 = *(const f32x4*)(gq + 32 * wc + 8 * fq + 4);
                *(u32x4*)(qp + 32 * wc + 8 * fq) = pack8(acc[ai][0][m][0] * g0 * rh, acc[ai][0][m][1] * g1 * rh);
                if (wc == 0) { const f32x4 h0 = *(const f32x4*)(gq + 96 + 8 * fq), h1 = *(const f32x4*)(gq + 96 + 8 * fq + 4);
                    *(u32x4*)(qp + 96 + 8 * fq) = pack8(acc[ai][1][m][0] * h0 * rh, acc[ai][1][m][1] * h1 * rh); }
            } else { f32x4 o1[2], o2[2];
#pragma unroll
                for (int n = 0; n < 2; ++n) { const f32x4 g1 = *(const f32x4*)(gq + 128 + 8 * fq + 4 * n), g2 = *(const f32x4*)(gq + 160 + 8 * fq + 4 * n);
#pragma unroll
                    for (int i = 0; i < 4; ++i) { const float2 cs = tab[(size_t)r * 32 + 8 * fq + 4 * n + i]; const float x1 = acc[ai][0][m][n][i] * g1[i] * rh, x2 = acc[ai][1][m][n][i] * g2[i] * rh;
                        o1[n][i] = x1 * cs.x - x2 * cs.y; o2[n][i] = x2 * cs.x + x1 * cs.y; } }
                *(u32x4*)(qp + 128 + 8 * fq) = pack8(o1[0], o1[1]); *(u32x4*)(qp + 160 + 8 * fq) = pack8(o2[0], o2[1]); } EPI_FENCE; }
    }
};
template <bool WITH_VT> struct PEpiKV {
    static constexpr bool PERM = true, HAS_MID = false; int tmid; unsigned char* ws;
    __device__ __forceinline__ void operator()(Acc& acc, const pg8::Unit& u, int wr, int wc, int fr, int fq, LAS float* scr) const {
        const float* sskv = EF32(WS_SSKV); const float* sskr = EF32(WS_SSKR); const float2* tab = (const float2*)(ws + WS_ROPE); const bf16_t* krb = EB16(WS_KR); bf16_t* K = EB16(WS_K); bf16_t* V = EB16(WS_V); bf16_t* Vt = EB16(WS_VT);
        float part[2][4][1];
        EPI_FOR_AM { const int r = PROW(ai, m); const float rs = rsqrtf(sskv[r] * (1.f / KVRANK) + EPS);
#pragma unroll
            for (int bj = 0; bj < 2; ++bj)
#pragma unroll
                for (int n = 0; n < 2; ++n) acc[ai][bj][m][n] = acc[ai][bj][m][n] * rs;
            part[ai][m][0] = dot4(acc[ai][0][m][0]) + dot4(acc[ai][0][m][1]); }
        xch_rows<1>(part, scr, wr, wc, fr, fq);
        const float* gk = EFI(14);
        EPI_FOR_AM { const int r = PROW(ai, m); const float rk = rsqrtf((part[ai][m][0] + sskr[r]) * (1.f / DQK) + EPS);
            bf16_t* kp = K + (size_t)r * (NH * DQK) + DQK * u.pn;
            const f32x4 g0 = *(const f32x4*)(gk + 32 * wc + 8 * fq), g1 = *(const f32x4*)(gk + 32 * wc + 8 * fq + 4);
            *(u32x4*)(kp + 32 * wc + 8 * fq) = pack8(acc[ai][0][m][0] * g0 * rk, acc[ai][0][m][1] * g1 * rk);
            *(u32x4*)(V + (size_t)r * 512 + 128 * u.pn + 32 * wc + 8 * fq) = pack8(acc[ai][1][m][0], acc[ai][1][m][1]);
            if (WITH_VT) { const int b = r / SEQ, t = r % SEQ;
#pragma unroll
                for (int n = 0; n < 2; ++n)
#pragma unroll
                    for (int i = 0; i < 4; ++i) Vt[((size_t)(b * NH + u.pn) * DV + 32 * wc + 8 * fq + 4 * n + i) * SEQ + t] = (bf16_t)f2bf(acc[ai][1][m][n][i]); }
            const int idx = 8 * wc + 2 * fq; const bf16_t* kr = krb + (size_t)r * 64;
            const unsigned a1 = *(const unsigned*)(kr + idx), a2 = *(const unsigned*)(kr + 32 + idx); const f32x4 cs = *(const f32x4*)((const float*)tab + ((size_t)r * 32 + idx) * 2);
            const float x1a = bf2f((unsigned short)(a1 & 0xffff)) * gk[128 + idx] * rk, x1b = bf2f((unsigned short)(a1 >> 16)) * gk[129 + idx] * rk;
            const float x2a = bf2f((unsigned short)(a2 & 0xffff)) * gk[160 + idx] * rk, x2b = bf2f((unsigned short)(a2 >> 16)) * gk[161 + idx] * rk;
            *(unsigned*)(kp + 128 + idx) = pk2(x1a * cs[0] - x2a * cs[1], x1b * cs[2] - x2b * cs[3]);
            *(unsigned*)(kp + 160 + idx) = pk2(x2a * cs[0] + x1a * cs[1], x2b * cs[2] + x1b * cs[3]); EPI_FENCE; }
    }
};
struct PEpiGlu {
    static constexpr bool PERM = true, HAS_MID = false; int tmid; unsigned char* ws;
    __device__ __forceinline__ void operator()(Acc& acc, const pg8::Unit& u, int wr, int wc, int fr, int fq, LAS float* scr) const {
        const bf16_t* G = EB16(WS_G); const float* bias = EFI(24); bf16_t* ycat = EB16(WS_YCAT); float* ssy = EF32(WS_SSY);
        float part[2][4][1];
        EPI_FOR_AM { const int r = PROW(ai, m); float s = 0.f;
#pragma unroll
            for (int bj = 0; bj < 2; ++bj) { const int col = 256 * u.pn + 128 * bj + 32 * wc + 8 * fq; const bf16x8 gb = *(const bf16x8*)(G + (size_t)r * SSMW + col); f32x4 o[2];
#pragma unroll
                for (int n = 0; n < 2; ++n) { const f32x4 bv = *(const f32x4*)(bias + col + 4 * n);
#pragma unroll
                    for (int i = 0; i < 4; ++i) { const float g = bf2f((unsigned short)gb[4 * n + i]); o[n][i] = g / (1.f + __expf(-(acc[ai][bj][m][n][i] + bv[i]))); } s += dot4(o[n]); }
                *(u32x4*)(ycat + (size_t)r * DM + 512 + col) = pack8(o[0], o[1]); }
            part[ai][m][0] = s; }
        xch_rows<1>(part, scr, wr, wc, fr, fq); if (wc == 0 && fq == 0) EPI_FOR_AM ssy[PROW(ai, m) * 8 + 4 + u.pn] = part[ai][m][0];
    }
};
struct PEpiXQ {
    static constexpr bool PERM = true, HAS_MID = false; int tmid; unsigned char* ws;
    __device__ __forceinline__ void operator()(Acc& acc, const pg8::Unit& u, int wr, int wc, int fr, int fq, LAS float* scr) const {
        const float* ss = EF32(WS_SS); bf16_t* XQ = EB16(WS_XQ);
        float part[2][4][2];
        EPI_FOR_AM { const int r = PROW(ai, m); const float rs = rs_from4(ss, r, 1.f / DM);
#pragma unroll
            for (int bj = 0; bj < 2; ++bj) { acc[ai][bj][m][0] = acc[ai][bj][m][0] * rs; acc[ai][bj][m][1] = acc[ai][bj][m][1] * rs; part[ai][m][bj] = dot4(acc[ai][bj][m][0]) + dot4(acc[ai][bj][m][1]); } }
        xch_rows<2>(part, scr, wr, wc, fr, fq);
        const float* gq = EFI(32);
        const f32x4 g0 = *(const f32x4*)(gq + 32 * wc + 8 * fq), g1 = *(const f32x4*)(gq + 32 * wc + 8 * fq + 4);
        EPI_FOR_AM { const int r = PROW(ai, m);
#pragma unroll
            for (int bj = 0; bj < 2; ++bj) { const float rh = rsqrtf(part[ai][m][bj] * (1.f / 128) + EPS) * XSCALE;
                *(u32x4*)(XQ + (size_t)r * 512 + 256 * u.pn + 128 * bj + 32 * wc + 8 * fq) = pack8(acc[ai][bj][m][0] * g0 * rh, acc[ai][bj][m][1] * g1 * rh); } }
    }
};
template <bool WITH_VT> struct PEpiMemKV {
    static constexpr bool PERM = true, HAS_MID = false; int tmid; unsigned char* ws;
    __device__ __forceinline__ void operator()(Acc& acc, const pg8::Unit& u, int wr, int wc, int fr, int fq, LAS float* scr) const {
        const float* ss = EF32(WS_SSMEM); bf16_t* XK = EB16(WS_XK); bf16_t* XV = EB16(WS_XV); bf16_t* XVt = EB16(WS_XVT);
        float part[2][4][2];
        EPI_FOR_AM { const int r = PROW(ai, m); const float rs = rs_from4(ss, r, 1.f / DM);
#pragma unroll
            for (int bj = 0; bj < 2; ++bj) { acc[ai][bj][m][0] = acc[ai][bj][m][0] * rs; acc[ai][bj][m][1] = acc[ai][bj][m][1] * rs; part[ai][m][bj] = dot4(acc[ai][bj][m][0]) + dot4(acc[ai][bj][m][1]); } }
        if (u.pn < 2) {
            xch_rows<2>(part, scr, wr, wc, fr, fq);
            const float* gk = EFI(33);
            const f32x4 g0 = *(const f32x4*)(gk + 32 * wc + 8 * fq), g1 = *(const f32x4*)(gk + 32 * wc + 8 * fq + 4);
            EPI_FOR_AM { const int r = PROW(ai, m);
#pragma unroll
                for (int bj = 0; bj < 2; ++bj) { const float rh = rsqrtf(part[ai][m][bj] * (1.f / 128) + EPS);
                    *(u32x4*)(XK + (size_t)r * 512 + 256 * u.pn + 128 * bj + 32 * wc + 8 * fq) = pack8(acc[ai][bj][m][0] * g0 * rh, acc[ai][bj][m][1] * g1 * rh); } }
        } else {
            EPI_FOR_AM { const int r = PROW(ai, m), b = r / MEML, mm = r % MEML;
#pragma unroll
                for (int bj = 0; bj < 2; ++bj) { const int c0 = 256 * (u.pn - 2) + 128 * bj + 32 * wc + 8 * fq;
                    *(u32x4*)(XV + (size_t)r * 512 + c0) = pack8(acc[ai][bj][m][0], acc[ai][bj][m][1]);
                    if (WITH_VT) {
#pragma unroll
                        for (int n = 0; n < 2; ++n)
#pragma unroll
                            for (int i = 0; i < 4; ++i) { const int c = c0 + 4 * n + i, h = c >> 7, d = c & 127; XVt[((size_t)(b * NH + h) * 128 + d) * MEML + mm] = (bf16_t)f2bf(acc[ai][bj][m][n][i]); } } } }
        }
    }
};
template <int DK, int DVv, bool CAUSAL> __device__ __forceinline__ void attn_simple_vb(int qblk, int bh, int vtid, const bf16_t* Q, const bf16_t* K, const bf16_t* Vt, bf16_t* O, float* ssout, int ldq, int ldk, int ldo, int ssld, int Sq, int Skv) {
    const int lane = vtid & 63, w = vtid >> 6, c = lane & 31, hi = lane >> 5;
    const int b = bh / NH, h = bh % NH, q0 = 128 * qblk + 32 * w;
    const bf16_t* qp = Q + (size_t)(b * Sq + q0 + c) * ldq + h * DK + 8 * hi;
    f32x16 o[DVv / 32];
#pragma unroll
    for (int d = 0; d < DVv / 32; ++d)
#pragma unroll
        for (int r = 0; r < 16; ++r) o[d][r] = 0.f;
    float m = -1e30f, l = 0.f;
    const int ntile = CAUSAL ? (q0 / 32 + 1) : (Skv / 32);
    const bf16_t* kbase = K + (size_t)(b * Skv) * ldk + h * DK + 8 * hi;
    const bf16_t* vbase = Vt + (size_t)bh * DVv * Skv;
    for (int tt = 0; tt < ntile; ++tt) {
        const int key0 = 32 * tt;
        f32x16 p;
#pragma unroll
        for (int r = 0; r < 16; ++r) p[r] = 0.f;
        const bf16_t* kp = kbase + (size_t)(key0 + c) * ldk;
#pragma unroll
        for (int s = 0; s < DK / 16; ++s) { const bf16x8 kf = *(const bf16x8*)(kp + 16 * s); const bf16x8 qf = *(const bf16x8*)(qp + 16 * s); p = __builtin_amdgcn_mfma_f32_32x32x16_bf16(kf, qf, p, 0, 0, 0); }
        if (CAUSAL && tt == ntile - 1) {
#pragma unroll
            for (int r = 0; r < 16; ++r) { const int key = key0 + (r & 3) + 8 * (r >> 2) + 4 * hi; if (key > q0 + c) p[r] = -INFINITY; }
        }
        float tm = p[0];
#pragma unroll
        for (int r = 1; r < 16; ++r) tm = fmaxf(tm, p[r]);
        tm = fmaxf(tm, __shfl_xor(tm, 32));
        const float mn = fmaxf(m, tm), alpha = exp2f(m - mn); m = mn;
        float ps = 0.f;
#pragma unroll
        for (int r = 0; r < 16; ++r) { p[r] = exp2f(p[r] - mn); ps += p[r]; }
        l = l * alpha + ps;
        bf16x8 pf[2];
#pragma unroll
        for (int s = 0; s < 2; ++s)
#pragma unroll
            for (int j = 0; j < 8; ++j) pf[s][j] = (short)f2bf(p[8 * s + j]);
#pragma unroll
        for (int d = 0; d < DVv / 32; ++d) {
#pragma unroll
            for (int r = 0; r < 16; ++r) o[d][r] *= alpha;
            const bf16_t* vp = vbase + (size_t)(32 * d + c) * Skv + key0 + 4 * hi;
#pragma unroll
            for (int s = 0; s < 2; ++s) { const bf16x4 v0 = *(const bf16x4*)(vp + 16 * s), v1 = *(const bf16x4*)(vp + 16 * s + 8);
                const bf16x8 vf = {v0[0], v0[1], v0[2], v0[3], v1[0], v1[1], v1[2], v1[3]};
                o[d] = __builtin_amdgcn_mfma_f32_32x32x16_bf16(vf, pf[s], o[d], 0, 0, 0); }
        }
    }
    l += __shfl_xor(l, 32); const float il = 1.f / l; float ss = 0.f;
    bf16_t* op = O + (size_t)(b * Sq + q0 + c) * ldo + h * DVv;
#pragma unroll
    for (int d = 0; d < DVv / 32; ++d)
#pragma unroll
        for (int g = 0; g < 4; ++g) { f32x4 v = {o[d][4 * g] * il, o[d][4 * g + 1] * il, o[d][4 * g + 2] * il, o[d][4 * g + 3] * il}; ss += dot4(v); st_bf4(op + 32 * d + 8 * g + 4 * hi, v); }
    if (ssout) { ss += __shfl_xor(ss, 32); if (hi == 0) ssout[(size_t)(b * Sq + q0 + c) * ssld + h] = ss; }
}

__device__ __forceinline__ void ssm_seq_wave(int bg, int p, const bf16_t* proj, const float* a_re, const float* a_im, const float* log_dt, const float* b_re, const float* b_im, const float* c_re, const float* c_im, const float* dd, bf16_t* G) {
    const int b = bg / SG, g = bg % SG;
    const float lr = a_re[g * SP + p], li = a_im[g * SP + p], dt = expf(log_dt[g]);
    const float decay = expf(lr * dt); float sn, cs; sincosf(li * dt, &sn, &cs);
    const float ar = decay * cs, ai = decay * sn, den = lr * lr + li * li, nr = ar - 1.f;
    const float cr = (nr * lr + ai * li) / den, ci = (ai * lr - nr * li) / den;
    float bbr[16], bbi[16], ccr[16], cci[16];
#pragma unroll
    for (int h = 0; h < 16; ++h) { const float br = b_re[(g * SP + p) * 16 + h], bi = b_im[(g * SP + p) * 16 + h]; bbr[h] = cr * br - ci * bi; bbi[h] = cr * bi + ci * br;
        ccr[h] = c_re[(g * 16 + h) * SP + p]; cci[h] = c_im[(g * 16 + h) * SP + p]; }
    const float dmy = dd[g * 16 + (p & 15)];
    float xr = 0.f, xi = 0.f;
    for (int t = 0; t < SEQ; ++t) {
        const bf16_t* up = proj + (size_t)(b * SEQ + t) * SSMW + g * 16;
        const bf16x8 u0 = *(const bf16x8*)up, u1 = *(const bf16x8*)(up + 8);
        float u[16];
#pragma unroll
        for (int h = 0; h < 8; ++h) { u[h] = bf2f((unsigned short)u0[h]); u[8 + h] = bf2f((unsigned short)u1[h]); }
        float bur = 0.f, bui = 0.f;
#pragma unroll
        for (int h = 0; h < 16; ++h) { bur += bbr[h] * u[h]; bui += bbi[h] * u[h]; }
        const float nxr = ar * xr - ai * xi + bur, nxi = ar * xi + ai * xr + bui; xr = nxr; xi = nxi;
        float ymine = 0.f;
#pragma unroll
        for (int h = 0; h < 16; ++h) { float v = wave_sum(xr * ccr[h] - xi * cci[h]); if ((p & 15) == h) ymine = v + dmy * u[h]; }
        if (p < 16) { const float y = ymine; const float gl = 0.5f * y * (1.f + tanhf(0.7978845608028654f * (y + 0.044715f * y * y * y)));
            G[(size_t)(b * SEQ + t) * SSMW + g * 16 + p] = (bf16_t)f2bf(gl); }
    }
}
namespace att {
typedef short v4i16_t __attribute__((ext_vector_type(4)));
__device__ __forceinline__ unsigned voff_b(unsigned row, unsigned ch) { return 256u * row + 16u * (ch ^ (((row & 3u) << 2) | ((row >> 2) & 3u))); }
template <int DK> struct Cfg { static constexpr int KB = 64 * DK * 2, VB = 64 * 128 * 2, STG = KB + VB, NPK = KB / 1024, NP = STG / 1024, NPW = NP / 8; };
template <int DK> __device__ __forceinline__ void stage_tile(LAS unsigned char* stg, const bf16_t* Kg, int ldk, const bf16_t* Vg, int ldv, int kt, int wid, int lane) {
    typedef Cfg<DK> C;
#pragma unroll
    for (int i = 0; i < C::NPW; ++i) { const int pi = wid * C::NPW + i;
        const bf16_t* src;
        if (pi < C::NPK) src = Kg + (size_t)(64 * kt + lane) * ldk + 8 * pi;
        else { const unsigned pv = pi - C::NPK, row = 4 * pv + (lane >> 4), chs = lane & 15, ch = chs ^ (((row & 3u) << 2) | ((row >> 2) & 3u)); src = Vg + (size_t)(64 * kt + row) * ldv + 8 * ch; }
        __builtin_amdgcn_global_load_lds((const unsigned*)src, (LAS unsigned*)(stg + pi * 1024), 16, 0, 0); }
}
template <int DK, bool CAUSAL> __device__ __forceinline__ void attn_wg(int tid, LAS unsigned char* ring, const bf16_t* Qbh, int ldq, const bf16_t* Kbh, int ldk, const bf16_t* Vbh, int ldv, bf16_t* Obh, int ldo, float* ssout, int ssld, int qrow_w, int nt_w, int nt_max) {
    typedef Cfg<DK> C; constexpr float THR = 8.f;
    const int lane = tid & 63, wid = __builtin_amdgcn_readfirstlane(tid >> 6), c = lane & 31, hi = lane >> 5;
    stage_tile<DK>(ring, Kbh, ldk, Vbh, ldv, 0, wid, lane);
    if (nt_max > 1) stage_tile<DK>(ring + C::STG, Kbh, ldk, Vbh, ldv, 1, wid, lane);
    bf16x8 qf[DK / 16];
    { const bf16_t* qp = Qbh + (size_t)(qrow_w + c) * ldq + 8 * hi;
#pragma unroll
      for (int s = 0; s < DK / 16; ++s) qf[s] = *(const bf16x8*)(qp + 16 * s); }
    f32x16 o[4];
#pragma unroll
    for (int d = 0; d < 4; ++d)
#pragma unroll
        for (int r = 0; r < 16; ++r) o[d][r] = 0.f;
    float m = -1e30f, l = 0.f;
    const int qrow = qrow_w + c;
    const unsigned q4 = (lane & 15) >> 2, p4 = lane & 3, blk = (lane >> 4) & 1, cl = 2 * blk + (p4 >> 1);
    const unsigned vbase0 = 256u * (4 * hi + q4) + 16u * (cl ^ (unsigned)hi) + 8u * (p4 & 1), vbase1 = 2048u + 256u * (4 * hi + q4) + 16u * (cl ^ (2u + (unsigned)hi)) + 8u * (p4 & 1);
    f32x16 zero16;
#pragma unroll
    for (int r = 0; r < 16; ++r) zero16[r] = 0.f;
    int st = 0;
    for (int t = 0; t < nt_max; ++t) {
        if (t + 1 < nt_max) asm volatile("s_waitcnt vmcnt(%0)" :: "n"(C::NPW) : "memory"); else asm volatile("s_waitcnt vmcnt(0)" ::: "memory");
        asm volatile("s_waitcnt lgkmcnt(0)" ::: "memory"); __builtin_amdgcn_s_barrier(); asm volatile("" ::: "memory");
        if (t + 2 < nt_max) { const int st2 = (st == 0) ? 2 : st - 1; stage_tile<DK>(ring + st2 * C::STG, Kbh, ldk, Vbh, ldv, t + 2, wid, lane); }
        if (t < nt_w) {
            LAS unsigned char* stg = ring + st * C::STG;
            f32x16 p0, p1;
            { const LAS unsigned char* kp = stg + hi * 1024 + c * 16; bf16x8 ka[4], kb[4];
#define ATT_KLD(dst, s) do { dst[0] = *(const LAS bf16x8*)(kp + (s) * 2048); dst[1] = *(const LAS bf16x8*)(kp + (s) * 2048 + 512); dst[2] = *(const LAS bf16x8*)(kp + (s) * 2048 + 2048); dst[3] = *(const LAS bf16x8*)(kp + (s) * 2048 + 2560); } while (0)
#define ATT_MM(k, s) do { p0 = __builtin_amdgcn_mfma_f32_32x32x16_bf16(k[0], qf[s], p0, 0, 0, 0); p1 = __builtin_amdgcn_mfma_f32_32x32x16_bf16(k[1], qf[s], p1, 0, 0, 0); \
                          p0 = __builtin_amdgcn_mfma_f32_32x32x16_bf16(k[2], qf[(s) + 1], p0, 0, 0, 0); p1 = __builtin_amdgcn_mfma_f32_32x32x16_bf16(k[3], qf[(s) + 1], p1, 0, 0, 0); } while (0)
#define ATT_SB __builtin_amdgcn_sched_barrier(0)
              ATT_KLD(ka, 0); ATT_SB; ATT_KLD(kb, 2); ATT_SB;
              p0 = __builtin_amdgcn_mfma_f32_32x32x16_bf16(ka[0], qf[0], zero16, 0, 0, 0); p1 = __builtin_amdgcn_mfma_f32_32x32x16_bf16(ka[1], qf[0], zero16, 0, 0, 0);
              p0 = __builtin_amdgcn_mfma_f32_32x32x16_bf16(ka[2], qf[1], p0, 0, 0, 0); p1 = __builtin_amdgcn_mfma_f32_32x32x16_bf16(ka[3], qf[1], p1, 0, 0, 0); ATT_SB;
              ATT_KLD(ka, 4); ATT_SB; ATT_MM(kb, 2); ATT_SB;
              ATT_KLD(kb, 6); ATT_SB; ATT_MM(ka, 4); ATT_SB;
              if (DK == 192) { ATT_KLD(ka, 8); ATT_SB; ATT_MM(kb, 6); ATT_SB; ATT_KLD(kb, 10); ATT_SB; ATT_MM(ka, 8); ATT_SB; ATT_MM(kb, 10); ATT_SB; }
              else { ATT_MM(kb, 6); ATT_SB; }
            }
            if (CAUSAL && (64 * t + 63 > qrow_w)) {
#pragma unroll
                for (int r = 0; r < 16; ++r) { const int key = 64 * t + (r & 3) + 8 * (r >> 2) + 4 * hi; if (key > qrow) p0[r] = -INFINITY; if (key + 32 > qrow) p1[r] = -INFINITY; } }
            float tm = fmaxf(p0[0], p1[0]);
#pragma unroll
            for (int r = 1; r < 16; ++r) tm = fmaxf(tm, fmaxf(p0[r], p1[r]));
            tm = fmaxf(tm, __shfl_xor(tm, 32));
            if (__any(tm > m + THR)) {
                const float mn = fmaxf(m, tm), alpha = __builtin_amdgcn_exp2f(m - mn); m = mn; l *= alpha;
#pragma unroll
                for (int d0 = 0; d0 < 4; ++d0)
#pragma unroll
                    for (int r = 0; r < 16; ++r) o[d0][r] *= alpha; }
            float ps = 0.f;
#pragma unroll
            for (int r = 0; r < 16; ++r) { p0[r] = __builtin_amdgcn_exp2f(p0[r] - m); p1[r] = __builtin_amdgcn_exp2f(p1[r] - m); ps += p0[r] + p1[r]; }
            l += ps;
            bf16x8 pf[4];
#pragma unroll
            for (int ks = 0; ks < 4; ++ks) { u32x4 w;
                if (ks < 2) { w.x = pk2(p0[8 * ks], p0[8 * ks + 1]); w.y = pk2(p0[8 * ks + 2], p0[8 * ks + 3]); w.z = pk2(p0[8 * ks + 4], p0[8 * ks + 5]); w.w = pk2(p0[8 * ks + 6], p0[8 * ks + 7]); }
                else { const int b = 8 * (ks - 2); w.x = pk2(p1[b], p1[b + 1]); w.y = pk2(p1[b + 2], p1[b + 3]); w.z = pk2(p1[b + 4], p1[b + 5]); w.w = pk2(p1[b + 6], p1[b + 7]); }
                pf[ks] = __builtin_bit_cast(bf16x8, w); }
            { const LAS unsigned char* vt = stg + C::KB; v4i16_t va[8], vb[8];
#define ATT_VLD(dst, d0) do { _Pragma("unroll") for (int ks = 0; ks < 4; ++ks) { \
                  dst[2 * ks] = __builtin_amdgcn_ds_read_tr16_b64_v4i16((LAS v4i16_t*)(vt + vbase0 + 64u * ((unsigned)(d0) ^ q4) + 4096u * ks)); \
                  dst[2 * ks + 1] = __builtin_amdgcn_ds_read_tr16_b64_v4i16((LAS v4i16_t*)(vt + vbase1 + 64u * ((unsigned)(d0) ^ q4) + 4096u * ks)); } } while (0)
#define ATT_PV(v, d0) do { _Pragma("unroll") for (int ks = 0; ks < 4; ++ks) { const bf16x8 vf = {v[2 * ks][0], v[2 * ks][1], v[2 * ks][2], v[2 * ks][3], v[2 * ks + 1][0], v[2 * ks + 1][1], v[2 * ks + 1][2], v[2 * ks + 1][3]}; \
                  o[d0] = __builtin_amdgcn_mfma_f32_32x32x16_bf16(vf, pf[ks], o[d0], 0, 0, 0); } } while (0)
              ATT_VLD(va, 0); ATT_SB; ATT_VLD(vb, 1); ATT_SB; ATT_PV(va, 0); ATT_SB; ATT_VLD(va, 2); ATT_SB; ATT_PV(vb, 1); ATT_SB; ATT_VLD(vb, 3); ATT_SB; ATT_PV(va, 2); ATT_SB; ATT_PV(vb, 3); ATT_SB;
            }
        }
        st = (st == 2) ? 0 : st + 1;
    }
    l += __shfl_xor(l, 32); const float il = 1.f / l; float ss = 0.f;
    bf16_t* op = Obh + (size_t)(qrow_w + c) * ldo;
#pragma unroll
    for (int d = 0; d < 4; ++d)
#pragma unroll
        for (int g = 0; g < 4; ++g) { f32x4 v = {o[d][4 * g] * il, o[d][4 * g + 1] * il, o[d][4 * g + 2] * il, o[d][4 * g + 3] * il}; ss += dot4(v); st_bf4(op + 32 * d + 8 * g + 4 * hi, v); }
    if (ssout) { ss += __shfl_xor(ss, 32); if (hi == 0) ssout[(size_t)(qrow_w + c) * ssld] = ss; }
    asm volatile("s_waitcnt lgkmcnt(0)" ::: "memory"); __builtin_amdgcn_s_barrier(); asm volatile("" ::: "memory");
}
}

constexpr int NTHREADS_C = 512;
constexpr int SSM_UL = 0, SSM_UL_STRIDE = 1040, SSM_KTL = 66560, SSM_SL = SSM_KTL + 16384, SSM_XPL = 140288, SSM_XP_STRIDE = 272;
__device__ __forceinline__ void pow_entry(float lr, float li, double dt, int n, float& re, float& im) {
    double a = (double)li * dt * (double)n; a -= 6.283185307179586 * rint(a * 0.15915494309189535); float sn, cs; __sincosf((float)a, &sn, &cs); const float mag = __expf((float)((double)lr * dt * (double)n)); re = mag * cs; im = mag * sn;
}
__device__ __forceinline__ void ssm_tables_item(int item, int tid, unsigned char* ldsb, unsigned char* ws) {
    const int g = item >> 3, part = item & 7;
    float2* pw = (float2*)ldsb;
    float2* bb = pw + 64 * 33;
    float2* cc = bb + 64 * 16;
    const float* a_re = EFI(15); const float* a_im = EFI(16); const float* log_dt = EFI(17);
    const double dt = exp((double)log_dt[g]);
    for (int e = tid; e < 64 * 33; e += NTHREADS_C) { const int p = e / 33, n = e % 33; float re, im; pow_entry(a_re[g * SP + p], a_im[g * SP + p], dt, n, re, im); pw[e] = make_float2(re, im); }
    { const float* b_re = EFI(18); const float* b_im = EFI(19);
      for (int e = tid; e < 64 * 16; e += NTHREADS_C) { const int p = e >> 4, h = e & 15; const float lr = a_re[g * SP + p], li = a_im[g * SP + p];
        float ar, ai; pow_entry(lr, li, dt, 1, ar, ai); const float den = lr * lr + li * li, nr = ar - 1.f;
        const float cr = (nr * lr + ai * li) / den, ci = (ai * lr - nr * li) / den; const float br = b_re[(g * SP + p) * 16 + h], bi = b_im[(g * SP + p) * 16 + h];
        bb[e] = make_float2(cr * br - ci * bi, cr * bi + ci * br); } }
    { const float* c_re = EFI(20); const float* c_im = EFI(21);
      for (int e = tid; e < 16 * 64; e += NTHREADS_C) cc[e] = make_float2(c_re[g * 16 * SP + e], c_im[g * 16 * SP + e]); }
    __syncthreads();
    if (part < 4) {
        const int hh = tid & 255, h = hh >> 4, h2 = hh & 15, tau0 = 8 * part + 4 * (tid >> 8);
        float acc[4];
#pragma unroll
        for (int j = 0; j < 4; ++j) acc[j] = 0.f;
        for (int p = 0; p < 64; ++p) { const float2 b = bb[p * 16 + h2], cv = cc[h * 64 + p];
#pragma unroll
            for (int j = 0; j < 4; ++j) { const float2 w = pw[p * 33 + tau0 + j]; const float wr = w.x * b.x - w.y * b.y, wi = w.x * b.y + w.y * b.x; acc[j] += cv.x * wr - cv.y * wi; } }
        if (tau0 == 0 && h == h2) acc[0] += EFI(22)[g * 16 + h];
        bf16_t* KT = EB16(WS_KT) + (size_t)g * 8192;
#pragma unroll
        for (int j = 0; j < 4; ++j) KT[((tau0 + j) * 16 + h) * 16 + h2] = (bf16_t)f2bf(acc[j]);
    } else if (part < 6) {
        bf16_t* BsT = EB16(WS_BST) + (size_t)g * 65536; const int k = tid, s = k >> 4, h2 = k & 15;
        for (int n = 64 * (part - 4); n < 64 * (part - 3); ++n) { const int p = n & 63; const float2 w = pw[p * 33 + 31 - s], b = bb[p * 16 + h2];
            const float v = (n < 64) ? (w.x * b.x - w.y * b.y) : (w.x * b.y + w.y * b.x); BsT[n * 512 + k] = (bf16_t)f2bf(v); }
    } else {
        bf16_t* CmT = EB16(WS_CMT) + (size_t)g * 65536; const int k = tid & 127, p = k & 63;
        for (int j = 0; j < 64; ++j) { const int n = 256 * (part - 6) + (tid >> 7) + 4 * j, t = n >> 4, h = n & 15; const float2 w = pw[p * 33 + t + 1], cv = cc[h * 64 + p];
            const float v = (k < 64) ? (cv.x * w.x - cv.y * w.y) : -(cv.x * w.y + cv.y * w.x); CmT[n * 128 + k] = (bf16_t)f2bf(v); }
    }
    __syncthreads();
}
__device__ __forceinline__ float gelu_tanh(float y) { const float z = 0.7978845608028654f * (y + 0.044715f * y * y * y); return y / (1.f + __expf(-2.f * z)); }
__device__ __forceinline__ void ssm_unit(int bg, int tid, LAS unsigned char* L, unsigned char* ws) {
    const int b = bg >> 5, g = bg & 31, lane = tid & 63, wid = __builtin_amdgcn_readfirstlane(tid >> 6), fr = lane & 15, fq = lane >> 4;
    const bf16_t* U = EB16(WS_U) + (size_t)b * SEQ * SSMW + g * 16;
    const bf16_t* BsT = EB16(WS_BST) + (size_t)g * 65536; const bf16_t* CmT = EB16(WS_CMT) + (size_t)g * 65536;
    bf16_t* Gout = EB16(WS_G) + (size_t)b * SEQ * SSMW + g * 16;
    { const u32x4* src = (const u32x4*)(EB16(WS_KT) + (size_t)g * 8192); LAS u32x4* dst = (LAS u32x4*)(L + SSM_KTL); dst[tid] = src[tid]; dst[tid + NTHREADS_C] = src[tid + NTHREADS_C]; }
    float xr = 0.f, xi = 0.f, Ar = 0.f, Ai = 0.f;
    if (wid == 0) pow_entry(EFI(15)[g * SP + lane], EFI(16)[g * SP + lane], exp((double)EFI(17)[g]), 32, Ar, Ai);
    const int tl0 = wid, tl1 = 15 - wid, tl2 = 16 + wid, tl3 = 31 - wid;
#define SSM_T(tt) ((tt) == 0 ? tl0 : (tt) == 1 ? tl1 : (tt) == 2 ? tl2 : tl3)
#pragma unroll 1
    for (int hf = 0; hf < 2; ++hf) {
#pragma unroll
        for (int i = 0; i < 4; ++i) { const int row = tid + NTHREADS_C * i; const u32x4* s = (const u32x4*)(U + (size_t)(hf * 2048 + row) * SSMW); LAS unsigned char* d = L + SSM_UL + (row >> 5) * SSM_UL_STRIDE + (row & 31) * 32;
            const u32x4 v0 = s[0], v1 = s[1]; *(LAS u32x4*)d = v0; *(LAS u32x4*)(d + 16) = v1; }
        __syncthreads();
        { f32x4 sacc[4];
#pragma unroll
          for (int mf = 0; mf < 4; ++mf) sacc[mf] = (f32x4){0.f, 0.f, 0.f, 0.f};
#pragma unroll 1
          for (int ks = 0; ks < 16; ++ks) { const bf16x8 bfr = *(const bf16x8*)(BsT + (size_t)(16 * wid + fr) * 512 + 32 * ks + 8 * fq);
#pragma unroll
              for (int mf = 0; mf < 4; ++mf) { const bf16x8 afr = *(const LAS bf16x8*)(L + SSM_UL + (16 * mf + fr) * SSM_UL_STRIDE + (2 * ks + (fq >> 1)) * 32 + (fq & 1) * 16);
                  sacc[mf] = __builtin_amdgcn_mfma_f32_16x16x32_bf16(bfr, afr, sacc[mf], 0, 0, 0); } }
#pragma unroll
          for (int mf = 0; mf < 4; ++mf) *(LAS f32x4*)(L + SSM_SL + ((16 * mf + fr) * 128 + 16 * wid + 4 * fq) * 4) = sacc[mf]; }
        __syncthreads();
        if (wid == 0) { const LAS float* S = (const LAS float*)(L + SSM_SL);
#pragma unroll 2
            for (int c = 0; c < 64; ++c) { LAS bf16_t* xp = (LAS bf16_t*)(L + SSM_XPL + c * SSM_XP_STRIDE); xp[lane] = (bf16_t)f2bf(xr); xp[64 + lane] = (bf16_t)f2bf(xi);
                const float sr = S[c * 128 + lane], si = S[c * 128 + 64 + lane]; const float nr = Ar * xr - Ai * xi + sr, ni = Ar * xi + Ai * xr + si; xr = nr; xi = ni; } }
        f32x4 acc[4][4];
#pragma unroll
        for (int tt = 0; tt < 4; ++tt)
#pragma unroll
            for (int mf = 0; mf < 4; ++mf) acc[tt][mf] = (f32x4){0.f, 0.f, 0.f, 0.f};
#pragma unroll 1
        for (int ks = 0; ks < 16; ++ks) { if (2 * ks > tl3) break;
            bf16x8 afr[4];
#pragma unroll
            for (int mf = 0; mf < 4; ++mf) afr[mf] = *(const LAS bf16x8*)(L + SSM_UL + (16 * mf + fr) * SSM_UL_STRIDE + (2 * ks + (fq >> 1)) * 32 + (fq & 1) * 16);
#pragma unroll
            for (int tt = 0; tt < 4; ++tt) { const int t = SSM_T(tt);
                if (2 * ks <= t) { const int tau = t - 2 * ks - (fq >> 1); bf16x8 bfr = {0, 0, 0, 0, 0, 0, 0, 0};
                    if (tau >= 0) bfr = *(const LAS bf16x8*)(L + SSM_KTL + ((tau * 16 + fr) * 16 + 8 * (fq & 1)) * 2);
#pragma unroll
                    for (int mf = 0; mf < 4; ++mf) acc[tt][mf] = __builtin_amdgcn_mfma_f32_16x16x32_bf16(bfr, afr[mf], acc[tt][mf], 0, 0, 0); } } }
        __syncthreads();
#pragma unroll 1
        for (int ks = 0; ks < 4; ++ks) { bf16x8 afr[4];
#pragma unroll
            for (int mf = 0; mf < 4; ++mf) afr[mf] = *(const LAS bf16x8*)(L + SSM_XPL + (16 * mf + fr) * SSM_XP_STRIDE + (32 * ks + 8 * fq) * 2);
#pragma unroll
            for (int tt = 0; tt < 4; ++tt) { const int t = SSM_T(tt); const bf16x8 bfr = *(const bf16x8*)(CmT + (size_t)(t * 16 + fr) * 128 + 32 * ks + 8 * fq);
#pragma unroll
                for (int mf = 0; mf < 4; ++mf) acc[tt][mf] = __builtin_amdgcn_mfma_f32_16x16x32_bf16(bfr, afr[mf], acc[tt][mf], 0, 0, 0); } }
#pragma unroll
        for (int tt = 0; tt < 4; ++tt) { const int t = SSM_T(tt);
#pragma unroll
            for (int mf = 0; mf < 4; ++mf) { f32x4 v = acc[tt][mf];
#pragma unroll
                for (int i = 0; i < 4; ++i) v[i] = gelu_tanh(v[i]);
                st_bf4(Gout + (size_t)(hf * 2048 + (16 * mf + fr) * 32 + t) * SSMW + 4 * fq, v); } }
        __syncthreads();
    }
#undef SSM_T
}

constexpr int NWAVES = 8, NTHREADS = NWAVES * 64;
constexpr int RING_BYTES = 131072, LDSCTL_OFF = RING_BYTES, MISC_OFF = LDSCTL_OFF + 320, SCR_OFF = RING_BYTES + 1024, LDS_BYTES = 163840;
constexpr size_t CTL_ZERO_BYTES = 64 * 1024;
constexpr int CW_BAR = 1024;
#define RLX_AGENT __ATOMIC_RELAXED, __HIP_MEMORY_SCOPE_AGENT
#define XB_TMO      128
#define XB_XCNT(j)  (256  + 64 * (j))
#define XB_XSUB(j)  (1280 + 64 * (j))
#define XB_XGEN(j)  (2304 + 64 * (j))
#define XB_TOP      3328
#define XB_TOPGEN   3392
#define XCD_BAR_WORDS 3456
#define XB_SPIN_CAP (1u << 24)
static_assert((CW_BAR + XCD_BAR_WORDS) * 4 <= (int)CTL_ZERO_BYTES, "barrier words inside the memset region");
__device__ __forceinline__ unsigned xb_ld(unsigned* p)              { return __hip_atomic_load(p, __ATOMIC_RELAXED, __HIP_MEMORY_SCOPE_AGENT); }
__device__ __forceinline__ unsigned xb_add(unsigned* p, unsigned v) { return __hip_atomic_fetch_add(p, v, __ATOMIC_RELAXED, __HIP_MEMORY_SCOPE_AGENT); }
__device__ __forceinline__ unsigned xb_xcc_id() { return (unsigned)__builtin_amdgcn_s_getreg((3 << 11) | 20) & 0xFu; }
#define XB_SPIN(cond, bar) do { unsigned _sp = 0; while (cond) { __builtin_amdgcn_s_sleep(1); \
    if ((++_sp & 255u) == 0u) { if (xb_ld(&(bar)[XB_TMO])) break; if (_sp > XB_SPIN_CAP) { atomicAdd(&(bar)[XB_TMO], 1u); break; } } } } while (0)
struct XcdBarrier { unsigned* bar; unsigned x; volatile LAS unsigned* st; };
__device__ __forceinline__ XcdBarrier xcd_barrier_post(unsigned* bar, volatile LAS unsigned* st) {
    XcdBarrier b; b.bar = bar; b.x = xb_xcc_id(); b.st = st;
    if (threadIdx.x == 0) (void)xb_add(&bar[XB_XCNT(b.x)], 1u);
    return b;
}
__device__ __forceinline__ void xcd_barrier_complete(unsigned* bar, unsigned x, unsigned& nloc, unsigned& nx) {
    const unsigned G = gridDim.x * gridDim.y * gridDim.z;
    unsigned sum, cnt, mine, sp = 0u;
    for (;;) {
        sum = 0u; cnt = 0u; mine = 0u;
#pragma unroll
        for (unsigned j = 0; j < 16; ++j) { const unsigned c = xb_ld(&bar[XB_XCNT(j)]); sum += c; cnt += (c > 0u) ? 1u : 0u; mine = (j == x) ? c : mine; }
        if (sum == G) break;
        __builtin_amdgcn_s_sleep(1);
        if ((++sp & 255u) == 0u) { if (xb_ld(&bar[XB_TMO])) break; if (sp > XB_SPIN_CAP) { atomicAdd(&bar[XB_TMO], 1u); break; } }
    }
    nloc = mine > 0u ? mine : 1u; nx = cnt > 0u ? cnt : 1u;
}
__device__ __forceinline__ void xcd_barrier(const XcdBarrier& b) {
    asm volatile("s_waitcnt vmcnt(0)" ::: "memory");
    __syncthreads();
    if (threadIdx.x == 0) {
        unsigned* bar = b.bar;
        __builtin_amdgcn_s_waitcnt(0);
        unsigned nloc = b.st[0], nx = b.st[1];
        if (nloc == 0u) { xcd_barrier_complete(bar, b.x, nloc, nx); b.st[0] = nloc; b.st[1] = nx; }
        const unsigned old = xb_add(&bar[XB_XSUB(b.x)], 1u);
        const unsigned gen = old / nloc;
        if (old + 1u == (gen + 1u) * nloc) {
            __builtin_amdgcn_fence(__ATOMIC_RELEASE, "agent");
            asm volatile("s_waitcnt vmcnt(0)" ::: "memory");
            const unsigned og = xb_add(&bar[XB_TOP], 1u);
            const unsigned tg = og / nx;
            if (og + 1u == (tg + 1u) * nx) xb_add(&bar[XB_TOPGEN], 1u);
            else XB_SPIN(xb_ld(&bar[XB_TOPGEN]) == tg, bar);
            __builtin_amdgcn_fence(__ATOMIC_ACQUIRE, "agent");
            xb_add(&bar[XB_XGEN(b.x)], 1u);
            asm volatile("s_waitcnt vmcnt(0)" ::: "memory");
        } else {
            XB_SPIN(xb_ld(&bar[XB_XGEN(b.x)]) == gen, bar);
            __builtin_amdgcn_fence(__ATOMIC_ACQUIRE, "agent");
            asm volatile("s_waitcnt vmcnt(0)" ::: "memory");
        }
    }
    __syncthreads();
}

constexpr int REP5A = 1, REP5S = 1; constexpr int REP0 = 1; constexpr int REP1 = 1; constexpr int REP2 = 1; constexpr int REP3 = 1; constexpr int REP4 = 1; constexpr int REP5 = 1; constexpr int REP6 = 1; constexpr int REP7 = 1; constexpr int REP8 = 1; constexpr int REP9 = 1; constexpr int REP10 = 1; constexpr int REP11 = 1;
#define FI(i) ((const float*)karg(i))
#define KOUT() ((float*)karg(39))
#define KWS() ((unsigned char*)karg(40))
#define B16(off) ((bf16_t*)(ws + (off)))
#define F32(off) ((float*)(ws + (off)))
#define PHASE_IDS() int tid = threadIdx.x; asm volatile("" : "+v"(tid)); const int lane = tid & 63, wave = __builtin_amdgcn_readfirstlane(tid >> 6), half = tid >> 8, vtid = tid & 255; \
    const int G = gridDim.x, bid = blockIdx.x; unsigned char* ws = KWS(); (void)lane; (void)wave; (void)half; (void)vtid; (void)G; (void)bid; (void)ws
#define FOR_VB(vb, n) for (int vb = 2 * bid + half; vb < (n); vb += 2 * G)
#define RING ((LAS unsigned char*)lds)
#define SCR ((LAS float*)(lds + SCR_OFF))
__global__ void __launch_bounds__(NTHREADS, 2) fwd_megakernel(Params P) {
    extern __shared__ __attribute__((aligned(16))) unsigned char lds[];
    { const int tid0 = threadIdx.x; for (int u = tid0; u < (LDS_BYTES - LDSCTL_OFF) / 4; u += NTHREADS) ((unsigned*)(lds + LDSCTL_OFF))[u] = 0u; }
    __syncthreads();
    XcdBarrier bar = xcd_barrier_post((unsigned*)(KWS() + WS_CTL) + CW_BAR, (volatile LAS unsigned*)(lds + MISC_OFF) + 8);
#define GRID_BAR() xcd_barrier(bar)

#pragma unroll 1
    for (int rep = 0; rep < REP0; ++rep) {
    { PHASE_IDS();
        for (int it = bid; it < 8 * SG; it += G) ssm_tables_item(it, tid, lds, ws);
        LAS float* scr = (LAS float*)(lds + wave * 8448);
        for (int idx = bid * NWAVES + wave; idx < NP0_ITEMS; idx += G * NWAVES) {
            if (idx < NCONV_ITEMS) { int r = idx, m = 0; for (; m < NWMAT - 1; ++m) { const int nt = 2 * wmat_tiles(m); if (r < nt) break; r -= nt; }
                const WDesc d = get_wdesc(ws, m); const int nch = d.N / 32; convert_item_wave(d, r % nch, r / nch, lane, scr); }
            else if (idx < NCONV_ITEMS + NROW_ITEMS) { const int r0 = 8 * (idx - NCONV_ITEMS); const float* x = FI(0);
#pragma unroll 2
                for (int j = 0; j < 8; ++j) row_to_bf16(x, B16(WS_XB), F32(WS_SS), r0 + j, lane); }
            else if (idx < NCONV_ITEMS + NROW_ITEMS + NMEM_ITEMS) { const int r0 = 8 * (idx - NCONV_ITEMS - NROW_ITEMS); const float* mem = FI(1);
                for (int j = 0; j < 8; ++j) row_to_bf16(mem, B16(WS_MEMB), F32(WS_SSMEM), r0 + j, lane); }
            else { const int e0 = 512 * (idx - NCONV_ITEMS - NROW_ITEMS - NMEM_ITEMS); const int* pos = (const int*)karg(2);
                for (int j = 0; j < 8; ++j) rope_entry(pos, (float2*)(ws + WS_ROPE), e0 + 64 * j + lane); }
        }
    }
    GRID_BAR(); }
#pragma unroll 1
    for (int rep = 0; rep < REP1; ++rep) {
    { PHASE_IDS(); pg8::Gemm g{B16(WS_XB), B16(WS_W1T), DM, DM, T, NUP}; pg8::StaticOrder S; S.init(T, NUP, G, bid);
      const PEpiUp<1> e{0, ws}; pg8::gemm_phase(tid, RING, SCR, g, S, e); }
    GRID_BAR(); }
#pragma unroll 1
    for (int rep = 0; rep < REP2; ++rep) {
    { PHASE_IDS(); pg8::Gemm g{B16(WS_H), B16(WS_WD1T), DFFP, DFFP, T, DM}; pg8::StaticOrder S; S.init(T, DM, G, bid);
      const PEpiRes<0> e{0, ws}; pg8::gemm_phase(tid, RING, SCR, g, S, e); }
    GRID_BAR(); }
#pragma unroll 1
    for (int rep = 0; rep < REP3; ++rep) {
    { PHASE_IDS(); pg8::Gemm g{B16(WS_XB), B16(WS_WINT), DM, DM, T, NIN}; pg8::StaticOrder S; S.init(T, NIN, G, bid);
      const PEpiIn e{0, ws}; pg8::gemm_phase(tid, RING, SCR, g, S, e); }
    { PHASE_IDS(); pg8::Gemm g{B16(WS_MEMB), B16(WS_WXKVT), DM, DM, TM, DM}; pg8::StaticOrder S; S.init(TM, DM, G, (bid >= 64 && bid < 80) ? bid - 64 : -1); S.G = 16;
      const PEpiMemKV<false> e{0, ws}; pg8::gemm_phase(tid, RING, SCR, g, S, e); }
    GRID_BAR(); }
#pragma unroll 1
    for (int rep = 0; rep < REP4; ++rep) {
    { PHASE_IDS(); pg8::Gemm g{B16(WS_CQ), B16(WS_WUQT), QRANK, QRANK, T, 1024}; pg8::StaticOrder S; S.init(T, 1024, G, bid);
      const PEpiQ e{0, ws}; pg8::gemm_phase(tid, RING, SCR, g, S, e); }
    { PHASE_IDS(); pg8::Gemm g{B16(WS_CKV), B16(WS_WUKVT), KVRANK, KVRANK, T, 1024}; pg8::StaticOrder S; S.init(T, 1024, G, bid);
      const PEpiKV<false> e{0, ws}; pg8::gemm_phase(tid, RING, SCR, g, S, e); }
    GRID_BAR(); }
#pragma unroll 1
    for (int rep = 0; rep < REP5; ++rep) {
    { PHASE_IDS(); const int vcu = (G % 8 == 0) ? (bid % 8) * (G / 8) + bid / 8 : bid;
#pragma unroll 1
      for (int rr = 0; rr < REP5A; ++rr)
      for (int v = vcu; v < 256; v += G) { const int bh = v >> 4, j = v & 15, b = bh / NH, h = bh % NH;
          const int wq = wave >> 1, qblk = (wq == 0) ? j : (wq == 1) ? 31 - j : (wq == 2) ? 63 - j : 32 + j;
          att::attn_wg<DQK, true>(tid, RING, B16(WS_Q) + (size_t)b * SEQ * (NH * DQK) + DQK * h, NH * DQK, B16(WS_K) + (size_t)b * SEQ * (NH * DQK) + DQK * h, NH * DQK, B16(WS_V) + (size_t)b * SEQ * 512 + DV * h, 512,
                                  B16(WS_YCAT) + (size_t)b * SEQ * DM + DV * h, DM, F32(WS_SSY) + (size_t)b * SEQ * 8 + h, 8, 64 * qblk + 32 * (wave & 1), qblk + 1, 64 - j); } }
    { PHASE_IDS(); const int vcu = (G % 8 == 0) ? (bid % 8) * (G / 8) + bid / 8 : bid;
#pragma unroll 1
      for (int rr = 0; rr < REP5S; ++rr)
      for (int v = vcu; v < 256; v += G) if ((v & 15) >= 8) ssm_unit((v >> 4) * 8 + (v & 15) - 8, tid, RING, ws); }
    GRID_BAR(); }
#pragma unroll 1
    for (int rep = 0; rep < REP6; ++rep) {
    { PHASE_IDS(); pg8::Gemm g{B16(WS_G), B16(WS_WGLUT), SSMW, SSMW, T, SSMW}; pg8::StaticOrder S; S.init(T, SSMW, G, bid);
      const PEpiGlu e{0, ws}; pg8::gemm_phase(tid, RING, SCR, g, S, e); }
    GRID_BAR(); }
#pragma unroll 1
    for (int rep = 0; rep < REP7; ++rep) {
    { PHASE_IDS(); pg8::Gemm g{B16(WS_YCAT), B16(WS_WOT), DM, DM, T, DM}; pg8::StaticOrder S; S.init(T, DM, G, bid);
      const PEpiWo e{8, ws}; pg8::gemm_phase(tid, RING, SCR, g, S, e); }
    GRID_BAR(); }
#pragma unroll 1
    for (int rep = 0; rep < REP8; ++rep) {
    { PHASE_IDS(); pg8::Gemm g{B16(WS_XB), B16(WS_WXQT), DM, DM, T, 512}; pg8::StaticOrder S; S.init(T, 512, G, bid);
      const PEpiXQ e{0, ws}; pg8::gemm_phase(tid, RING, SCR, g, S, e); }
    GRID_BAR(); }
#pragma unroll 1
    for (int rep = 0; rep < REP9; ++rep) {
    { PHASE_IDS(); const int vcu = (G % 8 == 0) ? (bid % 8) * (G / 8) + bid / 8 : bid;
      for (int v = vcu; v < 256; v += G) { const int bh = v >> 4, qb = v & 15, b = bh / NH, h = bh % NH; const size_t row0 = (size_t)b * SEQ + 256 * qb;
        att::attn_wg<128, false>(tid, RING, B16(WS_XQ) + (size_t)b * SEQ * 512 + 128 * h, 512, B16(WS_XK) + (size_t)b * MEML * 512 + 128 * h, 512, B16(WS_XV) + (size_t)b * MEML * 512 + 128 * h, 512,
                                 B16(WS_XO) + (size_t)b * SEQ * 512 + 128 * h, 512, (float*)nullptr, 0, 256 * qb + 32 * wave, MEML / 64, MEML / 64); } }
    GRID_BAR(); }
#pragma unroll 1
    for (int rep = 0; rep < REP10; ++rep) {
    { PHASE_IDS(); pg8::Gemm g{B16(WS_XO), B16(WS_WXOT), 512, 512, T, DM}; pg8::StaticOrder S; S.init(T, DM, G, bid);
      const PEpiRes<1> e{0, ws}; pg8::gemm_phase(tid, RING, SCR, g, S, e); }
    GRID_BAR(); }
#pragma unroll 1
    for (int rep = 0; rep < REP11; ++rep) {
    { PHASE_IDS(); pg8::Gemm g{B16(WS_XB), B16(WS_W2T), DM, DM, T, NUP}; pg8::StaticOrder S; S.init(T, NUP, G, bid);
      const PEpiUp<1> e{0, ws}; pg8::gemm_phase(tid, RING, SCR, g, S, e); }
    GRID_BAR(); }
    { PHASE_IDS(); pg8::Gemm g{B16(WS_H), B16(WS_WD2T), DFFP, DFFP, T, DM}; pg8::StaticOrder S; S.init(T, DM, G, bid);
      const PEpiRes<2> e{0, ws}; pg8::gemm_phase(tid, RING, SCR, g, S, e); }
}

extern "C" void kernel_launch(void* const* d_in, const int* in_sizes, int n_in, void* d_out, int out_size, void* d_ws, size_t ws_size, hipStream_t stream) {
    static int grid = 0;
    if (grid == 0) {
        if (n_in != 39 || out_size != T * DM || ws_size < WS_END) { fprintf(stderr, "kernel_launch: unexpected shapes (n_in %d out %d ws %zu)\n", n_in, out_size, ws_size); grid = -1; return; }
        int dev = 0, cus = 0, per_cu = 0;
        if (hipGetDevice(&dev) != hipSuccess || hipDeviceGetAttribute(&cus, hipDeviceAttributeMultiprocessorCount, dev) != hipSuccess) { grid = -1; return; }
        if (hipFuncSetAttribute((const void*)fwd_megakernel, hipFuncAttributeMaxDynamicSharedMemorySize, LDS_BYTES) != hipSuccess) { fprintf(stderr, "kernel_launch: hipFuncSetAttribute failed\n"); grid = -1; return; }
        if (hipOccupancyMaxActiveBlocksPerMultiprocessor(&per_cu, (const void*)fwd_megakernel, NTHREADS, LDS_BYTES) != hipSuccess || per_cu < 1) { fprintf(stderr, "kernel_launch: occupancy query says %d\n", per_cu); }
        (void)hipGetLastError();
        grid = cus;
    }
    if (grid < 0) return;
    (void)hipMemsetAsync((char*)d_ws + WS_CTL, 0, CTL_ZERO_BYTES, stream);
    Params p{};
    for (int i = 0; i < 39; ++i) p.in[i] = d_in[i];
    p.out = (float*)d_out; p.ws = (unsigned char*)d_ws;
    hipLaunchKernelGGL(fwd_megakernel, dim3(grid), dim3(NTHREADS), LDS_BYTES, stream, p);
}
```

```cpp
#include <hip/hip_runtime.h>
#include <cstdint>
#include <cstdio>

typedef unsigned short bf16_t;
typedef short bf16x8 __attribute__((ext_vector_type(8)));
typedef short bf16x4 __attribute__((ext_vector_type(4)));
typedef float f32x4 __attribute__((ext_vector_type(4)));
typedef float f32x16 __attribute__((ext_vector_type(16)));
typedef unsigned u32x2 __attribute__((ext_vector_type(2)));
typedef unsigned u32x4 __attribute__((ext_vector_type(4)));

constexpr int BATCH = 4, SEQ = 4096, DM = 1024, T = BATCH * SEQ, MEML = 256, TM = BATCH * MEML;
constexpr int DFF = 2752, DFFP = 2816, NUP = 2 * DFFP;
constexpr int NIN = 1280;
constexpr int PQ = 0, PKR = 384, PKV = 512, PU = 768;
constexpr int QRANK = 384, KVRANK = 256, NH = 4, DQK = 192, DNOPE = 128, DROPE = 64, DV = 128;
constexpr int SSMW = 512, SG = 32, SP = 64;
constexpr float EPS = 1e-6f;
constexpr float LOG2E = 1.4426950408889634f;
constexpr float QSCALE = 0.07216878364870322f * LOG2E;
constexpr float XSCALE = 0.08838834764831845f * LOG2E;

constexpr size_t MiB = 1u << 20;
constexpr size_t WS_CTL = 0;
constexpr size_t WS_W1T = 1 * MiB;
constexpr size_t WS_WD1T = 12 * MiB;
constexpr size_t WS_W2T = 18 * MiB;
constexpr size_t WS_WD2T = 29 * MiB;
constexpr size_t WS_WINT = 35 * MiB;
constexpr size_t WS_WUQT = 38 * MiB;
constexpr size_t WS_WUKVT = 39 * MiB;
constexpr size_t WS_WGLUT = 40 * MiB;
constexpr size_t WS_WOT = 41 * MiB;
constexpr size_t WS_WXQT = 43 * MiB;
constexpr size_t WS_WXKVT = 44 * MiB;
constexpr size_t WS_WXOT = 46 * MiB;
constexpr size_t WS_ROPE = 63 * MiB;
constexpr size_t WS_SS = 67 * MiB;
constexpr size_t WS_SSQ = WS_SS + 256 * 1024;
constexpr size_t WS_SSKR = WS_SSQ + 128 * 1024;
constexpr size_t WS_SSKV = WS_SSKR + 64 * 1024;
constexpr size_t WS_SSY = 68 * MiB;
constexpr size_t WS_SSMEM = WS_SSY + 512 * 1024;
constexpr size_t WS_MEMB = 69 * MiB;
constexpr size_t WS_XK = 71 * MiB;
constexpr size_t WS_XVT = 72 * MiB;
constexpr size_t WS_XV = 73 * MiB;
constexpr size_t WS_XB = 74 * MiB;
constexpr size_t WS_G = 106 * MiB;
constexpr size_t WS_H = 106 * MiB;
constexpr size_t WS_CQ = WS_H;
constexpr size_t WS_CKV = WS_H + 12 * MiB;
constexpr size_t WS_U = WS_H + 20 * MiB;
constexpr size_t WS_KR = WS_H + 36 * MiB;
constexpr size_t WS_Q = WS_H + 40 * MiB;
constexpr size_t WS_K = WS_H + 64 * MiB;
constexpr size_t WS_XQ = WS_Q;
constexpr size_t WS_XO = WS_K;
constexpr size_t WS_KT = 194 * MiB;
constexpr size_t WS_BST = 195 * MiB;
constexpr size_t WS_CMT = 199 * MiB;
constexpr size_t WS_VT = 203 * MiB;
constexpr size_t WS_V = 47 * MiB;
constexpr size_t WS_YCAT = 210 * MiB;
constexpr size_t WS_END = 256 * MiB;

__device__ __forceinline__ unsigned f2bf(float f) { unsigned u = __builtin_bit_cast(unsigned, f); return (u + 0x7fffu + ((u >> 16) & 1u)) >> 16; }
typedef float f32x2_t __attribute__((ext_vector_type(2))); typedef __bf16 bf16x2_t __attribute__((ext_vector_type(2)));
__device__ __forceinline__ unsigned pk2(float lo, float hi) { f32x2_t v = {lo, hi}; bf16x2_t b = __builtin_convertvector(v, bf16x2_t); return __builtin_bit_cast(unsigned, b); }
__device__ __forceinline__ float bf2f(unsigned short b) { return __builtin_bit_cast(float, (unsigned)b << 16); }
__device__ __forceinline__ float wave_sum(float v) {
#pragma unroll
    for (int o = 1; o < 64; o <<= 1) v += __shfl_xor(v, o);
    return v;
}
__device__ __forceinline__ float quad_row_sum(float v) { v += __shfl_xor(v, 16); v += __shfl_xor(v, 32); return v; }
__device__ __forceinline__ void st_bf4(bf16_t* p, f32x4 v) { u32x2 w; w.x = pk2(v[0], v[1]); w.y = pk2(v[2], v[3]); *(u32x2*)p = w; }
__device__ __forceinline__ float dot4(f32x4 v) { return (v[0] * v[0] + v[1] * v[1]) + (v[2] * v[2] + v[3] * v[3]); }

#define LAS __attribute__((address_space(3)))
#define GAS __attribute__((address_space(1)))
struct Params { const void* in[39]; float* out; unsigned char* ws; };
__device__ __forceinline__ const void* karg(int i) {
    unsigned long long p;
    asm volatile("s_load_dwordx2 %0, %1, %2\n\ts_waitcnt lgkmcnt(0)" : "=s"(p) : "s"(__builtin_amdgcn_kernarg_segment_ptr()), "i"(8 * i) : "memory");
    return (const void*)(const GAS void*)p;
}

struct WDesc { const float* W; const float* W2; int ldw; int Ksrc; bf16_t* dst; int N; int K; const float* g; const float* g2; int gsplit; int mode; int ncols_src; int pad; };
__device__ __forceinline__ int src_chunk_col(const WDesc& d, int c, const float*& src) {
    src = d.W;
    switch (d.mode) {
        case 0: return (32 * c < d.ncols_src) ? 32 * c : -1;
        case 1: { const int pn = c >> 3, q = c & 7; const int col = 128 * pn + 32 * (q & 3); if (q >= 4) src = d.W2; return col < d.ncols_src ? col : -1; }
        case 2: { if (c < 12) return 32 * c; if (c < 14) return 640 + 32 * (c - 12); if (c < 16) return -1; if (c < 24) return 384 + 32 * (c - 16); return 704 + 32 * (c - 24); }
        case 3: { const int h = c >> 3, q = c & 7; if (q < 3) return 192 * h + 32 * q; if (q == 3) return 192 * h + 128; if (q == 4) return 192 * h + 96; if (q == 7) return 192 * h + 160; return -1; }
    }
    return -1;
}
constexpr int NWMAT = 12;
__device__ __forceinline__ WDesc get_wdesc(unsigned char* ws, int m) {
#define FI(i) ((const float*)karg(i))
#define WB(off) ((bf16_t*)(ws + (off)))
    switch (m) {
        case 0: return WDesc{FI(4), FI(5), DFF, DM, WB(WS_W1T), NUP, DM, FI(3), FI(3), DM, 1, DFF, 0};
        case 1: return WDesc{FI(36), FI(37), DFF, DM, WB(WS_W2T), NUP, DM, FI(35), FI(35), DM, 1, DFF, 0};
        case 2: return WDesc{FI(6), nullptr, DM, DFF, WB(WS_WD1T), DM, DFFP, nullptr, nullptr, 0, 0, DM, 0};
        case 3: return WDesc{FI(38), nullptr, DM, DFF, WB(WS_WD2T), DM, DFFP, nullptr, nullptr, 0, 0, DM, 0};
        case 4: return WDesc{FI(8), nullptr, 1216, DM, WB(WS_WINT), NIN, DM, FI(7), FI(7), DM, 2, 1216, 0};
        case 5: return WDesc{FI(10), nullptr, 768, QRANK, WB(WS_WUQT), 1024, QRANK, FI(9), FI(9), QRANK, 3, 768, 0};
        case 6: return WDesc{FI(12), nullptr, 1024, KVRANK, WB(WS_WUKVT), 1024, KVRANK, FI(11), FI(11), KVRANK, 0, 1024, 0};
        case 7: return WDesc{FI(23), nullptr, 512, 512, WB(WS_WGLUT), 512, 512, nullptr, nullptr, 0, 0, 512, 0};
        case 8: return WDesc{FI(27), nullptr, DM, DM, WB(WS_WOT), DM, DM, FI(25), FI(26), 512, 0, DM, 0};
        case 9: return WDesc{FI(30), nullptr, 512, DM, WB(WS_WXQT), 512, DM, FI(28), FI(28), DM, 0, 512, 0};
        case 10: return WDesc{FI(31), nullptr, DM, DM, WB(WS_WXKVT), DM, DM, FI(29), FI(29), DM, 0, DM, 0};
        default: return WDesc{FI(34), nullptr, DM, 512, WB(WS_WXOT), DM, 512, nullptr, nullptr, 0, 0, DM, 0};
    }
#undef FI
#undef WB
}
__device__ __forceinline__ int wmat_tiles(int m) {
    switch (m) { case 0: case 1: return (NUP / 64) * (DM / 64); case 2: case 3: return (DM / 64) * (DFFP / 64); case 4: return (NIN / 64) * (DM / 64); case 5: return 16 * (QRANK / 64);
        case 6: return 16 * (KVRANK / 64); case 7: return 64; case 8: return 256; case 9: return 8 * 16; case 10: return 256; default: return 16 * 8; }
}
constexpr int WTILES_TOTAL = 2 * (NUP / 64) * (DM / 64) + 2 * (DM / 64) * (DFFP / 64) + (NIN / 64) * (DM / 64) + 16 * (QRANK / 64) + 16 * (KVRANK / 64) + 64 + 256 + 128 + 256 + 128;
__device__ __forceinline__ void convert_tile_load(const WDesc& d, int nc, int kc, int vtid, float* tile, int& valid) {
    const float* src0; const float* src1; const int c0 = src_chunk_col(d, 2 * nc, src0), c1 = src_chunk_col(d, 2 * nc + 1, src1); const int k0 = 64 * kc;
    valid = (k0 < d.Ksrc) ? ((c0 >= 0 ? 1 : 0) | (c1 >= 0 ? 2 : 0)) : 0;
    if (valid) {
        for (int e = vtid; e < 64 * 64; e += 256) { const int kk = e >> 6, nn = e & 63; const int k = k0 + kk; const int sub = nn >> 5; const int cc = sub ? c1 : c0; const float* src = sub ? src1 : src0;
            float gg = 1.f; if (d.g) gg = (k < d.gsplit) ? d.g[k] : d.g2[k - d.gsplit];
            tile[kk * 65 + nn] = (cc >= 0) ? src[(size_t)k * d.ldw + cc + (nn & 31)] * gg : 0.f; }
    }
}
__device__ __forceinline__ void convert_tile_store(const WDesc& d, int nc, int kc, int vtid, const float* tile, int valid) {
    const int k0 = 64 * kc;
    for (int e = vtid; e < 64 * 8; e += 256) { const int nn = e >> 3, ch = e & 7;
        u32x4 o = {0u, 0u, 0u, 0u};
        if (valid) { o.x = pk2(tile[(8 * ch + 0) * 65 + nn], tile[(8 * ch + 1) * 65 + nn]); o.y = pk2(tile[(8 * ch + 2) * 65 + nn], tile[(8 * ch + 3) * 65 + nn]);
                     o.z = pk2(tile[(8 * ch + 4) * 65 + nn], tile[(8 * ch + 5) * 65 + nn]); o.w = pk2(tile[(8 * ch + 6) * 65 + nn], tile[(8 * ch + 7) * 65 + nn]); }
        *(u32x4*)(d.dst + (size_t)(64 * nc + nn) * d.K + k0 + 8 * ch) = o; }
}
__device__ __forceinline__ void convert_item_wave(const WDesc& d, int nc, int kc, int lane, LAS float* scr) {
    const float* src; const int col0 = src_chunk_col(d, nc, src); const int k0 = 64 * kc, n0 = 32 * nc; const int c = lane & 7;
    if (col0 < 0 || k0 >= d.Ksrc) {
#pragma unroll
        for (int j = 0; j < 4; ++j) { const int n = (lane >> 3) + 8 * j; *(u32x4*)(d.dst + (size_t)(n0 + n) * d.K + k0 + 8 * c) = (u32x4){0u, 0u, 0u, 0u}; }
        return; }
    const float* sp = src + (size_t)(k0 + (lane >> 3)) * d.ldw + col0 + 4 * c;
    f32x4 v[8]; float gg[8];
#pragma unroll
    for (int i = 0; i < 8; ++i) { v[i] = *(const f32x4*)(sp + (size_t)(8 * i) * d.ldw); const int k = k0 + (lane >> 3) + 8 * i; gg[i] = d.g ? ((k < d.gsplit) ? d.g[k] : d.g2[k - d.gsplit]) : 1.f; }
#pragma unroll
    for (int i = 0; i < 8; ++i) { LAS float* w = scr + ((lane >> 3) + 8 * i) * 33 + 4 * c; w[0] = v[i][0] * gg[i]; w[1] = v[i][1] * gg[i]; w[2] = v[i][2] * gg[i]; w[3] = v[i][3] * gg[i]; }
    asm volatile("s_waitcnt lgkmcnt(0)" ::: "memory");
#pragma unroll
    for (int j = 0; j < 4; ++j) { const int n = (lane >> 3) + 8 * j; const LAS float* s = scr + (8 * c) * 33 + n;
        u32x4 o; o.x = pk2(s[0 * 33], s[1 * 33]); o.y = pk2(s[2 * 33], s[3 * 33]); o.z = pk2(s[4 * 33], s[5 * 33]); o.w = pk2(s[6 * 33], s[7 * 33]);
        *(u32x4*)(d.dst + (size_t)(n0 + n) * d.K + k0 + 8 * c) = o; }
    asm volatile("s_waitcnt lgkmcnt(0)" ::: "memory");
}
__device__ __forceinline__ void convert_subset(unsigned mask, int wrank, int nwaves, int lane, LAS float* scr, unsigned char* ws) {
    for (int m = 0; m < NWMAT; ++m) { if (!((mask >> m) & 1u)) continue;
        const WDesc d = get_wdesc(ws, m); const int nt = 2 * wmat_tiles(m), nch = d.N / 32;
        for (int r = wrank; r < nt; r += nwaves) convert_item_wave(d, r % nch, r / nch, lane, scr); }
}
constexpr unsigned WM_P0 = (1u << 0) | (1u << 2) | (1u << 4) | (1u << 5) | (1u << 6) | (1u << 7) | (1u << 10);
constexpr unsigned WM_P6 = (1u << 1) | (1u << 8) | (1u << 9);
constexpr unsigned WM_P8 = (1u << 3) | (1u << 11);
constexpr int NCONV_ITEMS = 2 * WTILES_TOTAL, NROW_ITEMS = T / 8, NMEM_ITEMS = TM / 8, NROPE_ITEMS = T * 32 / 512, NP0_ITEMS = NROW_ITEMS + NMEM_ITEMS + NROPE_ITEMS;
constexpr int CW_Q0 = 64;
__device__ __forceinline__ void row_to_bf16(const float* x, bf16_t* out, float* ss4, int row, int lane) {
    const f32x4* xr = (const f32x4*)(x + (size_t)row * DM) + lane; float s = 0.f;
    unsigned long long* o8 = (unsigned long long*)(out + (size_t)row * DM) + lane;
#pragma unroll
    for (int j = 0; j < 4; ++j) { const f32x4 v = xr[64 * j]; s += dot4(v); o8[64 * j] = (unsigned long long)pk2(v[0], v[1]) | ((unsigned long long)pk2(v[2], v[3]) << 32); }
    s = wave_sum(s);
    if (lane < 4) ss4[row * 4 + lane] = lane == 0 ? s : 0.f;
}
__device__ __forceinline__ void rope_entry(const int* pos, float2* tab, int idx) {
    const int t = idx >> 5, i = idx & 31;
    const double inv = exp2(-(double)i / 32.0 * 13.287712379549449);
    double a = (double)pos[t] * inv; a -= 6.283185307179586 * rint(a / 6.283185307179586);
    float s, c; sincosf((float)a, &s, &c); tab[idx] = make_float2(c, s);
}

__device__ __forceinline__ float rs_from4(const float* ss4, int row, float invc) { const f32x4 s = *(const f32x4*)(ss4 + 4 * row); return rsqrtf(((s[0] + s[1]) + (s[2] + s[3])) * invc + EPS); }

namespace pg8 {
#define PG8_LAS __attribute__((address_space(3)))
constexpr int BM = 256, BK = 64, HALF = 128, HTB = HALF * BK * 2, STAGE_BYTES = 8 * HTB, NXCD = 8, WGM = 8;
__host__ __device__ __forceinline__ int lds_byte(int r, int c) { const int st = (r >> 4) * 2 + (c >> 5), rr = r & 15, cc = c & 31, ob = rr * 64 + cc * 2; return st * 1024 + (ob ^ (((ob >> 9) & 1) << 5)); }
__host__ __device__ __forceinline__ void stage_rc(int b, int& R, int& C) { const int st = b / 1024, sb = b % 1024, swz = sb ^ (((sb >> 9) & 1) << 5); R = (st >> 1) * 16 + swz / 64; C = (st & 1) * 32 + (swz % 64) / 2; }
__host__ __device__ __forceinline__ int perm32(int rho) { const int n = rho >> 4, i = rho & 15; return 8 * (i >> 2) + 4 * n + (i & 3); }
struct Unit { int pm, pn; };
struct Gemm { const bf16_t* A; const bf16_t* Bt; int lda; int K; int M, N; };
struct StaticOrder {
    int nM, nN, nwg, G, c;
    __device__ void init(int M, int N, int G_, int c_) { nM = M / BM; nN = N / BM; nwg = nM * nN; G = G_; c = c_; }
    __device__ bool next(int i, Unit& u) const {
        const long L = (long)i * G + c; if (c < 0 || L >= nwg) return false;
        int wgid = (int)L; { const int q = nwg / NXCD, r = nwg % NXCD, xcd = wgid % NXCD, off = wgid / NXCD; wgid = (xcd < r ? xcd * (q + 1) : r * (q + 1) + (xcd - r) * q) + off; }
        const int nig = WGM * nN, gid = wgid / nig, fm = gid * WGM, gsz = (nM - fm) < WGM ? (nM - fm) : WGM;
        u.pm = fm + ((wgid % nig) % gsz); u.pn = (wgid % nig) / gsz; return true;
    }
};
template <class Epi>
__device__ __forceinline__ void gemm_phase(int tid, PG8_LAS unsigned char* lds, PG8_LAS float* scr, const Gemm g, const StaticOrder& S, const Epi& E) {
    const int wid = __builtin_amdgcn_readfirstlane(tid >> 6), lane = tid & 63, wr = wid >> 2, wc = wid & 3, fr = lane & 15, fq = lane >> 4;
    const int K = g.K, nt = K / BK;
    unsigned voffA[2], voffB[2];
#pragma unroll
    for (int i = 0; i < 2; ++i) { int R, C; stage_rc(tid * 16 + i * 8192, R, C); const int Rb = Epi::PERM ? ((R & ~31) + perm32(R & 31)) : R;
        voffA[i] = (unsigned)(R * g.lda + C) * 2u; voffB[i] = (unsigned)(Rb * K + C) * 2u; }
    const size_t kstep = (size_t)(BK * 2);
    const size_t hstepA = (size_t)HALF * g.lda * 2, hstepB = (size_t)HALF * K * 2;
    const size_t tstepA = 2 * hstepA, tstepB = 2 * hstepB;
    const unsigned ldsw = (unsigned)wid * 1024u;
    const int aoff = lds_byte(wr * 64 + fr, fq * 8), boff = lds_byte(wc * 32 + fr, fq * 8);
#define PG8_SA(b, h) (((b) * 2 + (h)) * HTB)
#define PG8_SB(b, h) ((4 + (b) * 2 + (h)) * HTB)
#define PG8_STAGE(bufoff, gbase, voff) do { _Pragma("unroll") for (int _i = 0; _i < 2; ++_i) \
        __builtin_amdgcn_global_load_lds((const unsigned*)((const char*)(gbase) + (voff)[_i]), (PG8_LAS unsigned*)(lds + (bufoff) + ldsw + _i * 8192), 16, 0, 0); } while (0)
#define PG8_LDA(dst, b, h) do { _Pragma("unroll") for (int m = 0; m < 4; ++m) _Pragma("unroll") for (int k = 0; k < 2; ++k) dst[m][k] = *(const PG8_LAS bf16x8*)(lds + PG8_SA(b, h) + aoff + m * 2048 + k * 1024); } while (0)
#define PG8_LDB(dst, b, h) do { _Pragma("unroll") for (int n = 0; n < 2; ++n) _Pragma("unroll") for (int k = 0; k < 2; ++k) dst[n][k] = *(const PG8_LAS bf16x8*)(lds + PG8_SB(b, h) + boff + n * 2048 + k * 1024); } while (0)
#define PG8_MMA(ai, bj, At, Bt) do { __builtin_amdgcn_s_setprio(1); _Pragma("unroll") for (int m = 0; m < 4; ++m) _Pragma("unroll") for (int n = 0; n < 2; ++n) _Pragma("unroll") for (int k = 0; k < 2; ++k) \
        acc[ai][bj][m][n] = __builtin_amdgcn_mfma_f32_16x16x32_bf16(Bt[n][k], At[m][k], acc[ai][bj][m][n], 0, 0, 0); __builtin_amdgcn_s_setprio(0); } while (0)
#define PG8_WAIT_V(n) asm volatile("s_waitcnt vmcnt(" #n ")" ::: "memory")
#define PG8_WAIT_L(n) asm volatile("s_waitcnt lgkmcnt(" #n ")" ::: "memory")
#define PG8_BAR __builtin_amdgcn_s_barrier()
#define PG8_SCHED __builtin_amdgcn_sched_barrier(0)
    Unit cur, nxt; int ui = 0;
    if (!S.next(0, cur)) return;
    f32x4 acc[2][2][4][2];
#pragma unroll
    for (int a = 0; a < 2; ++a)
#pragma unroll
        for (int b = 0; b < 2; ++b)
#pragma unroll
            for (int m = 0; m < 4; ++m)
#pragma unroll
                for (int n = 0; n < 2; ++n) acc[a][b][m][n] = (f32x4){0.f, 0.f, 0.f, 0.f};
    bf16x8 At[4][2], B0[2][2], B1[2][2];
    const char* cA = (const char*)g.A + (size_t)cur.pm * tstepA; const char* cB = (const char*)g.Bt + (size_t)cur.pn * tstepB;
    PG8_STAGE(PG8_SB(0, 0), cB, voffB); PG8_STAGE(PG8_SB(0, 1), cB + hstepB, voffB); PG8_STAGE(PG8_SA(0, 0), cA, voffA); PG8_STAGE(PG8_SA(0, 1), cA + hstepA, voffA);
    if (wr == 1) PG8_BAR;
    PG8_WAIT_V(2); PG8_BAR;
    PG8_STAGE(PG8_SB(1, 0), cB + kstep, voffB); PG8_STAGE(PG8_SA(1, 0), cA + kstep, voffA); PG8_STAGE(PG8_SB(1, 1), cB + hstepB + kstep, voffB);
    PG8_WAIT_V(6); PG8_BAR;
    for (;;) {
        const bool has_next = S.next(ui + 1, nxt);
        const char* nA = has_next ? (const char*)g.A + (size_t)nxt.pm * tstepA : cA; const char* nB = has_next ? (const char*)g.Bt + (size_t)nxt.pn * tstepB : cB;
#pragma unroll 1
        for (int t = 0; t < nt; t += 2) {
            const bool last = (t == nt - 2);
            const char* a1 = cA + (size_t)(t + 1) * kstep;
            const char* a2 = last ? nA : cA + (size_t)(t + 2) * kstep; const char* b2 = last ? nB : cB + (size_t)(t + 2) * kstep;
            const char* a3 = a2 + kstep; const char* b3 = b2 + kstep;
            if constexpr (Epi::HAS_MID) { if (t == E.tmid) { int t2 = tid; asm volatile("" : "+v"(t2)); E.mid(acc, cur, wr, t2 & 15); } }
            PG8_LDB(B0, 0, 0); PG8_LDB(B1, 0, 1); PG8_SCHED; PG8_LDA(At, 0, 0); PG8_STAGE(PG8_SA(1, 1), a1 + hstepA, voffA);
            PG8_WAIT_V(8); PG8_WAIT_L(0); PG8_BAR; PG8_MMA(0, 0, At, B0); PG8_MMA(0, 1, At, B1); PG8_BAR; PG8_SCHED;
            PG8_LDA(At, 0, 1); PG8_STAGE(PG8_SB(0, 0), b2, voffB); PG8_STAGE(PG8_SB(0, 1), b2 + hstepB, voffB); PG8_STAGE(PG8_SA(0, 0), a2, voffA);
            PG8_WAIT_V(8); PG8_WAIT_L(0); PG8_BAR; PG8_MMA(1, 0, At, B0); PG8_MMA(1, 1, At, B1); PG8_BAR; PG8_SCHED;
            PG8_LDB(B0, 1, 0); PG8_LDB(B1, 1, 1); PG8_SCHED; PG8_LDA(At, 1, 0); PG8_STAGE(PG8_SA(0, 1), a2 + hstepA, voffA);
            PG8_WAIT_V(8); PG8_WAIT_L(0); PG8_BAR; PG8_MMA(0, 0, At, B0); PG8_MMA(0, 1, At, B1); PG8_BAR; PG8_SCHED;
            PG8_LDA(At, 1, 1); PG8_STAGE(PG8_SB(1, 0), b3, voffB); PG8_STAGE(PG8_SB(1, 1), b3 + hstepB, voffB); PG8_STAGE(PG8_SA(1, 0), a3, voffA);
            PG8_WAIT_V(8); PG8_WAIT_L(0); PG8_BAR; PG8_MMA(1, 0, At, B0); PG8_MMA(1, 1, At, B1); PG8_BAR; PG8_SCHED;
        }
        if (wr == 0) PG8_BAR;
        { int t2 = tid; asm volatile("" : "+v"(t2)); const int efr = t2 & 15, efq = (t2 >> 4) & 3;
          E(acc, cur, wr, wc, efr, efq, scr); }
        if (!has_next) break;
#pragma unroll
        for (int a = 0; a < 2; ++a)
#pragma unroll
            for (int b = 0; b < 2; ++b)
#pragma unroll
                for (int m = 0; m < 4; ++m)
#pragma unroll
                    for (int n = 0; n < 2; ++n) acc[a][b][m][n] = (f32x4){0.f, 0.f, 0.f, 0.f};
        cur = nxt; cA = nA; cB = nB; ++ui;
        if (wr == 1) PG8_BAR;
    }
    PG8_WAIT_V(0);
    PG8_BAR;
#undef PG8_SA
#undef PG8_SB
#undef PG8_STAGE
#undef PG8_LDA
#undef PG8_LDB
#undef PG8_MMA
#undef PG8_WAIT_V
#undef PG8_WAIT_L
#undef PG8_BAR
#undef PG8_SCHED
}
}

typedef f32x4 Acc[2][2][4][2];
#define PROW(ai, m) (u.pm * 256 + (ai) * 128 + wr * 64 + (m) * 16 + fr)
#define EPI_FOR_AM _Pragma("unroll") for (int ai = 0; ai < 2; ++ai) _Pragma("unroll") for (int m = 0; m < 4; ++m)
#define EPI_FENCE asm volatile("" ::: "memory")
__device__ __forceinline__ u32x4 pack8(f32x4 a, f32x4 b) { u32x4 w; w.x = pk2(a[0], a[1]); w.y = pk2(a[2], a[3]); w.z = pk2(b[0], b[1]); w.w = pk2(b[2], b[3]); return w; }
template <int NV> __device__ __forceinline__ void xch_rows(float (&v)[2][4][NV], LAS float* scr, int wr, int wc, int fr, int fq) {
    EPI_FOR_AM {
#pragma unroll
        for (int k = 0; k < NV; ++k) { const float t = quad_row_sum(v[ai][m][k]); if (fq == 0) scr[((ai * 128 + wr * 64 + m * 16 + fr) * 4 + wc) * NV + k] = t; } }
    asm volatile("s_waitcnt lgkmcnt(0)" ::: "memory"); __builtin_amdgcn_s_barrier(); asm volatile("" ::: "memory");
    EPI_FOR_AM { const LAS float* p = scr + (ai * 128 + wr * 64 + m * 16 + fr) * 4 * NV;
#pragma unroll
        for (int k = 0; k < NV; ++k) v[ai][m][k] = (p[k] + p[NV + k]) + (p[2 * NV + k] + p[3 * NV + k]); }
}
__device__ __forceinline__ float silu_mul(float g, float u) { return g / (1.f + __expf(-g)) * u; }

#define EB16(off) ((bf16_t*)(ws + (off)))
#define EF32(off) ((float*)(ws + (off)))
#define EFI(i) ((const float*)karg(i))
template <int FFN> struct PEpiUp {
    static constexpr bool PERM = true, HAS_MID = false; int tmid; unsigned char* ws;
    __device__ __forceinline__ void operator()(Acc& acc, const pg8::Unit& u, int wr, int wc, int fr, int fq, LAS float*) const {
        const float* ss = EF32(WS_SS); bf16_t* H = EB16(WS_H);
        EPI_FOR_AM { const int r = PROW(ai, m); const float rs = rs_from4(ss, r, 1.f / DM); f32x4 h0, h1;
#pragma unroll
            for (int i = 0; i < 4; ++i) { h0[i] = silu_mul(acc[ai][0][m][0][i] * rs, acc[ai][1][m][0][i] * rs); h1[i] = silu_mul(acc[ai][0][m][1][i] * rs, acc[ai][1][m][1][i] * rs); }
            *(u32x4*)(H + (size_t)r * DFFP + 128 * u.pn + 32 * wc + 8 * fq) = pack8(h0, h1); }
    }
};
__device__ __forceinline__ void unpack8(u32x4 w, f32x4& a, f32x4& b) { a[0] = __builtin_bit_cast(float, w.x << 16); a[1] = __builtin_bit_cast(float, w.x & 0xffff0000u); a[2] = __builtin_bit_cast(float, w.y << 16); a[3] = __builtin_bit_cast(float, w.y & 0xffff0000u);
    b[0] = __builtin_bit_cast(float, w.z << 16); b[1] = __builtin_bit_cast(float, w.z & 0xffff0000u); b[2] = __builtin_bit_cast(float, w.w << 16); b[3] = __builtin_bit_cast(float, w.w & 0xffff0000u); }
template <int MODE> struct PEpiRes {
    static constexpr bool PERM = true, HAS_MID = false; int tmid; unsigned char* ws;
    __device__ __forceinline__ void operator()(Acc& acc, const pg8::Unit& u, int wr, int wc, int fr, int fq, LAS float* scr) const {
        bf16_t* xb = EB16(WS_XB); float* ssout = EF32(WS_SS); const float alpha = (MODE == 1) ? 1.f : 0.5f;
        float part[2][4][1];
        EPI_FOR_AM { const int r = PROW(ai, m); float s = 0.f;
#pragma unroll
            for (int bj = 0; bj < 2; ++bj) { const size_t off = (size_t)r * DM + 256 * u.pn + 128 * bj + 32 * wc + 8 * fq; f32x4 r0, r1;
                if (MODE == 0) { const float* x = EFI(0); r0 = *(const f32x4*)(x + off); r1 = *(const f32x4*)(x + off + 4); } else unpack8(*(const u32x4*)(xb + off), r0, r1);
                const f32x4 v0 = r0 + acc[ai][bj][m][0] * alpha, v1 = r1 + acc[ai][bj][m][1] * alpha;
                if (MODE == 2) { float* out = (float*)karg(39); *(f32x4*)(out + off) = v0; *(f32x4*)(out + off + 4) = v1; }
                else { *(u32x4*)(xb + off) = pack8(v0, v1); s += dot4(v0) + dot4(v1); } }
            part[ai][m][0] = s; EPI_FENCE; }
        if (MODE != 2) { xch_rows<1>(part, scr, wr, wc, fr, fq); if (wc == 0 && fq == 0) EPI_FOR_AM ssout[PROW(ai, m) * 4 + u.pn] = part[ai][m][0]; }
    }
};
struct PEpiWo {
    static constexpr bool PERM = true, HAS_MID = true; int tmid; unsigned char* ws;
    __device__ __forceinline__ void rsv(int row, float& rm, float& rsm) const { const float* ssy = EF32(WS_SSY); const f32x4 a = *(const f32x4*)(ssy + 8 * row), b = *(const f32x4*)(ssy + 8 * row + 4);
        rm = rsqrtf(((a[0] + a[1]) + (a[2] + a[3])) * (1.f / 512) + EPS); rsm = rsqrtf((b[0] + b[1]) * (1.f / 512) + EPS); }
    __device__ __forceinline__ void mid(Acc& acc, const pg8::Unit& u, int wr, int fr) const {
        EPI_FOR_AM { float rm, rsm; rsv(PROW(ai, m), rm, rsm); const float q = rm / rsm;
#pragma unroll
            for (int bj = 0; bj < 2; ++bj)
#pragma unroll
                for (int n = 0; n < 2; ++n) acc[ai][bj][m][n] = acc[ai][bj][m][n] * q; }
    }
    __device__ __forceinline__ void operator()(Acc& acc, const pg8::Unit& u, int wr, int wc, int fr, int fq, LAS float* scr) const {
        bf16_t* xb = EB16(WS_XB); float* ssout = EF32(WS_SS);
        float part[2][4][1];
        EPI_FOR_AM { const int r = PROW(ai, m); float rm, rsm; rsv(r, rm, rsm); float s = 0.f;
#pragma unroll
            for (int bj = 0; bj < 2; ++bj) { const size_t off = (size_t)r * DM + 256 * u.pn + 128 * bj + 32 * wc + 8 * fq; f32x4 r0, r1; unpack8(*(const u32x4*)(xb + off), r0, r1);
                const f32x4 v0 = r0 + acc[ai][bj][m][0] * rsm, v1 = r1 + acc[ai][bj][m][1] * rsm; *(u32x4*)(xb + off) = pack8(v0, v1); s += dot4(v0) + dot4(v1); }
            part[ai][m][0] = s; EPI_FENCE; }
        xch_rows<1>(part, scr, wr, wc, fr, fq); if (wc == 0 && fq == 0) EPI_FOR_AM ssout[PROW(ai, m) * 4 + u.pn] = part[ai][m][0];
    }
};
struct PEpiIn {
    static constexpr bool PERM = true, HAS_MID = false; int tmid; unsigned char* ws;
    __device__ __forceinline__ void operator()(Acc& acc, const pg8::Unit& u, int wr, int wc, int fr, int fq, LAS float* scr) const {
        const float* ss = EF32(WS_SS); float* ssq = EF32(WS_SSQ); float* sskr = EF32(WS_SSKR); float* sskv = EF32(WS_SSKV);
        float part[2][4][2];
        EPI_FOR_AM { const int r = PROW(ai, m); const float rs = rs_from4(ss, r, 1.f / DM);
#pragma unroll
            for (int bj = 0; bj < 2; ++bj) { const f32x4 v0 = acc[ai][bj][m][0] * rs, v1 = acc[ai][bj][m][1] * rs; const int c = 128 * bj + 32 * wc + 8 * fq; bf16_t* dst = nullptr;
                if (u.pn == 0) dst = EB16(WS_CQ) + (size_t)r * QRANK + c;
                else if (u.pn == 1) { if (bj == 0) dst = EB16(WS_CQ) + (size_t)r * QRANK + 256 + c; else if (wc < 2) dst = EB16(WS_KR) + (size_t)r * 64 + (c - 128); }
                else if (u.pn == 2) dst = EB16(WS_CKV) + (size_t)r * KVRANK + c;
                else dst = EB16(WS_U) + (size_t)r * SSMW + 256 * (u.pn - 3) + c;
                if (dst) *(u32x4*)dst = pack8(v0, v1);
                part[ai][m][bj] = dot4(v0) + dot4(v1); } }
        if (u.pn < 3) {
            if (u.pn == 1 && wc >= 2) EPI_FOR_AM part[ai][m][1] = 0.f;
            xch_rows<2>(part, scr, wr, wc, fr, fq);
            if (wc == 0 && fq == 0) EPI_FOR_AM { const int r = PROW(ai, m);
                if (u.pn == 0) ssq[2 * r] = part[ai][m][0] + part[ai][m][1];
                else if (u.pn == 1) { ssq[2 * r + 1] = part[ai][m][0]; sskr[r] = part[ai][m][1]; }
                else sskv[r] = part[ai][m][0] + part[ai][m][1]; } }
    }
};
struct PEpiQ {
    static constexpr bool PERM = true, HAS_MID = false; int tmid; unsigned char* ws;
    __device__ __forceinline__ void operator()(Acc& acc, const pg8::Unit& u, int wr, int wc, int fr, int fq, LAS float* scr) const {
        const float* ssq = EF32(WS_SSQ); bf16_t* Q = EB16(WS_Q); const float2* tab = (const float2*)(ws + WS_ROPE);
        float part[2][4][1];
        EPI_FOR_AM { const int r = PROW(ai, m); const float rs = rsqrtf((ssq[2 * r] + ssq[2 * r + 1]) * (1.f / QRANK) + EPS); float s = 0.f;
#pragma unroll
            for (int bj = 0; bj < 2; ++bj)
#pragma unroll
                for (int n = 0; n < 2; ++n) { acc[ai][bj][m][n] = acc[ai][bj][m][n] * rs; s += dot4(acc[ai][bj][m][n]); }
            part[ai][m][0] = s; }
        xch_rows<1>(part, scr, wr, wc, fr, fq);
        const float* gq = EFI(13);
        EPI_FOR_AM { const int r = PROW(ai, m); const float rh = rsqrtf(part[ai][m][0] * (1.f / DQK) + EPS) * QSCALE;
            bf16_t* qp = Q + (size_t)r * (NH * DQK) + DQK * u.pn;
            if (wc < 3) { const f32x4 g0 = *(const f32x4*)(gq + 32 * wc + 8 * fq), g1 = *(const f32x4*)(gq + 32 * wc + 8 * fq + 4);
                *(u32x4*)(qp + 32 * wc + 8 * fq) = pack8(acc[ai][0][m][0] * g0 * rh, acc[ai][0][m][1] * g1 * rh);
                if (wc == 0) { const f32x4 h0 = *(const f32x4*)(gq + 96 + 8 * fq), h1 = *(const f32x4*)(gq + 96 + 8 * fq + 4);
                    *(u32x4*)(qp + 96 + 8 * fq) = pack8(acc[ai][1][m][0] * h0 * rh, acc[ai][1][m][1] * h1 * rh); }
            } else { f32x4 o1[2], o2[2];
#pragma unroll
                for (int n = 0; n < 2; ++n) { const f32x4 g1 = *(const f32x4*)(gq + 128 + 8 * fq + 4 * n), g2 = *(const f32x4*)(gq + 160 + 8 * fq + 4 * n);
#pragma unroll
                    for (int i = 0; i < 4; ++i) { const float2 cs = tab[(size_t)r * 32 + 8 * fq + 4 * n + i]; const float x1 = acc[ai][0][m][n][i] * g1[i] * rh, x2 = acc[ai][1][m][n][i] * g2[i] * rh;
                        o1[n][i] = x1 * cs.x - x2 * cs.y; o2[n][i] = x2 * cs.x + x1 * cs.y; } }
                *(u32x4*)(qp + 128 + 8 * fq) = pack8(o1[0], o1[1]); *(u32x4*)(qp + 160 + 8 * fq) = pack8(o2[0], o2[1]); } EPI_FENCE; }
    }
};
template <bool WITH_VT> struct PEpiKV {
    static constexpr bool PERM = true, HAS_MID = false; int tmid; unsigned char* ws;
    __device__ __forceinline__ void operator()(Acc& acc, const pg8::Unit& u, int wr, int wc, int fr, int fq, LAS float* scr) const {
        const float* sskv = EF32(WS_SSKV); const float* sskr = EF32(WS_SSKR); const float2* tab = (const float2*)(ws + WS_ROPE); const bf16_t* krb = EB16(WS_KR); bf16_t* K = EB16(WS_K); bf16_t* V = EB16(WS_V); bf16_t* Vt = EB16(WS_VT);
        float part[2][4][1];
        EPI_FOR_AM { const int r = PROW(ai, m); const float rs = rsqrtf(sskv[r] * (1.f / KVRANK) + EPS);
#pragma unroll
            for (int bj = 0; bj < 2; ++bj)
#pragma unroll
                for (int n = 0; n < 2; ++n) acc[ai][bj][m][n] = acc[ai][bj][m][n] * rs;
            part[ai][m][0] = dot4(acc[ai][0][m][0]) + dot4(acc[ai][0][m][1]); }
        xch_rows<1>(part, scr, wr, wc, fr, fq);
        const float* gk = EFI(14);
        EPI_FOR_AM { const int r = PROW(ai, m); const float rk = rsqrtf((part[ai][m][0] + sskr[r]) * (1.f / DQK) + EPS);
            bf16_t* kp = K + (size_t)r * (NH * DQK) + DQK * u.pn;
            const f32x4 g0 = *(const f32x4*)(gk + 32 * wc + 8 * fq), g1 = *(const f32x4*)(gk + 32 * wc + 8 * fq + 4);
            *(u32x4*)(kp + 32 * wc + 8 * fq) = pack8(acc[ai][0][m][0] * g0 * rk, acc[ai][0][m][1] * g1 * rk);
            *(u32x4*)(V + (size_t)r * 512 + 128 * u.pn + 32 * wc + 8 * fq) = pack8(acc[ai][1][m][0], acc[ai][1][m][1]);
            if (WITH_VT) { const int b = r / SEQ, t = r % SEQ;
#pragma unroll
                for (int n = 0; n < 2; ++n)
#pragma unroll
                    for (int i = 0; i < 4; ++i) Vt[((size_t)(b * NH + u.pn) * DV + 32 * wc + 8 * fq + 4 * n + i) * SEQ + t] = (bf16_t)f2bf(acc[ai][1][m][n][i]); }
            const int idx = 8 * wc + 2 * fq; const bf16_t* kr = krb + (size_t)r * 64;
            const unsigned a1 = *(const unsigned*)(kr + idx), a2 = *(const unsigned*)(kr + 32 + idx); const f32x4 cs = *(const f32x4*)((const float*)tab + ((size_t)r * 32 + idx) * 2);
            const float x1a = bf2f((unsigned short)(a1 & 0xffff)) * gk[128 + idx] * rk, x1b = bf2f((unsigned short)(a1 >> 16)) * gk[129 + idx] * rk;
            const float x2a = bf2f((unsigned short)(a2 & 0xffff)) * gk[160 + idx] * rk, x2b = bf2f((unsigned short)(a2 >> 16)) * gk[161 + idx] * rk;
            *(unsigned*)(kp + 128 + idx) = pk2(x1a * cs[0] - x2a * cs[1], x1b * cs[2] - x2b * cs[3]);
            *(unsigned*)(kp + 160 + idx) = pk2(x2a * cs[0] + x1a * cs[1], x2b * cs[2] + x1b * cs[3]); EPI_FENCE; }
    }
};
struct PEpiGlu {
    static constexpr bool PERM = true, HAS_MID = false; int tmid; unsigned char* ws;
    __device__ __forceinline__ void operator()(Acc& acc, const pg8::Unit& u, int wr, int wc, int fr, int fq, LAS float* scr) const {
        const bf16_t* G = EB16(WS_G); const float* bias = EFI(24); bf16_t* ycat = EB16(WS_YCAT); float* ssy = EF32(WS_SSY);
        float part[2][4][1];
        EPI_FOR_AM { const int r = PROW(ai, m); float s = 0.f;
#pragma unroll
            for (int bj = 0; bj < 2; ++bj) { const int col = 256 * u.pn + 128 * bj + 32 * wc + 8 * fq; const bf16x8 gb = *(const bf16x8*)(G + (size_t)r * SSMW + col); f32x4 o[2];
#pragma unroll
                for (int n = 0; n < 2; ++n) { const f32x4 bv = *(const f32x4*)(bias + col + 4 * n);
#pragma unroll
                    for (int i = 0; i < 4; ++i) { const float g = bf2f((unsigned short)gb[4 * n + i]); o[n][i] = g / (1.f + __expf(-(acc[ai][bj][m][n][i] + bv[i]))); } s += dot4(o[n]); }
                *(u32x4*)(ycat + (size_t)r * DM + 512 + col) = pack8(o[0], o[1]); }
            part[ai][m][0] = s; }
        xch_rows<1>(part, scr, wr, wc, fr, fq); if (wc == 0 && fq == 0) EPI_FOR_AM ssy[PROW(ai, m) * 8 + 4 + u.pn] = part[ai][m][0];
    }
};
struct PEpiXQ {
    static constexpr bool PERM = true, HAS_MID = false; int tmid; unsigned char* ws;
    __device__ __forceinline__ void operator()(Acc& acc, const pg8::Unit& u, int wr, int wc, int fr, int fq, LAS float* scr) const {
        const float* ss = EF32(WS_SS); bf16_t* XQ = EB16(WS_XQ);
        float part[2][4][2];
        EPI_FOR_AM { const int r = PROW(ai, m); const float rs = rs_from4(ss, r, 1.f / DM);
#pragma unroll
            for (int bj = 0; bj < 2; ++bj) { acc[ai][bj][m][0] = acc[ai][bj][m][0] * rs; acc[ai][bj][m][1] = acc[ai][bj][m][1] * rs; part[ai][m][bj] = dot4(acc[ai][bj][m][0]) + dot4(acc[ai][bj][m][1]); } }
        xch_rows<2>(part, scr, wr, wc, fr, fq);
        const float* gq = EFI(32);
        const f32x4 g0 = *(const f32x4*)(gq + 32 * wc + 8 * fq), g1 = *(const f32x4*)(gq + 32 * wc + 8 * fq + 4);
        EPI_FOR_AM { const int r = PROW(ai, m);
#pragma unroll
            for (int bj = 0; bj < 2; ++bj) { const float rh = rsqrtf(part[ai][m][bj] * (1.f / 128) + EPS) * XSCALE;
                *(u32x4*)(XQ + (size_t)r * 512 + 256 * u.pn + 128 * bj + 32 * wc + 8 * fq) = pack8(acc[ai][bj][m][0] * g0 * rh, acc[ai][bj][m][1] * g1 * rh); } }
    }
};
template <bool WITH_VT> struct PEpiMemKV {
    static constexpr bool PERM = true, HAS_MID = false; int tmid; unsigned char* ws;
    __device__ __forceinline__ void operator()(Acc& acc, const pg8::Unit& u, int wr, int wc, int fr, int fq, LAS float* scr) const {
        const float* ss = EF32(WS_SSMEM); bf16_t* XK = EB16(WS_XK); bf16_t* XV = EB16(WS_XV); bf16_t* XVt = EB16(WS_XVT);
        float part[2][4][2];
        EPI_FOR_AM { const int r = PROW(ai, m); const float rs = rs_from4(ss, r, 1.f / DM);
#pragma unroll
            for (int bj = 0; bj < 2; ++bj) { acc[ai][bj][m][0] = acc[ai][bj][m][0] * rs; acc[ai][bj][m][1] = acc[ai][bj][m][1] * rs; part[ai][m][bj] = dot4(acc[ai][bj][m][0]) + dot4(acc[ai][bj][m][1]); } }
        if (u.pn < 2) {
            xch_rows<2>(part, scr, wr, wc, fr, fq);
            const float* gk = EFI(33);
            const f32x4 g0 = *(const f32x4*)(gk + 32 * wc + 8 * fq), g1 = *(const f32x4*)(gk + 32 * wc + 8 * fq + 4);
            EPI_FOR_AM { const int r = PROW(ai, m);
#pragma unroll
                for (int bj = 0; bj < 2; ++bj) { const float rh = rsqrtf(part[ai][m][bj] * (1.f / 128) + EPS);
                    *(u32x4*)(XK + (size_t)r * 512 + 256 * u.pn + 128 * bj + 32 * wc + 8 * fq) = pack8(acc[ai][bj][m][0] * g0 * rh, acc[ai][bj][m][1] * g1 * rh); } }
        } else {
            EPI_FOR_AM { const int r = PROW(ai, m), b = r / MEML, mm = r % MEML;
#pragma unroll
                for (int bj = 0; bj < 2; ++bj) { const int c0 = 256 * (u.pn - 2) + 128 * bj + 32 * wc + 8 * fq;
                    *(u32x4*)(XV + (size_t)r * 512 + c0) = pack8(acc[ai][bj][m][0], acc[ai][bj][m][1]);
                    if (WITH_VT) {
#pragma unroll
                        for (int n = 0; n < 2; ++n)
#pragma unroll
                            for (int i = 0; i < 4; ++i) { const int c = c0 + 4 * n + i, h = c >> 7, d = c & 127; XVt[((size_t)(b * NH + h) * 128 + d) * MEML + mm] = (bf16_t)f2bf(acc[ai][bj][m][n][i]); } } } }
        }
    }
};
template <int DK, int DVv, bool CAUSAL> __device__ __forceinline__ void attn_simple_vb(int qblk, int bh, int vtid, const bf16_t* Q, const bf16_t* K, const bf16_t* Vt, bf16_t* O, float* ssout, int ldq, int ldk, int ldo, int ssld, int Sq, int Skv) {
    const int lane = vtid & 63, w = vtid >> 6, c = lane & 31, hi = lane >> 5;
    const int b = bh / NH, h = bh % NH, q0 = 128 * qblk + 32 * w;
    const bf16_t* qp = Q + (size_t)(b * Sq + q0 + c) * ldq + h * DK + 8 * hi;
    f32x16 o[DVv / 32];
#pragma unroll
    for (int d = 0; d < DVv / 32; ++d)
#pragma unroll
        for (int r = 0; r < 16; ++r) o[d][r] = 0.f;
    float m = -1e30f, l = 0.f;
    const int ntile = CAUSAL ? (q0 / 32 + 1) : (Skv / 32);
    const bf16_t* kbase = K + (size_t)(b * Skv) * ldk + h * DK + 8 * hi;
    const bf16_t* vbase = Vt + (size_t)bh * DVv * Skv;
    for (int tt = 0; tt < ntile; ++tt) {
        const int key0 = 32 * tt;
        f32x16 p;
#pragma unroll
        for (int r = 0; r < 16; ++r) p[r] = 0.f;
        const bf16_t* kp = kbase + (size_t)(key0 + c) * ldk;
#pragma unroll
        for (int s = 0; s < DK / 16; ++s) { const bf16x8 kf = *(const bf16x8*)(kp + 16 * s); const bf16x8 qf = *(const bf16x8*)(qp + 16 * s); p = __builtin_amdgcn_mfma_f32_32x32x16_bf16(kf, qf, p, 0, 0, 0); }
        if (CAUSAL && tt == ntile - 1) {
#pragma unroll
            for (int r = 0; r < 16; ++r) { const int key = key0 + (r & 3) + 8 * (r >> 2) + 4 * hi; if (key > q0 + c) p[r] = -INFINITY; }
        }
        float tm = p[0];
#pragma unroll
        for (int r = 1; r < 16; ++r) tm = fmaxf(tm, p[r]);
        tm = fmaxf(tm, __shfl_xor(tm, 32));
        const float mn = fmaxf(m, tm), alpha = exp2f(m - mn); m = mn;
        float ps = 0.f;
#pragma unroll
        for (int r = 0; r < 16; ++r) { p[r] = exp2f(p[r] - mn); ps += p[r]; }
        l = l * alpha + ps;
        bf16x8 pf[2];
#pragma unroll
        for (int s = 0; s < 2; ++s)
#pragma unroll
            for (int j = 0; j < 8; ++j) pf[s][j] = (short)f2bf(p[8 * s + j]);
#pragma unroll
        for (int d = 0; d < DVv / 32; ++d) {
#pragma unroll
            for (int r = 0; r < 16; ++r) o[d][r] *= alpha;
            const bf16_t* vp = vbase + (size_t)(32 * d + c) * Skv + key0 + 4 * hi;
#pragma unroll
            for (int s = 0; s < 2; ++s) { const bf16x4 v0 = *(const bf16x4*)(vp + 16 * s), v1 = *(const bf16x4*)(vp + 16 * s + 8);
                const bf16x8 vf = {v0[0], v0[1], v0[2], v0[3], v1[0], v1[1], v1[2], v1[3]};
                o[d] = __builtin_amdgcn_mfma_f32_32x32x16_bf16(vf, pf[s], o[d], 0, 0, 0); }
        }
    }
    l += __shfl_xor(l, 32); const float il = 1.f / l; float ss = 0.f;
    bf16_t* op = O + (size_t)(b * Sq + q0 + c) * ldo + h * DVv;
#pragma unroll
    for (int d = 0; d < DVv / 32; ++d)
#pragma unroll
        for (int g = 0; g < 4; ++g) { f32x4 v = {o[d][4 * g] * il, o[d][4 * g + 1] * il, o[d][4 * g + 2] * il, o[d][4 * g + 3] * il}; ss += dot4(v); st_bf4(op + 32 * d + 8 * g + 4 * hi, v); }
    if (ssout) { ss += __shfl_xor(ss, 32); if (hi == 0) ssout[(size_t)(b * Sq + q0 + c) * ssld + h] = ss; }
}

__device__ __forceinline__ void ssm_seq_wave(int bg, int p, const bf16_t* proj, const float* a_re, const float* a_im, const float* log_dt, const float* b_re, const float* b_im, const float* c_re, const float* c_im, const float* dd, bf16_t* G) {
    const int b = bg / SG, g = bg % SG;
    const float lr = a_re[g * SP + p], li = a_im[g * SP + p], dt = expf(log_dt[g]);
    const float decay = expf(lr * dt); float sn, cs; sincosf(li * dt, &sn, &cs);
    const float ar = decay * cs, ai = decay * sn, den = lr * lr + li * li, nr = ar - 1.f;
    const float cr = (nr * lr + ai * li) / den, ci = (ai * lr - nr * li) / den;
    float bbr[16], bbi[16], ccr[16], cci[16];
#pragma unroll
    for (int h = 0; h < 16; ++h) { const float br = b_re[(g * SP + p) * 16 + h], bi = b_im[(g * SP + p) * 16 + h]; bbr[h] = cr * br - ci * bi; bbi[h] = cr * bi + ci * br;
        ccr[h] = c_re[(g * 16 + h) * SP + p]; cci[h] = c_im[(g * 16 + h) * SP + p]; }
    const float dmy = dd[g * 16 + (p & 15)];
    float xr = 0.f, xi = 0.f;
    for (int t = 0; t < SEQ; ++t) {
        const bf16_t* up = proj + (size_t)(b * SEQ + t) * SSMW + g * 16;
        const bf16x8 u0 = *(const bf16x8*)up, u1 = *(const bf16x8*)(up + 8);
        float u[16];
#pragma unroll
        for (int h = 0; h < 8; ++h) { u[h] = bf2f((unsigned short)u0[h]); u[8 + h] = bf2f((unsigned short)u1[h]); }
        float bur = 0.f, bui = 0.f;
#pragma unroll
        for (int h = 0; h < 16; ++h) { bur += bbr[h] * u[h]; bui += bbi[h] * u[h]; }
        const float nxr = ar * xr - ai * xi + bur, nxi = ar * xi + ai * xr + bui; xr = nxr; xi = nxi;
        float ymine = 0.f;
#pragma unroll
        for (int h = 0; h < 16; ++h) { float v = wave_sum(xr * ccr[h] - xi * cci[h]); if ((p & 15) == h) ymine = v + dmy * u[h]; }
        if (p < 16) { const float y = ymine; const float gl = 0.5f * y * (1.f + tanhf(0.7978845608028654f * (y + 0.044715f * y * y * y)));
            G[(size_t)(b * SEQ + t) * SSMW + g * 16 + p] = (bf16_t)f2bf(gl); }
    }
}
namespace att {
typedef short v4i16_t __attribute__((ext_vector_type(4)));
__device__ __forceinline__ unsigned voff_b(unsigned row, unsigned ch) { return 256u * row + 16u * (ch ^ (((row & 3u) << 2) | ((row >> 2) & 3u))); }
template <int DK> struct Cfg { static constexpr int KB = 64 * DK * 2, VB = 64 * 128 * 2, STG = KB + VB, NPK = KB / 1024, NP = STG / 1024, NPW = NP / 8; };
template <int DK> __device__ __forceinline__ void stage_tile(LAS unsigned char* stg, const bf16_t* Kg, int ldk, const bf16_t* Vg, int ldv, int kt, int wid, int lane) {
    typedef Cfg<DK> C;
#pragma unroll
    for (int i = 0; i < C::NPW; ++i) { const int pi = wid * C::NPW + i;
        const bf16_t* src;
        if (pi < C::NPK) src = Kg + (size_t)(64 * kt + lane) * ldk + 8 * pi;
        else { const unsigned pv = pi - C::NPK, row = 4 * pv + (lane >> 4), chs = lane & 15, ch = chs ^ (((row & 3u) << 2) | ((row >> 2) & 3u)); src = Vg + (size_t)(64 * kt + row) * ldv + 8 * ch; }
        __builtin_amdgcn_global_load_lds((const unsigned*)src, (LAS unsigned*)(stg + pi * 1024), 16, 0, 0); }
}
template <int DK, bool CAUSAL> __device__ __forceinline__ void attn_wg(int tid, LAS unsigned char* ring, const bf16_t* Qbh, int ldq, const bf16_t* Kbh, int ldk, const bf16_t* Vbh, int ldv, bf16_t* Obh, int ldo, float* ssout, int ssld, int qrow_w, int nt_w, int nt_max) {
    typedef Cfg<DK> C; constexpr float THR = 8.f;
    const int lane = tid & 63, wid = __builtin_amdgcn_readfirstlane(tid >> 6), c = lane & 31, hi = lane >> 5;
    stage_tile<DK>(ring, Kbh, ldk, Vbh, ldv, 0, wid, lane);
    if (nt_max > 1) stage_tile<DK>(ring + C::STG, Kbh, ldk, Vbh, ldv, 1, wid, lane);
    bf16x8 qf[DK / 16];
    { const bf16_t* qp = Qbh + (size_t)(qrow_w + c) * ldq + 8 * hi;
#pragma unroll
      for (int s = 0; s < DK / 16; ++s) qf[s] = *(const bf16x8*)(qp + 16 * s); }
    f32x16 o[4];
#pragma unroll
    for (int d = 0; d < 4; ++d)
#pragma unroll
        for (int r = 0; r < 16; ++r) o[d][r] = 0.f;
    float m = -1e30f, l = 0.f;
    const int qrow = qrow_w + c;
    const unsigned q4 = (lane & 15) >> 2, p4 = lane & 3, blk = (lane >> 4) & 1, cl = 2 * blk + (p4 >> 1);
    const unsigned vbase0 = 256u * (4 * hi + q4) + 16u * (cl ^ (unsigned)hi) + 8u * (p4 & 1), vbase1 = 2048u + 256u * (4 * hi + q4) + 16u * (cl ^ (2u + (unsigned)hi)) + 8u * (p4 & 1);
    f32x16 zero16;
#pragma unroll
    for (int r = 0; r < 16; ++r) zero16[r] = 0.f;
    int st = 0;
    for (int t = 0; t < nt_max; ++t) {
        if (t + 1 < nt_max) asm volatile("s_waitcnt vmcnt(%0)" :: "n"(C::NPW) : "memory"); else asm volatile("s_waitcnt vmcnt(0)" ::: "memory");
        asm volatile("s_waitcnt lgkmcnt(0)" ::: "memory"); __builtin_amdgcn_s_barrier(); asm volatile("" ::: "memory");
        if (t + 2 < nt_max) { const int st2 = (st == 0) ? 2 : st - 1; stage_tile<DK>(ring + st2 * C::STG, Kbh, ldk, Vbh, ldv, t + 2, wid, lane); }
        if (t < nt_w) {
            LAS unsigned char* stg = ring + st * C::STG;
            f32x16 p0, p1;
            { const LAS unsigned char* kp = stg + hi * 1024 + c * 16; bf16x8 ka[4], kb[4];
#define ATT_KLD(dst, s) do { dst[0] = *(const LAS bf16x8*)(kp + (s) * 2048); dst[1] = *(const LAS bf16x8*)(kp + (s) * 2048 + 512); dst[2] = *(const LAS bf16x8*)(kp + (s) * 2048 + 2048); dst[3] = *(const LAS bf16x8*)(kp + (s) * 2048 + 2560); } while (0)
#define ATT_MM(k, s) do { p0 = __builtin_amdgcn_mfma_f32_32x32x16_bf16(k[0], qf[s], p0, 0, 0, 0); p1 = __builtin_amdgcn_mfma_f32_32x32x16_bf16(k[1], qf[s], p1, 0, 0, 0); \
                          p0 = __builtin_amdgcn_mfma_f32_32x32x16_bf16(k[2], qf[(s) + 1], p0, 0, 0, 0); p1 = __builtin_amdgcn_mfma_f32_32x32x16_bf16(k[3], qf[(s) + 1], p1, 0, 0, 0); } while (0)
#define ATT_SB __builtin_amdgcn_sched_barrier(0)
              ATT_KLD(ka, 0); ATT_SB; ATT_KLD(kb, 2); ATT_SB;
              p0 = __builtin_amdgcn_mfma_f32_32x32x16_bf16(ka[0], qf[0], zero16, 0, 0, 0); p1 = __builtin_amdgcn_mfma_f32_32x32x16_bf16(ka[1], qf[0], zero16, 0, 0, 0);
              p0 = __builtin_amdgcn_mfma_f32_32x32x16_bf16(ka[2], qf[1], p0, 0, 0, 0); p1 = __builtin_amdgcn_mfma_f32_32x32x16_bf16(ka[3], qf[1], p1, 0, 0, 0); ATT_SB;
              ATT_KLD(ka, 4); ATT_SB; ATT_MM(kb, 2); ATT_SB;
              ATT_KLD(kb, 6); ATT_SB; ATT_MM(ka, 4); ATT_SB;
              if (DK == 192) { ATT_KLD(ka, 8); ATT_SB; ATT_MM(kb, 6); ATT_SB; ATT_KLD(kb, 10); ATT_SB; ATT_MM(ka, 8); ATT_SB; ATT_MM(kb, 10); ATT_SB; }
              else { ATT_MM(kb, 6); ATT_SB; }
            }
            if (CAUSAL && (64 * t + 63 > qrow_w)) {
#pragma unroll
                for (int r = 0; r < 16; ++r) { const int key = 64 * t + (r & 3) + 8 * (r >> 2) + 4 * hi; if (key > qrow) p0[r] = -INFINITY; if (key + 32 > qrow) p1[r] = -INFINITY; } }
            float tm = fmaxf(p0[0], p1[0]);
#pragma unroll
            for (int r = 1; r < 16; ++r) tm = fmaxf(tm, fmaxf(p0[r], p1[r]));
            tm = fmaxf(tm, __shfl_xor(tm, 32));
            if (__any(tm > m + THR)) {
                const float mn = fmaxf(m, tm), alpha = __builtin_amdgcn_exp2f(m - mn); m = mn; l *= alpha;
#pragma unroll
                for (int d0 = 0; d0 < 4; ++d0)
#pragma unroll
                    for (int r = 0; r < 16; ++r) o[d0][r] *= alpha; }
            float ps = 0.f;
#pragma unroll
            for (int r = 0; r < 16; ++r) { p0[r] = __builtin_amdgcn_exp2f(p0[r] - m); p1[r] = __builtin_amdgcn_exp2f(p1[r] - m); ps += p0[r] + p1[r]; }
            l += ps;
            bf16x8 pf[4];
#pragma unroll
            for (int ks = 0; ks < 4; ++ks) { u32x4 w;
                if (ks < 2) { w.x = pk2(p0[8 * ks], p0[8 * ks + 1]); w.y = pk2(p0[8 * ks + 2], p0[8 * ks + 3]); w.z = pk2(p0[8 * ks + 4], p0[8 * ks + 5]); w.w = pk2(p0[8 * ks + 6], p0[8 * ks + 7]); }
                else { const int b = 8 * (ks - 2); w.x = pk2(p1[b], p1[b + 1]); w.y = pk2(p1[b + 2], p1[b + 3]); w.z = pk2(p1[b + 4], p1[b + 5]); w.w = pk2(p1[b + 6], p1[b + 7]); }
                pf[ks] = __builtin_bit_cast(bf16x8, w); }
            { const LAS unsigned char* vt = stg + C::KB; v4i16_t va[8], vb[8];
#define ATT_VLD(dst, d0) do { _Pragma("unroll") for (int ks = 0; ks < 4; ++ks) { \
                  dst[2 * ks] = __builtin_amdgcn_ds_read_tr16_b64_v4i16((LAS v4i16_t*)(vt + vbase0 + 64u * ((unsigned)(d0) ^ q4) + 4096u * ks)); \
                  dst[2 * ks + 1] = __builtin_amdgcn_ds_read_tr16_b64_v4i16((LAS v4i16_t*)(vt + vbase1 + 64u * ((unsigned)(d0) ^ q4) + 4096u * ks)); } } while (0)
#define ATT_PV(v, d0) do { _Pragma("unroll") for (int ks = 0; ks < 4; ++ks) { const bf16x8 vf = {v[2 * ks][0], v[2 * ks][1], v[2 * ks][2], v[2 * ks][3], v[2 * ks + 1][0], v[2 * ks + 1][1], v[2 * ks + 1][2], v[2 * ks + 1][3]}; \
                  o[d0] = __builtin_amdgcn_mfma_f32_32x32x16_bf16(vf, pf[ks], o[d0], 0, 0, 0); } } while (0)
              ATT_VLD(va, 0); ATT_SB; ATT_VLD(vb, 1); ATT_SB; ATT_PV(va, 0); ATT_SB; ATT_VLD(va, 2); ATT_SB; ATT_PV(vb, 1); ATT_SB; ATT_VLD(vb, 3); ATT_SB; ATT_PV(va, 2); ATT_SB; ATT_PV(vb, 3); ATT_SB;
            }
        }
        st = (st == 2) ? 0 : st + 1;
    }
    l += __shfl_xor(l, 32); const float il = 1.f / l; float ss = 0.f;
    bf16_t* op = Obh + (size_t)(qrow_w + c) * ldo;
#pragma unroll
    for (int d = 0; d < 4; ++d)
#pragma unroll
        for (int g = 0; g < 4; ++g) { f32x4 v = {o[d][4 * g] * il, o[d][4 * g + 1] * il, o[d][4 * g + 2] * il, o[d][4 * g + 3] * il}; ss += dot4(v); st_bf4(op + 32 * d + 8 * g + 4 * hi, v); }
    if (ssout) { ss += __shfl_xor(ss, 32); if (hi == 0) ssout[(size_t)(qrow_w + c) * ssld] = ss; }
    asm volatile("s_waitcnt lgkmcnt(0)" ::: "memory"); __builtin_amdgcn_s_barrier(); asm volatile("" ::: "memory");
}
}

constexpr int NTHREADS_C = 512;
constexpr int SSM_UL = 0, SSM_UL_STRIDE = 1040, SSM_KTL = 66560, SSM_SL = SSM_KTL + 16384, SSM_XPL = 140288, SSM_XP_STRIDE = 272;
__device__ __forceinline__ void pow_entry(float lr, float li, double dt, int n, float& re, float& im) {
    double a = (double)li * dt * (double)n; a -= 6.283185307179586 * rint(a * 0.15915494309189535); float sn, cs; __sincosf((float)a, &sn, &cs); const float mag = __expf((float)((double)lr * dt * (double)n)); re = mag * cs; im = mag * sn;
}
__device__ __forceinline__ void ssm_tables_item(int item, int tid, unsigned char* ldsb, unsigned char* ws) {
    const int g = item >> 3, part = item & 7;
    float2* pw = (float2*)ldsb;
    float2* bb = pw + 64 * 33;
    float2* cc = bb + 64 * 16;
    const float* a_re = EFI(15); const float* a_im = EFI(16); const float* log_dt = EFI(17);
    const double dt = exp((double)log_dt[g]);
    for (int e = tid; e < 64 * 33; e += NTHREADS_C) { const int p = e / 33, n = e % 33; float re, im; pow_entry(a_re[g * SP + p], a_im[g * SP + p], dt, n, re, im); pw[e] = make_float2(re, im); }
    { const float* b_re = EFI(18); const float* b_im = EFI(19);
      for (int e = tid; e < 64 * 16; e += NTHREADS_C) { const int p = e >> 4, h = e & 15; const float lr = a_re[g * SP + p], li = a_im[g * SP + p];
        float ar, ai; pow_entry(lr, li, dt, 1, ar, ai); const float den = lr * lr + li * li, nr = ar - 1.f;
        const float cr = (nr * lr + ai * li) / den, ci = (ai * lr - nr * li) / den; const float br = b_re[(g * SP + p) * 16 + h], bi = b_im[(g * SP + p) * 16 + h];
        bb[e] = make_float2(cr * br - ci * bi, cr * bi + ci * br); } }
    { const float* c_re = EFI(20); const float* c_im = EFI(21);
      for (int e = tid; e < 16 * 64; e += NTHREADS_C) cc[e] = make_float2(c_re[g * 16 * SP + e], c_im[g * 16 * SP + e]); }
    __syncthreads();
    if (part < 4) {
        const int hh = tid & 255, h = hh >> 4, h2 = hh & 15, tau0 = 8 * part + 4 * (tid >> 8);
        float acc[4];
#pragma unroll
        for (int j = 0; j < 4; ++j) acc[j] = 0.f;
        for (int p = 0; p < 64; ++p) { const float2 b = bb[p * 16 + h2], cv = cc[h * 64 + p];
#pragma unroll
            for (int j = 0; j < 4; ++j) { const float2 w = pw[p * 33 + tau0 + j]; const float wr = w.x * b.x - w.y * b.y, wi = w.x * b.y + w.y * b.x; acc[j] += cv.x * wr - cv.y * wi; } }
        if (tau0 == 0 && h == h2) acc[0] += EFI(22)[g * 16 + h];
        bf16_t* KT = EB16(WS_KT) + (size_t)g * 8192;
#pragma unroll
        for (int j = 0; j < 4; ++j) KT[((tau0 + j) * 16 + h) * 16 + h2] = (bf16_t)f2bf(acc[j]);
    } else if (part < 6) {
        bf16_t* BsT = EB16(WS_BST) + (size_t)g * 65536; const int k = tid, s = k >> 4, h2 = k & 15;
        for (int n = 64 * (part - 4); n < 64 * (part - 3); ++n) { const int p = n & 63; const float2 w = pw[p * 33 + 31 - s], b = bb[p * 16 + h2];
            const float v = (n < 64) ? (w.x * b.x - w.y * b.y) : (w.x * b.y + w.y * b.x); BsT[n * 512 + k] = (bf16_t)f2bf(v); }
    } else {
        bf16_t* CmT = EB16(WS_CMT) + (size_t)g * 65536; const int k = tid & 127, p = k & 63;
        for (int j = 0; j < 64; ++j) { const int n = 256 * (part - 6) + (tid >> 7) + 4 * j, t = n >> 4, h = n & 15; const float2 w = pw[p * 33 + t + 1], cv = cc[h * 64 + p];
            const float v = (k < 64) ? (cv.x * w.x - cv.y * w.y) : -(cv.x * w.y + cv.y * w.x); CmT[n * 128 + k] = (bf16_t)f2bf(v); }
    }
    __syncthreads();
}
__device__ __forceinline__ float gelu_tanh(float y) { const float z = 0.7978845608028654f * (y + 0.044715f * y * y * y); return y / (1.f + __expf(-2.f * z)); }
__device__ __forceinline__ void ssm_unit(int bg, int tid, LAS unsigned char* L, unsigned char* ws) {
    const int b = bg >> 5, g = bg & 31, lane = tid & 63, wid = __builtin_amdgcn_readfirstlane(tid >> 6), fr = lane & 15, fq = lane >> 4;
    const bf16_t* U = EB16(WS_U) + (size_t)b * SEQ * SSMW + g * 16;
    const bf16_t* BsT = EB16(WS_BST) + (size_t)g * 65536; const bf16_t* CmT = EB16(WS_CMT) + (size_t)g * 65536;
    bf16_t* Gout = EB16(WS_G) + (size_t)b * SEQ * SSMW + g * 16;
    { const u32x4* src = (const u32x4*)(EB16(WS_KT) + (size_t)g * 8192); LAS u32x4* dst = (LAS u32x4*)(L + SSM_KTL); dst[tid] = src[tid]; dst[tid + NTHREADS_C] = src[tid + NTHREADS_C]; }
    float xr = 0.f, xi = 0.f, Ar = 0.f, Ai = 0.f;
    if (wid == 0) pow_entry(EFI(15)[g * SP + lane], EFI(16)[g * SP + lane], exp((double)EFI(17)[g]), 32, Ar, Ai);
    const int tl0 = wid, tl1 = 15 - wid, tl2 = 16 + wid, tl3 = 31 - wid;
#define SSM_T(tt) ((tt) == 0 ? tl0 : (tt) == 1 ? tl1 : (tt) == 2 ? tl2 : tl3)
    bf16x8 cfr[4][4];
#pragma unroll
    for (int ks = 0; ks < 4; ++ks)
#pragma unroll
        for (int tt = 0; tt < 4; ++tt) cfr[ks][tt] = *(const bf16x8*)(CmT + (size_t)(SSM_T(tt) * 16 + fr) * 128 + 32 * ks + 8 * fq);
#pragma unroll 1
    for (int hf = 0; hf < 2; ++hf) {
#pragma unroll
        for (int i = 0; i < 4; ++i) { const int row = tid + NTHREADS_C * i; const u32x4* s = (const u32x4*)(U + (size_t)(hf * 2048 + row) * SSMW); LAS unsigned char* d = L + SSM_UL + (row >> 5) * SSM_UL_STRIDE + (row & 31) * 32;
            const u32x4 v0 = s[0], v1 = s[1]; *(LAS u32x4*)d = v0; *(LAS u32x4*)(d + 16) = v1; }
        __syncthreads();
        { f32x4 sacc[4]; bf16x8 bfr[16];
#pragma unroll
          for (int ks = 0; ks < 16; ++ks) bfr[ks] = *(const bf16x8*)(BsT + (size_t)(16 * wid + fr) * 512 + 32 * ks + 8 * fq);
#pragma unroll
          for (int mf = 0; mf < 4; ++mf) sacc[mf] = (f32x4){0.f, 0.f, 0.f, 0.f};
#pragma unroll
          for (int ks = 0; ks < 16; ++ks) {
#pragma unroll
              for (int mf = 0; mf < 4; ++mf) { const bf16x8 afr = *(const LAS bf16x8*)(L + SSM_UL + (16 * mf + fr) * SSM_UL_STRIDE + (2 * ks + (fq >> 1)) * 32 + (fq & 1) * 16);
                  sacc[mf] = __builtin_amdgcn_mfma_f32_16x16x32_bf16(bfr[ks], afr, sacc[mf], 0, 0, 0); } }
#pragma unroll
          for (int mf = 0; mf < 4; ++mf) *(LAS f32x4*)(L + SSM_SL + ((16 * mf + fr) * 128 + 16 * wid + 4 * fq) * 4) = sacc[mf]; }
        __syncthreads();
        if (wid == 0) { const LAS float* S = (const LAS float*)(L + SSM_SL);
#pragma unroll 1
            for (int c0 = 0; c0 < 64; c0 += 8) { float sr[8], si[8];
#pragma unroll
                for (int i = 0; i < 8; ++i) { sr[i] = S[(c0 + i) * 128 + lane]; si[i] = S[(c0 + i) * 128 + 64 + lane]; }
#pragma unroll
                for (int i = 0; i < 8; ++i) { LAS bf16_t* xp = (LAS bf16_t*)(L + SSM_XPL + (c0 + i) * SSM_XP_STRIDE); xp[lane] = (bf16_t)f2bf(xr); xp[64 + lane] = (bf16_t)f2bf(xi);
                    const float nr = Ar * xr - Ai * xi + sr[i], ni = Ar * xi + Ai * xr + si[i]; xr = nr; xi = ni; } } }
        f32x4 acc[4][4];
#pragma unroll
        for (int tt = 0; tt < 4; ++tt)
#pragma unroll
            for (int mf = 0; mf < 4; ++mf) acc[tt][mf] = (f32x4){0.f, 0.f, 0.f, 0.f};
#pragma unroll 2
        for (int ks = 0; ks < 16; ++ks) { if (2 * ks > tl3) break;
            bf16x8 afr[4];
#pragma unroll
            for (int mf = 0; mf < 4; ++mf) afr[mf] = *(const LAS bf16x8*)(L + SSM_UL + (16 * mf + fr) * SSM_UL_STRIDE + (2 * ks + (fq >> 1)) * 32 + (fq & 1) * 16);
#pragma unroll
            for (int tt = 0; tt < 4; ++tt) { const int t = SSM_T(tt);
                if (2 * ks <= t) { const int tau = t - 2 * ks - (fq >> 1); bf16x8 bfr = {0, 0, 0, 0, 0, 0, 0, 0};
                    if (tau >= 0) bfr = *(const LAS bf16x8*)(L + SSM_KTL + ((tau * 16 + fr) * 16 + 8 * (fq & 1)) * 2);
#pragma unroll
                    for (int mf = 0; mf < 4; ++mf) acc[tt][mf] = __builtin_amdgcn_mfma_f32_16x16x32_bf16(bfr, afr[mf], acc[tt][mf], 0, 0, 0); } } }
        __syncthreads();
#pragma unroll
        for (int ks = 0; ks < 4; ++ks) { bf16x8 afr[4];
#pragma unroll
            for (int mf = 0; mf < 4; ++mf) afr[mf] = *(const LAS bf16x8*)(L + SSM_XPL + (16 * mf + fr) * SSM_XP_STRIDE + (32 * ks + 8 * fq) * 2);
#pragma unroll
            for (int tt = 0; tt < 4; ++tt) {
#pragma unroll
                for (int mf = 0; mf < 4; ++mf) acc[tt][mf] = __builtin_amdgcn_mfma_f32_16x16x32_bf16(cfr[ks][tt], afr[mf], acc[tt][mf], 0, 0, 0); } }
#pragma unroll
        for (int tt = 0; tt < 4; ++tt) { const int t = SSM_T(tt);
#pragma unroll
            for (int mf = 0; mf < 4; ++mf) { f32x4 v = acc[tt][mf];
#pragma unroll
                for (int i = 0; i < 4; ++i) v[i] = gelu_tanh(v[i]);
                st_bf4(Gout + (size_t)(hf * 2048 + (16 * mf + fr) * 32 + t) * SSMW + 4 * fq, v); } }
        __syncthreads();
    }
#undef SSM_T
}

constexpr int NWAVES = 8, NTHREADS = NWAVES * 64;
constexpr int RING_BYTES = 131072, LDSCTL_OFF = RING_BYTES, MISC_OFF = LDSCTL_OFF + 320, SCR_OFF = RING_BYTES + 1024, LDS_BYTES = 163840;
constexpr size_t CTL_ZERO_BYTES = 64 * 1024;
constexpr int CW_BAR = 1024;
#define RLX_AGENT __ATOMIC_RELAXED, __HIP_MEMORY_SCOPE_AGENT
#define XB_TMO      128
#define XB_XCNT(j)  (256  + 64 * (j))
#define XB_XSUB(j)  (1280 + 64 * (j))
#define XB_XGEN(j)  (2304 + 64 * (j))
#define XB_TOP      3328
#define XB_TOPGEN   3392
#define XCD_BAR_WORDS 3456
#define XB_SPIN_CAP (1u << 24)
static_assert((CW_BAR + XCD_BAR_WORDS) * 4 <= (int)CTL_ZERO_BYTES, "barrier words inside the memset region");
__device__ __forceinline__ unsigned xb_ld(unsigned* p)              { return __hip_atomic_load(p, __ATOMIC_RELAXED, __HIP_MEMORY_SCOPE_AGENT); }
__device__ __forceinline__ unsigned xb_add(unsigned* p, unsigned v) { return __hip_atomic_fetch_add(p, v, __ATOMIC_RELAXED, __HIP_MEMORY_SCOPE_AGENT); }
__device__ __forceinline__ unsigned xb_xcc_id() { return (unsigned)__builtin_amdgcn_s_getreg((3 << 11) | 20) & 0xFu; }
#define XB_SPIN(cond, bar) do { unsigned _sp = 0; while (cond) { __builtin_amdgcn_s_sleep(1); \
    if ((++_sp & 255u) == 0u) { if (xb_ld(&(bar)[XB_TMO])) break; if (_sp > XB_SPIN_CAP) { atomicAdd(&(bar)[XB_TMO], 1u); break; } } } } while (0)
struct XcdBarrier { unsigned* bar; unsigned x; volatile LAS unsigned* st; };
__device__ __forceinline__ XcdBarrier xcd_barrier_post(unsigned* bar, volatile LAS unsigned* st) {
    XcdBarrier b; b.bar = bar; b.x = xb_xcc_id(); b.st = st;
    if (threadIdx.x == 0) (void)xb_add(&bar[XB_XCNT(b.x)], 1u);
    return b;
}
__device__ __forceinline__ void xcd_barrier_complete(unsigned* bar, unsigned x, unsigned& nloc, unsigned& nx) {
    const unsigned G = gridDim.x * gridDim.y * gridDim.z;
    unsigned sum, cnt, mine, sp = 0u;
    for (;;) {
        sum = 0u; cnt = 0u; mine = 0u;
#pragma unroll
        for (unsigned j = 0; j < 16; ++j) { const unsigned c = xb_ld(&bar[XB_XCNT(j)]); sum += c; cnt += (c > 0u) ? 1u : 0u; mine = (j == x) ? c : mine; }
        if (sum == G) break;
        __builtin_amdgcn_s_sleep(1);
        if ((++sp & 255u) == 0u) { if (xb_ld(&bar[XB_TMO])) break; if (sp > XB_SPIN_CAP) { atomicAdd(&bar[XB_TMO], 1u); break; } }
    }
    nloc = mine > 0u ? mine : 1u; nx = cnt > 0u ? cnt : 1u;
}
__device__ __forceinline__ void xcd_barrier(const XcdBarrier& b) {
    asm volatile("s_waitcnt vmcnt(0)" ::: "memory");
    __syncthreads();
    if (threadIdx.x == 0) {
        unsigned* bar = b.bar;
        __builtin_amdgcn_s_waitcnt(0);
        unsigned nloc = b.st[0], nx = b.st[1];
        if (nloc == 0u) { xcd_barrier_complete(bar, b.x, nloc, nx); b.st[0] = nloc; b.st[1] = nx; }
        const unsigned old = xb_add(&bar[XB_XSUB(b.x)], 1u);
        const unsigned gen = old / nloc;
        if (old + 1u == (gen + 1u) * nloc) {
            __builtin_amdgcn_fence(__ATOMIC_RELEASE, "agent");
            asm volatile("s_waitcnt vmcnt(0)" ::: "memory");
            const unsigned og = xb_add(&bar[XB_TOP], 1u);
            const unsigned tg = og / nx;
            if (og + 1u == (tg + 1u) * nx) xb_add(&bar[XB_TOPGEN], 1u);
            else XB_SPIN(xb_ld(&bar[XB_TOPGEN]) == tg, bar);
            __builtin_amdgcn_fence(__ATOMIC_ACQUIRE, "agent");
            xb_add(&bar[XB_XGEN(b.x)], 1u);
            asm volatile("s_waitcnt vmcnt(0)" ::: "memory");
        } else {
            XB_SPIN(xb_ld(&bar[XB_XGEN(b.x)]) == gen, bar);
            __builtin_amdgcn_fence(__ATOMIC_ACQUIRE, "agent");
            asm volatile("s_waitcnt vmcnt(0)" ::: "memory");
        }
    }
    __syncthreads();
}

constexpr int REP5A = 1, REP5S = 1; constexpr int REP0 = 1; constexpr int REP1 = 1; constexpr int REP2 = 1; constexpr int REP3 = 1; constexpr int REP4 = 1; constexpr int REP5 = 1; constexpr int REP6 = 1; constexpr int REP7 = 1; constexpr int REP8 = 1; constexpr int REP9 = 1; constexpr int REP10 = 1; constexpr int REP11 = 1;
#define FI(i) ((const float*)karg(i))
#define KOUT() ((float*)karg(39))
#define KWS() ((unsigned char*)karg(40))
#define B16(off) ((bf16_t*)(ws + (off)))
#define F32(off) ((float*)(ws + (off)))
#define PHASE_IDS() int tid = threadIdx.x; asm volatile("" : "+v"(tid)); const int lane = tid & 63, wave = __builtin_amdgcn_readfirstlane(tid >> 6), half = tid >> 8, vtid = tid & 255; \
    const int G = gridDim.x, bid = blockIdx.x; unsigned char* ws = KWS(); (void)lane; (void)wave; (void)half; (void)vtid; (void)G; (void)bid; (void)ws
#define FOR_VB(vb, n) for (int vb = 2 * bid + half; vb < (n); vb += 2 * G)
#define RING ((LAS unsigned char*)lds)
#define SCR ((LAS float*)(lds + SCR_OFF))
__global__ void __launch_bounds__(NTHREADS, 2) fwd_megakernel(Params P) {
    extern __shared__ __attribute__((aligned(16))) unsigned char lds[];
    { const int tid0 = threadIdx.x; for (int u = tid0; u < (LDS_BYTES - LDSCTL_OFF) / 4; u += NTHREADS) ((unsigned*)(lds + LDSCTL_OFF))[u] = 0u; }
    __syncthreads();
    XcdBarrier bar = xcd_barrier_post((unsigned*)(KWS() + WS_CTL) + CW_BAR, (volatile LAS unsigned*)(lds + MISC_OFF) + 8);
#define GRID_BAR() xcd_barrier(bar)

#pragma unroll 1
    for (int rep = 0; rep < REP0; ++rep) {
    { PHASE_IDS();
        LAS float* scr = (LAS float*)(lds + wave * 8448);
        convert_subset(WM_P0, bid * NWAVES + wave, G * NWAVES, lane, scr, ws);
        for (int idx = bid * NWAVES + wave; idx < NP0_ITEMS; idx += G * NWAVES) {
            if (idx < NROW_ITEMS) { const int r0 = 8 * idx; const float* x = FI(0);
#pragma unroll 2
                for (int j = 0; j < 8; ++j) row_to_bf16(x, B16(WS_XB), F32(WS_SS), r0 + j, lane); }
            else if (idx < NROW_ITEMS + NMEM_ITEMS) { const int r0 = 8 * (idx - NROW_ITEMS); const float* mem = FI(1);
                for (int j = 0; j < 8; ++j) row_to_bf16(mem, B16(WS_MEMB), F32(WS_SSMEM), r0 + j, lane); }
            else { const int e0 = 512 * (idx - NROW_ITEMS - NMEM_ITEMS); const int* pos = (const int*)karg(2);
                for (int j = 0; j < 8; ++j) rope_entry(pos, (float2*)(ws + WS_ROPE), e0 + 64 * j + lane); }
        }
    }
    GRID_BAR(); }
#pragma unroll 1
    for (int rep = 0; rep < REP1; ++rep) {
    { PHASE_IDS(); pg8::Gemm g{B16(WS_XB), B16(WS_W1T), DM, DM, T, NUP}; pg8::StaticOrder S; S.init(T, NUP, G, bid);
      const PEpiUp<1> e{0, ws}; pg8::gemm_phase(tid, RING, SCR, g, S, e); }
    GRID_BAR(); }
#pragma unroll 1
    for (int rep = 0; rep < REP2; ++rep) {
    { PHASE_IDS(); pg8::Gemm g{B16(WS_H), B16(WS_WD1T), DFFP, DFFP, T, DM}; pg8::StaticOrder S; S.init(T, DM, G, bid);
      const PEpiRes<0> e{0, ws}; pg8::gemm_phase(tid, RING, SCR, g, S, e); }
    GRID_BAR(); }
#pragma unroll 1
    for (int rep = 0; rep < REP3; ++rep) {
    { PHASE_IDS(); pg8::Gemm g{B16(WS_XB), B16(WS_WINT), DM, DM, T, NIN}; pg8::StaticOrder S; S.init(T, NIN, G, bid);
      const PEpiIn e{0, ws}; pg8::gemm_phase(tid, RING, SCR, g, S, e); }
    { PHASE_IDS(); pg8::Gemm g{B16(WS_MEMB), B16(WS_WXKVT), DM, DM, TM, DM}; pg8::StaticOrder S; S.init(TM, DM, G, (bid >= 64 && bid < 80) ? bid - 64 : -1); S.G = 16;
      const PEpiMemKV<false> e{0, ws}; pg8::gemm_phase(tid, RING, SCR, g, S, e); }
    { PHASE_IDS(); if (G > 80 && bid >= 80) for (int it = bid - 80; it < 8 * SG; it += G - 80) ssm_tables_item(it, tid, lds, ws);
      if (G <= 80) for (int it = bid; it < 8 * SG; it += G) ssm_tables_item(it, tid, lds, ws); }
    GRID_BAR(); }
#pragma unroll 1
    for (int rep = 0; rep < REP4; ++rep) {
    { PHASE_IDS(); pg8::Gemm g{B16(WS_CQ), B16(WS_WUQT), QRANK, QRANK, T, 1024}; pg8::StaticOrder S; S.init(T, 1024, G, bid);
      const PEpiQ e{0, ws}; pg8::gemm_phase(tid, RING, SCR, g, S, e); }
    { PHASE_IDS(); pg8::Gemm g{B16(WS_CKV), B16(WS_WUKVT), KVRANK, KVRANK, T, 1024}; pg8::StaticOrder S; S.init(T, 1024, G, bid);
      const PEpiKV<false> e{0, ws}; pg8::gemm_phase(tid, RING, SCR, g, S, e); }
    GRID_BAR(); }
#pragma unroll 1
    for (int rep = 0; rep < REP5; ++rep) {
    { PHASE_IDS(); const int vcu = (G % 8 == 0) ? (bid % 8) * (G / 8) + bid / 8 : bid;
#pragma unroll 1
      for (int rr = 0; rr < REP5A; ++rr)
      for (int v = vcu; v < 256; v += G) { const int bh = v >> 4, j = v & 15, b = bh / NH, h = bh % NH;
          const int wq = wave >> 1, qblk = (wq == 0) ? j : (wq == 1) ? 31 - j : (wq == 2) ? 63 - j : 32 + j;
          att::attn_wg<DQK, true>(tid, RING, B16(WS_Q) + (size_t)b * SEQ * (NH * DQK) + DQK * h, NH * DQK, B16(WS_K) + (size_t)b * SEQ * (NH * DQK) + DQK * h, NH * DQK, B16(WS_V) + (size_t)b * SEQ * 512 + DV * h, 512,
                                  B16(WS_YCAT) + (size_t)b * SEQ * DM + DV * h, DM, F32(WS_SSY) + (size_t)b * SEQ * 8 + h, 8, 64 * qblk + 32 * (wave & 1), qblk + 1, 64 - j); } }
    { PHASE_IDS(); const int vcu = (G % 8 == 0) ? (bid % 8) * (G / 8) + bid / 8 : bid;
#pragma unroll 1
      for (int rr = 0; rr < REP5S; ++rr)
      for (int v = vcu; v < 256; v += G) if ((v & 15) >= 8) ssm_unit((v >> 4) * 8 + (v & 15) - 8, tid, RING, ws); }
    GRID_BAR(); }
#pragma unroll 1
    for (int rep = 0; rep < REP6; ++rep) {
    { PHASE_IDS(); pg8::Gemm g{B16(WS_G), B16(WS_WGLUT), SSMW, SSMW, T, SSMW}; pg8::StaticOrder S; S.init(T, SSMW, G, bid);
      const PEpiGlu e{0, ws}; pg8::gemm_phase(tid, RING, SCR, g, S, e); }
    { PHASE_IDS(); const int nun = (T / 256) * (SSMW / 256);
      if (G > nun) { if (bid >= nun) convert_subset(WM_P6, (bid - nun) * NWAVES + wave, (G - nun) * NWAVES, lane, (LAS float*)(lds + wave * 8448), ws); }
      else convert_subset(WM_P6, bid * NWAVES + wave, G * NWAVES, lane, (LAS float*)(lds + wave * 8448), ws); }
    GRID_BAR(); }
#pragma unroll 1
    for (int rep = 0; rep < REP7; ++rep) {
    { PHASE_IDS(); pg8::Gemm g{B16(WS_YCAT), B16(WS_WOT), DM, DM, T, DM}; pg8::StaticOrder S; S.init(T, DM, G, bid);
      const PEpiWo e{8, ws}; pg8::gemm_phase(tid, RING, SCR, g, S, e); }
    GRID_BAR(); }
#pragma unroll 1
    for (int rep = 0; rep < REP8; ++rep) {
    { PHASE_IDS(); pg8::Gemm g{B16(WS_XB), B16(WS_WXQT), DM, DM, T, 512}; pg8::StaticOrder S; S.init(T, 512, G, bid);
      const PEpiXQ e{0, ws}; pg8::gemm_phase(tid, RING, SCR, g, S, e); }
    { PHASE_IDS(); const int nun = (T / 256) * (512 / 256);
      if (G > nun) { if (bid >= nun) convert_subset(WM_P8, (bid - nun) * NWAVES + wave, (G - nun) * NWAVES, lane, (LAS float*)(lds + wave * 8448), ws); }
      else convert_subset(WM_P8, bid * NWAVES + wave, G * NWAVES, lane, (LAS float*)(lds + wave * 8448), ws); }
    GRID_BAR(); }
#pragma unroll 1
    for (int rep = 0; rep < REP9; ++rep) {
    { PHASE_IDS(); const int vcu = (G % 8 == 0) ? (bid % 8) * (G / 8) + bid / 8 : bid;
      for (int v = vcu; v < 256; v += G) { const int bh = v >> 4, qb = v & 15, b = bh / NH, h = bh % NH; const size_t row0 = (size_t)b * SEQ + 256 * qb;
        att::attn_wg<128, false>(tid, RING, B16(WS_XQ) + (size_t)b * SEQ * 512 + 128 * h, 512, B16(WS_XK) + (size_t)b * MEML * 512 + 128 * h, 512, B16(WS_XV) + (size_t)b * MEML * 512 + 128 * h, 512,
                                 B16(WS_XO) + (size_t)b * SEQ * 512 + 128 * h, 512, (float*)nullptr, 0, 256 * qb + 32 * wave, MEML / 64, MEML / 64); } }
    GRID_BAR(); }
#pragma unroll 1
    for (int rep = 0; rep < REP10; ++rep) {
    { PHASE_IDS(); pg8::Gemm g{B16(WS_XO), B16(WS_WXOT), 512, 512, T, DM}; pg8::StaticOrder S; S.init(T, DM, G, bid);
      const PEpiRes<1> e{0, ws}; pg8::gemm_phase(tid, RING, SCR, g, S, e); }
    GRID_BAR(); }
#pragma unroll 1
    for (int rep = 0; rep < REP11; ++rep) {
    { PHASE_IDS(); pg8::Gemm g{B16(WS_XB), B16(WS_W2T), DM, DM, T, NUP}; pg8::StaticOrder S; S.init(T, NUP, G, bid);
      const PEpiUp<1> e{0, ws}; pg8::gemm_phase(tid, RING, SCR, g, S, e); }
    GRID_BAR(); }
    { PHASE_IDS(); pg8::Gemm g{B16(WS_H), B16(WS_WD2T), DFFP, DFFP, T, DM}; pg8::StaticOrder S; S.init(T, DM, G, bid);
      const PEpiRes<2> e{0, ws}; pg8::gemm_phase(tid, RING, SCR, g, S, e); }
}

extern "C" void kernel_launch(void* const* d_in, const int* in_sizes, int n_in, void* d_out, int out_size, void* d_ws, size_t ws_size, hipStream_t stream) {
    static int grid = 0;
    if (grid == 0) {
        if (n_in != 39 || out_size != T * DM || ws_size < WS_END) { fprintf(stderr, "kernel_launch: unexpected shapes (n_in %d out %d ws %zu)\n", n_in, out_size, ws_size); grid = -1; return; }
        int dev = 0, cus = 0, per_cu = 0;
        if (hipGetDevice(&dev) != hipSuccess || hipDeviceGetAttribute(&cus, hipDeviceAttributeMultiprocessorCount, dev) != hipSuccess) { grid = -1; return; }
        if (hipFuncSetAttribute((const void*)fwd_megakernel, hipFuncAttributeMaxDynamicSharedMemorySize, LDS_BYTES) != hipSuccess) { fprintf(stderr, "kernel_launch: hipFuncSetAttribute failed\n"); grid = -1; return; }
        if (hipOccupancyMaxActiveBlocksPerMultiprocessor(&per_cu, (const void*)fwd_megakernel, NTHREADS, LDS_BYTES) != hipSuccess || per_cu < 1) { fprintf(stderr, "kernel_launch: occupancy query says %d\n", per_cu); }
        (void)hipGetLastError();
        grid = cus;
    }
    if (grid < 0) return;
    (void)hipMemsetAsync((char*)d_ws + WS_CTL, 0, CTL_ZERO_BYTES, stream);
    Params p{};
    for (int i = 0; i < 39; ++i) p.in[i] = d_in[i];
    p.out = (float*)d_out; p.ws = (unsigned char*)d_ws;
    hipLaunchKernelGGL(fwd_megakernel, dim3(grid), dim3(NTHREADS), LDS_BYTES, stream, p);
}
```

```cpp
#include <hip/hip_runtime.h>
#include <cstdint>
#include <cstdio>

typedef unsigned short bf16_t;
typedef short bf16x8 __attribute__((ext_vector_type(8)));
typedef short bf16x4 __attribute__((ext_vector_type(4)));
typedef float f32x4 __attribute__((ext_vector_type(4)));
typedef float f32x16 __attribute__((ext_vector_type(16)));
typedef unsigned u32x2 __attribute__((ext_vector_type(2)));
typedef unsigned u32x4 __attribute__((ext_vector_type(4)));

constexpr int BATCH = 4, SEQ = 4096, DM = 1024, T = BATCH * SEQ, MEML = 256, TM = BATCH * MEML;
constexpr int DFF = 2752, DFFP = 2816, NUP = 2 * DFFP;
constexpr int NIN = 1280;
constexpr int PQ = 0, PKR = 384, PKV = 512, PU = 768;
constexpr int QRANK = 384, KVRANK = 256, NH = 4, DQK = 192, DNOPE = 128, DROPE = 64, DV = 128;
constexpr int SSMW = 512, SG = 32, SP = 64;
constexpr float EPS = 1e-6f;
constexpr float LOG2E = 1.4426950408889634f;
constexpr float QSCALE = 0.07216878364870322f * LOG2E;
constexpr float XSCALE = 0.08838834764831845f * LOG2E;

constexpr size_t MiB = 1u << 20;
constexpr size_t WS_CTL = 0;
constexpr size_t WS_W1T = 1 * MiB;
constexpr size_t WS_WD1T = 12 * MiB;
constexpr size_t WS_W2T = 18 * MiB;
constexpr size_t WS_WD2T = 29 * MiB;
constexpr size_t WS_WINT = 35 * MiB;
constexpr size_t WS_WUQT = 38 * MiB;
constexpr size_t WS_WUKVT = 39 * MiB;
constexpr size_t WS_WGLUT = 40 * MiB;
constexpr size_t WS_WOT = 41 * MiB;
constexpr size_t WS_WXQT = 43 * MiB;
constexpr size_t WS_WXKVT = 44 * MiB;
constexpr size_t WS_WXOT = 46 * MiB;
constexpr size_t WS_ROPE = 63 * MiB;
constexpr size_t WS_SS = 67 * MiB;
constexpr size_t WS_SSQ = WS_SS + 256 * 1024;
constexpr size_t WS_SSKR = WS_SSQ + 128 * 1024;
constexpr size_t WS_SSKV = WS_SSKR + 64 * 1024;
constexpr size_t WS_SSY = 68 * MiB;
constexpr size_t WS_SSMEM = WS_SSY + 512 * 1024;
constexpr size_t WS_MEMB = 69 * MiB;
constexpr size_t WS_XK = 71 * MiB;
constexpr size_t WS_XVT = 72 * MiB;
constexpr size_t WS_XV = 73 * MiB;
constexpr size_t WS_XB = 74 * MiB;
constexpr size_t WS_G = 106 * MiB;
constexpr size_t WS_H = 106 * MiB;
constexpr size_t WS_CQ = WS_H;
constexpr size_t WS_CKV = WS_H + 12 * MiB;
constexpr size_t WS_U = WS_H + 20 * MiB;
constexpr size_t WS_KR = WS_H + 36 * MiB;
constexpr size_t WS_Q = WS_H + 40 * MiB;
constexpr size_t WS_K = WS_H + 64 * MiB;
constexpr size_t WS_XQ = WS_Q;
constexpr size_t WS_XO = WS_K;
constexpr size_t WS_KT = 194 * MiB;
constexpr size_t WS_BST = 195 * MiB;
constexpr size_t WS_CMT = 199 * MiB;
constexpr size_t WS_VT = 203 * MiB;
constexpr size_t WS_V = 47 * MiB;
constexpr size_t WS_YCAT = 210 * MiB;
constexpr size_t WS_END = 256 * MiB;

__device__ __forceinline__ unsigned f2bf(float f) { unsigned u = __builtin_bit_cast(unsigned, f); return (u + 0x7fffu + ((u >> 16) & 1u)) >> 16; }
typedef float f32x2_t __attribute__((ext_vector_type(2))); typedef __bf16 bf16x2_t __attribute__((ext_vector_type(2)));
__device__ __forceinline__ unsigned pk2(float lo, float hi) { f32x2_t v = {lo, hi}; bf16x2_t b = __builtin_convertvector(v, bf16x2_t); return __builtin_bit_cast(unsigned, b); }
__device__ __forceinline__ float bf2f(unsigned short b) { return __builtin_bit_cast(float, (unsigned)b << 16); }
__device__ __forceinline__ float wave_sum(float v) {
#pragma unroll
    for (int o = 1; o < 64; o <<= 1) v += __shfl_xor(v, o);
    return v;
}
__device__ __forceinline__ float quad_row_sum(float v) { v += __shfl_xor(v, 16); v += __shfl_xor(v, 32); return v; }
__device__ __forceinline__ void st_bf4(bf16_t* p, f32x4 v) { u32x2 w; w.x = pk2(v[0], v[1]); w.y = pk2(v[2], v[3]); *(u32x2*)p = w; }
__device__ __forceinline__ float dot4(f32x4 v) { return (v[0] * v[0] + v[1] * v[1]) + (v[2] * v[2] + v[3] * v[3]); }

#define LAS __attribute__((address_space(3)))
#define GAS __attribute__((address_space(1)))
struct Params { const void* in[39]; float* out; unsigned char* ws; };
__device__ __forceinline__ const void* karg(int i) {
    unsigned long long p;
    asm volatile("s_load_dwordx2 %0, %1, %2\n\ts_waitcnt lgkmcnt(0)" : "=s"(p) : "s"(__builtin_amdgcn_kernarg_segment_ptr()), "i"(8 * i) : "memory");
    return (const void*)(const GAS void*)p;
}

struct WDesc { const float* W; const float* W2; int ldw; int Ksrc; bf16_t* dst; int N; int K; const float* g; const float* g2; int gsplit; int mode; int ncols_src; int pad; };
__device__ __forceinline__ int src_chunk_col(const WDesc& d, int c, const float*& src) {
    src = d.W;
    switch (d.mode) {
        case 0: return (32 * c < d.ncols_src) ? 32 * c : -1;
        case 1: { const int pn = c >> 3, q = c & 7; const int col = 128 * pn + 32 * (q & 3); if (q >= 4) src = d.W2; return col < d.ncols_src ? col : -1; }
        case 2: { if (c < 12) return 32 * c; if (c < 14) return 640 + 32 * (c - 12); if (c < 16) return -1; if (c < 24) return 384 + 32 * (c - 16); return 704 + 32 * (c - 24); }
        case 3: { const int h = c >> 3, q = c & 7; if (q < 3) return 192 * h + 32 * q; if (q == 3) return 192 * h + 128; if (q == 4) return 192 * h + 96; if (q == 7) return 192 * h + 160; return -1; }
    }
    return -1;
}
constexpr int NWMAT = 12;
__device__ __forceinline__ WDesc get_wdesc(unsigned char* ws, int m) {
#define FI(i) ((const float*)karg(i))
#define WB(off) ((bf16_t*)(ws + (off)))
    switch (m) {
        case 0: return WDesc{FI(4), FI(5), DFF, DM, WB(WS_W1T), NUP, DM, FI(3), FI(3), DM, 1, DFF, 0};
        case 1: return WDesc{FI(36), FI(37), DFF, DM, WB(WS_W2T), NUP, DM, FI(35), FI(35), DM, 1, DFF, 0};
        case 2: return WDesc{FI(6), nullptr, DM, DFF, WB(WS_WD1T), DM, DFFP, nullptr, nullptr, 0, 0, DM, 0};
        case 3: return WDesc{FI(38), nullptr, DM, DFF, WB(WS_WD2T), DM, DFFP, nullptr, nullptr, 0, 0, DM, 0};
        case 4: return WDesc{FI(8), nullptr, 1216, DM, WB(WS_WINT), NIN, DM, FI(7), FI(7), DM, 2, 1216, 0};
        case 5: return WDesc{FI(10), nullptr, 768, QRANK, WB(WS_WUQT), 1024, QRANK, FI(9), FI(9), QRANK, 3, 768, 0};
        case 6: return WDesc{FI(12), nullptr, 1024, KVRANK, WB(WS_WUKVT), 1024, KVRANK, FI(11), FI(11), KVRANK, 0, 1024, 0};
        case 7: return WDesc{FI(23), nullptr, 512, 512, WB(WS_WGLUT), 512, 512, nullptr, nullptr, 0, 0, 512, 0};
        case 8: return WDesc{FI(27), nullptr, DM, DM, WB(WS_WOT), DM, DM, FI(25), FI(26), 512, 0, DM, 0};
        case 9: return WDesc{FI(30), nullptr, 512, DM, WB(WS_WXQT), 512, DM, FI(28), FI(28), DM, 0, 512, 0};
        case 10: return WDesc{FI(31), nullptr, DM, DM, WB(WS_WXKVT), DM, DM, FI(29), FI(29), DM, 0, DM, 0};
        default: return WDesc{FI(34), nullptr, DM, 512, WB(WS_WXOT), DM, 512, nullptr, nullptr, 0, 0, DM, 0};
    }
#undef FI
#undef WB
}
__device__ __forceinline__ int wmat_tiles(int m) {
    switch (m) { case 0: case 1: return (NUP / 64) * (DM / 64); case 2: case 3: return (DM / 64) * (DFFP / 64); case 4: return (NIN / 64) * (DM / 64); case 5: return 16 * (QRANK / 64);
        case 6: return 16 * (KVRANK / 64); case 7: return 64; case 8: return 256; case 9: return 8 * 16; case 10: return 256; default: return 16 * 8; }
}
constexpr int WTILES_TOTAL = 2 * (NUP / 64) * (DM / 64) + 2 * (DM / 64) * (DFFP / 64) + (NIN / 64) * (DM / 64) + 16 * (QRANK / 64) + 16 * (KVRANK / 64) + 64 + 256 + 128 + 256 + 128;
__device__ __forceinline__ void convert_tile_load(const WDesc& d, int nc, int kc, int vtid, float* tile, int& valid) {
    const float* src0; const float* src1; const int c0 = src_chunk_col(d, 2 * nc, src0), c1 = src_chunk_col(d, 2 * nc + 1, src1); const int k0 = 64 * kc;
    valid = (k0 < d.Ksrc) ? ((c0 >= 0 ? 1 : 0) | (c1 >= 0 ? 2 : 0)) : 0;
    if (valid) {
        for (int e = vtid; e < 64 * 64; e += 256) { const int kk = e >> 6, nn = e & 63; const int k = k0 + kk; const int sub = nn >> 5; const int cc = sub ? c1 : c0; const float* src = sub ? src1 : src0;
            float gg = 1.f; if (d.g) gg = (k < d.gsplit) ? d.g[k] : d.g2[k - d.gsplit];
            tile[kk * 65 + nn] = (cc >= 0) ? src[(size_t)k * d.ldw + cc + (nn & 31)] * gg : 0.f; }
    }
}
__device__ __forceinline__ void convert_tile_store(const WDesc& d, int nc, int kc, int vtid, const float* tile, int valid) {
    const int k0 = 64 * kc;
    for (int e = vtid; e < 64 * 8; e += 256) { const int nn = e >> 3, ch = e & 7;
        u32x4 o = {0u, 0u, 0u, 0u};
        if (valid) { o.x = pk2(tile[(8 * ch + 0) * 65 + nn], tile[(8 * ch + 1) * 65 + nn]); o.y = pk2(tile[(8 * ch + 2) * 65 + nn], tile[(8 * ch + 3) * 65 + nn]);
                     o.z = pk2(tile[(8 * ch + 4) * 65 + nn], tile[(8 * ch + 5) * 65 + nn]); o.w = pk2(tile[(8 * ch + 6) * 65 + nn], tile[(8 * ch + 7) * 65 + nn]); }
        *(u32x4*)(d.dst + (size_t)(64 * nc + nn) * d.K + k0 + 8 * ch) = o; }
}
__device__ __forceinline__ void convert_item_wave(const WDesc& d, int nc, int kc, int lane, LAS float* scr) {
    const float* src; const int col0 = src_chunk_col(d, nc, src); const int k0 = 64 * kc, n0 = 32 * nc; const int c = lane & 7;
    if (col0 < 0 || k0 >= d.Ksrc) {
#pragma unroll
        for (int j = 0; j < 4; ++j) { const int n = (lane >> 3) + 8 * j; *(u32x4*)(d.dst + (size_t)(n0 + n) * d.K + k0 + 8 * c) = (u32x4){0u, 0u, 0u, 0u}; }
        return; }
    const float* sp = src + (size_t)(k0 + (lane >> 3)) * d.ldw + col0 + 4 * c;
    f32x4 v[8]; float gg[8];
#pragma unroll
    for (int i = 0; i < 8; ++i) { v[i] = *(const f32x4*)(sp + (size_t)(8 * i) * d.ldw); const int k = k0 + (lane >> 3) + 8 * i; gg[i] = d.g ? ((k < d.gsplit) ? d.g[k] : d.g2[k - d.gsplit]) : 1.f; }
#pragma unroll
    for (int i = 0; i < 8; ++i) { LAS float* w = scr + ((lane >> 3) + 8 * i) * 33 + 4 * c; w[0] = v[i][0] * gg[i]; w[1] = v[i][1] * gg[i]; w[2] = v[i][2] * gg[i]; w[3] = v[i][3] * gg[i]; }
    asm volatile("s_waitcnt lgkmcnt(0)" ::: "memory");
#pragma unroll
    for (int j = 0; j < 4; ++j) { const int n = (lane >> 3) + 8 * j; const LAS float* s = scr + (8 * c) * 33 + n;
        u32x4 o; o.x = pk2(s[0 * 33], s[1 * 33]); o.y = pk2(s[2 * 33], s[3 * 33]); o.z = pk2(s[4 * 33], s[5 * 33]); o.w = pk2(s[6 * 33], s[7 * 33]);
        *(u32x4*)(d.dst + (size_t)(n0 + n) * d.K + k0 + 8 * c) = o; }
    asm volatile("s_waitcnt lgkmcnt(0)" ::: "memory");
}
__device__ __forceinline__ void convert_subset(unsigned mask, int wrank, int nwaves, int lane, LAS float* scr, unsigned char* ws) {
    for (int m = 0; m < NWMAT; ++m) { if (!((mask >> m) & 1u)) continue;
        const WDesc d = get_wdesc(ws, m); const int nt = 2 * wmat_tiles(m), nch = d.N / 32;
        for (int r = wrank; r < nt; r += nwaves) convert_item_wave(d, r % nch, r / nch, lane, scr); }
}
constexpr unsigned WM_P0 = (1u << 0);
constexpr unsigned WM_P1 = (1u << 2) | (1u << 4) | (1u << 5) | (1u << 6) | (1u << 7) | (1u << 10);
constexpr unsigned WM_P6 = (1u << 1) | (1u << 8) | (1u << 9);
constexpr unsigned WM_P8 = (1u << 3) | (1u << 11);
constexpr int NCONV_ITEMS = 2 * WTILES_TOTAL, NROW_ITEMS = T / 8, NMEM_ITEMS = TM / 8, NROPE_ITEMS = T * 32 / 512, NP0_ITEMS = NROW_ITEMS + NMEM_ITEMS + NROPE_ITEMS;
constexpr int CW_Q0 = 64;
__device__ __forceinline__ void row_to_bf16(const float* x, bf16_t* out, float* ss4, int row, int lane) {
    const f32x4* xr = (const f32x4*)(x + (size_t)row * DM) + lane; float s = 0.f;
    unsigned long long* o8 = (unsigned long long*)(out + (size_t)row * DM) + lane;
#pragma unroll
    for (int j = 0; j < 4; ++j) { const f32x4 v = xr[64 * j]; s += dot4(v); o8[64 * j] = (unsigned long long)pk2(v[0], v[1]) | ((unsigned long long)pk2(v[2], v[3]) << 32); }
    s = wave_sum(s);
    if (lane < 4) ss4[row * 4 + lane] = lane == 0 ? s : 0.f;
}
__device__ __forceinline__ void rope_entry(const int* pos, float2* tab, int idx) {
    const int t = idx >> 5, i = idx & 31;
    const double inv = exp2(-(double)i / 32.0 * 13.287712379549449);
    double a = (double)pos[t] * inv; a -= 6.283185307179586 * rint(a / 6.283185307179586);
    float s, c; sincosf((float)a, &s, &c); tab[idx] = make_float2(c, s);
}

__device__ __forceinline__ float rs_from4(const float* ss4, int row, float invc) { const f32x4 s = *(const f32x4*)(ss4 + 4 * row); return rsqrtf(((s[0] + s[1]) + (s[2] + s[3])) * invc + EPS); }

namespace pg8 {
#define PG8_LAS __attribute__((address_space(3)))
constexpr int BM = 256, BK = 64, HALF = 128, HTB = HALF * BK * 2, STAGE_BYTES = 8 * HTB, NXCD = 8, WGM = 8;
__host__ __device__ __forceinline__ int lds_byte(int r, int c) { const int st = (r >> 4) * 2 + (c >> 5), rr = r & 15, cc = c & 31, ob = rr * 64 + cc * 2; return st * 1024 + (ob ^ (((ob >> 9) & 1) << 5)); }
__host__ __device__ __forceinline__ void stage_rc(int b, int& R, int& C) { const int st = b / 1024, sb = b % 1024, swz = sb ^ (((sb >> 9) & 1) << 5); R = (st >> 1) * 16 + swz / 64; C = (st & 1) * 32 + (swz % 64) / 2; }
__host__ __device__ __forceinline__ int perm32(int rho) { const int n = rho >> 4, i = rho & 15; return 8 * (i >> 2) + 4 * n + (i & 3); }
struct Unit { int pm, pn; };
struct Gemm { const bf16_t* A; const bf16_t* Bt; int lda; int K; int M, N; };
struct StaticOrder {
    int nM, nN, nwg, G, c;
    __device__ void init(int M, int N, int G_, int c_) { nM = M / BM; nN = N / BM; nwg = nM * nN; G = G_; c = c_; }
    __device__ bool next(int i, Unit& u) const {
        const long L = (long)i * G + c; if (c < 0 || L >= nwg) return false;
        int wgid = (int)L; { const int q = nwg / NXCD, r = nwg % NXCD, xcd = wgid % NXCD, off = wgid / NXCD; wgid = (xcd < r ? xcd * (q + 1) : r * (q + 1) + (xcd - r) * q) + off; }
        const int nig = WGM * nN, gid = wgid / nig, fm = gid * WGM, gsz = (nM - fm) < WGM ? (nM - fm) : WGM;
        u.pm = fm + ((wgid % nig) % gsz); u.pn = (wgid % nig) / gsz; return true;
    }
};
template <class Epi>
__device__ __forceinline__ void gemm_phase(int tid, PG8_LAS unsigned char* lds, PG8_LAS float* scr, const Gemm g, const StaticOrder& S, const Epi& E) {
    const int wid = __builtin_amdgcn_readfirstlane(tid >> 6), lane = tid & 63, wr = wid >> 2, wc = wid & 3, fr = lane & 15, fq = lane >> 4;
    const int K = g.K, nt = K / BK;
    unsigned voffA[2], voffB[2];
#pragma unroll
    for (int i = 0; i < 2; ++i) { int R, C; stage_rc(tid * 16 + i * 8192, R, C); const int Rb = Epi::PERM ? ((R & ~31) + perm32(R & 31)) : R;
        voffA[i] = (unsigned)(R * g.lda + C) * 2u; voffB[i] = (unsigned)(Rb * K + C) * 2u; }
    const size_t kstep = (size_t)(BK * 2);
    const size_t hstepA = (size_t)HALF * g.lda * 2, hstepB = (size_t)HALF * K * 2;
    const size_t tstepA = 2 * hstepA, tstepB = 2 * hstepB;
    const unsigned ldsw = (unsigned)wid * 1024u;
    const int aoff = lds_byte(wr * 64 + fr, fq * 8), boff = lds_byte(wc * 32 + fr, fq * 8);
#define PG8_SA(b, h) (((b) * 2 + (h)) * HTB)
#define PG8_SB(b, h) ((4 + (b) * 2 + (h)) * HTB)
#define PG8_STAGE(bufoff, gbase, voff) do { _Pragma("unroll") for (int _i = 0; _i < 2; ++_i) \
        __builtin_amdgcn_global_load_lds((const unsigned*)((const char*)(gbase) + (voff)[_i]), (PG8_LAS unsigned*)(lds + (bufoff) + ldsw + _i * 8192), 16, 0, 0); } while (0)
#define PG8_LDA(dst, b, h) do { _Pragma("unroll") for (int m = 0; m < 4; ++m) _Pragma("unroll") for (int k = 0; k < 2; ++k) dst[m][k] = *(const PG8_LAS bf16x8*)(lds + PG8_SA(b, h) + aoff + m * 2048 + k * 1024); } while (0)
#define PG8_LDB(dst, b, h) do { _Pragma("unroll") for (int n = 0; n < 2; ++n) _Pragma("unroll") for (int k = 0; k < 2; ++k) dst[n][k] = *(const PG8_LAS bf16x8*)(lds + PG8_SB(b, h) + boff + n * 2048 + k * 1024); } while (0)
#define PG8_MMA(ai, bj, At, Bt) do { __builtin_amdgcn_s_setprio(1); _Pragma("unroll") for (int m = 0; m < 4; ++m) _Pragma("unroll") for (int n = 0; n < 2; ++n) _Pragma("unroll") for (int k = 0; k < 2; ++k) \
        acc[ai][bj][m][n] = __builtin_amdgcn_mfma_f32_16x16x32_bf16(Bt[n][k], At[m][k], acc[ai][bj][m][n], 0, 0, 0); __builtin_amdgcn_s_setprio(0); } while (0)
#define PG8_WAIT_V(n) asm volatile("s_waitcnt vmcnt(" #n ")" ::: "memory")
#define PG8_WAIT_L(n) asm volatile("s_waitcnt lgkmcnt(" #n ")" ::: "memory")
#define PG8_BAR __builtin_amdgcn_s_barrier()
#define PG8_SCHED __builtin_amdgcn_sched_barrier(0)
    Unit cur, nxt; int ui = 0;
    if (!S.next(0, cur)) return;
    f32x4 acc[2][2][4][2];
#pragma unroll
    for (int a = 0; a < 2; ++a)
#pragma unroll
        for (int b = 0; b < 2; ++b)
#pragma unroll
            for (int m = 0; m < 4; ++m)
#pragma unroll
                for (int n = 0; n < 2; ++n) acc[a][b][m][n] = (f32x4){0.f, 0.f, 0.f, 0.f};
    bf16x8 At[4][2], B0[2][2], B1[2][2];
    const char* cA = (const char*)g.A + (size_t)cur.pm * tstepA; const char* cB = (const char*)g.Bt + (size_t)cur.pn * tstepB;
    PG8_STAGE(PG8_SB(0, 0), cB, voffB); PG8_STAGE(PG8_SB(0, 1), cB + hstepB, voffB); PG8_STAGE(PG8_SA(0, 0), cA, voffA); PG8_STAGE(PG8_SA(0, 1), cA + hstepA, voffA);
    if (wr == 1) PG8_BAR;
    PG8_WAIT_V(2); PG8_BAR;
    PG8_STAGE(PG8_SB(1, 0), cB + kstep, voffB); PG8_STAGE(PG8_SA(1, 0), cA + kstep, voffA); PG8_STAGE(PG8_SB(1, 1), cB + hstepB + kstep, voffB);
    PG8_WAIT_V(6); PG8_BAR;
    for (;;) {
        const bool has_next = S.next(ui + 1, nxt);
        const char* nA = has_next ? (const char*)g.A + (size_t)nxt.pm * tstepA : cA; const char* nB = has_next ? (const char*)g.Bt + (size_t)nxt.pn * tstepB : cB;
#pragma unroll 1
        for (int t = 0; t < nt; t += 2) {
            const bool last = (t == nt - 2);
            const char* a1 = cA + (size_t)(t + 1) * kstep;
            const char* a2 = last ? nA : cA + (size_t)(t + 2) * kstep; const char* b2 = last ? nB : cB + (size_t)(t + 2) * kstep;
            const char* a3 = a2 + kstep; const char* b3 = b2 + kstep;
            if constexpr (Epi::HAS_MID) { if (t == E.tmid) { int t2 = tid; asm volatile("" : "+v"(t2)); E.mid(acc, cur, wr, t2 & 15); } }
            PG8_LDB(B0, 0, 0); PG8_LDB(B1, 0, 1); PG8_SCHED; PG8_LDA(At, 0, 0); PG8_STAGE(PG8_SA(1, 1), a1 + hstepA, voffA);
            PG8_WAIT_V(8); PG8_WAIT_L(0); PG8_BAR; PG8_MMA(0, 0, At, B0); PG8_MMA(0, 1, At, B1); PG8_BAR; PG8_SCHED;
            PG8_LDA(At, 0, 1); PG8_STAGE(PG8_SB(0, 0), b2, voffB); PG8_STAGE(PG8_SB(0, 1), b2 + hstepB, voffB); PG8_STAGE(PG8_SA(0, 0), a2, voffA);
            PG8_WAIT_V(8); PG8_WAIT_L(0); PG8_BAR; PG8_MMA(1, 0, At, B0); PG8_MMA(1, 1, At, B1); PG8_BAR; PG8_SCHED;
            PG8_LDB(B0, 1, 0); PG8_LDB(B1, 1, 1); PG8_SCHED; PG8_LDA(At, 1, 0); PG8_STAGE(PG8_SA(0, 1), a2 + hstepA, voffA);
            PG8_WAIT_V(8); PG8_WAIT_L(0); PG8_BAR; PG8_MMA(0, 0, At, B0); PG8_MMA(0, 1, At, B1); PG8_BAR; PG8_SCHED;
            PG8_LDA(At, 1, 1); PG8_STAGE(PG8_SB(1, 0), b3, voffB); PG8_STAGE(PG8_SB(1, 1), b3 + hstepB, voffB); PG8_STAGE(PG8_SA(1, 0), a3, voffA);
            PG8_WAIT_V(8); PG8_WAIT_L(0); PG8_BAR; PG8_MMA(1, 0, At, B0); PG8_MMA(1, 1, At, B1); PG8_BAR; PG8_SCHED;
        }
        if (wr == 0) PG8_BAR;
        { int t2 = tid; asm volatile("" : "+v"(t2)); const int efr = t2 & 15, efq = (t2 >> 4) & 3;
          E(acc, cur, wr, wc, efr, efq, scr); }
        if (!has_next) break;
#pragma unroll
        for (int a = 0; a < 2; ++a)
#pragma unroll
            for (int b = 0; b < 2; ++b)
#pragma unroll
                for (int m = 0; m < 4; ++m)
#pragma unroll
                    for (int n = 0; n < 2; ++n) acc[a][b][m][n] = (f32x4){0.f, 0.f, 0.f, 0.f};
        cur = nxt; cA = nA; cB = nB; ++ui;
        if (wr == 1) PG8_BAR;
    }
    PG8_WAIT_V(0);
    PG8_BAR;
#undef PG8_SA
#undef PG8_SB
#undef PG8_STAGE
#undef PG8_LDA
#undef PG8_LDB
#undef PG8_MMA
#undef PG8_WAIT_V
#undef PG8_WAIT_L
#undef PG8_BAR
#undef PG8_SCHED
}
}

typedef f32x4 Acc[2][2][4][2];
#define PROW(ai, m) (u.pm * 256 + (ai) * 128 + wr * 64 + (m) * 16 + fr)
#define EPI_FOR_AM _Pragma("unroll") for (int ai = 0; ai < 2; ++ai) _Pragma("unroll") for (int m = 0; m < 4; ++m)
#define EPI_FENCE asm volatile("" ::: "memory")
__device__ __forceinline__ u32x4 pack8(f32x4 a, f32x4 b) { u32x4 w; w.x = pk2(a[0], a[1]); w.y = pk2(a[2], a[3]); w.z = pk2(b[0], b[1]); w.w = pk2(b[2], b[3]); return w; }
template <int NV> __device__ __forceinline__ void xch_rows(float (&v)[2][4][NV], LAS float* scr, int wr, int wc, int fr, int fq) {
    EPI_FOR_AM {
#pragma unroll
        for (int k = 0; k < NV; ++k) { const float t = quad_row_sum(v[ai][m][k]); if (fq == 0) scr[((ai * 128 + wr * 64 + m * 16 + fr) * 4 + wc) * NV + k] = t; } }
    asm volatile("s_waitcnt lgkmcnt(0)" ::: "memory"); __builtin_amdgcn_s_barrier(); asm volatile("" ::: "memory");
    EPI_FOR_AM { const LAS float* p = scr + (ai * 128 + wr * 64 + m * 16 + fr) * 4 * NV;
#pragma unroll
        for (int k = 0; k < NV; ++k) v[ai][m][k] = (p[k] + p[NV + k]) + (p[2 * NV + k] + p[3 * NV + k]); }
}
__device__ __forceinline__ float silu_mul(float g, float u) { return g / (1.f + __expf(-g)) * u; }

#define EB16(off) ((bf16_t*)(ws + (off)))
#define EF32(off) ((float*)(ws + (off)))
#define EFI(i) ((const float*)karg(i))
template <int FFN> struct PEpiUp {
    static constexpr bool PERM = true, HAS_MID = false; int tmid; unsigned char* ws;
    __device__ __forceinline__ void operator()(Acc& acc, const pg8::Unit& u, int wr, int wc, int fr, int fq, LAS float*) const {
        const float* ss = EF32(WS_SS); bf16_t* H = EB16(WS_H);
        EPI_FOR_AM { const int r = PROW(ai, m); const float rs = rs_from4(ss, r, 1.f / DM); f32x4 h0, h1;
#pragma unroll
            for (int i = 0; i < 4; ++i) { h0[i] = silu_mul(acc[ai][0][m][0][i] * rs, acc[ai][1][m][0][i] * rs); h1[i] = silu_mul(acc[ai][0][m][1][i] * rs, acc[ai][1][m][1][i] * rs); }
            *(u32x4*)(H + (size_t)r * DFFP + 128 * u.pn + 32 * wc + 8 * fq) = pack8(h0, h1); }
    }
};
__device__ __forceinline__ void unpack8(u32x4 w, f32x4& a, f32x4& b) { a[0] = __builtin_bit_cast(float, w.x << 16); a[1] = __builtin_bit_cast(float, w.x & 0xffff0000u); a[2] = __builtin_bit_cast(float, w.y << 16); a[3] = __builtin_bit_cast(float, w.y & 0xffff0000u);
    b[0] = __builtin_bit_cast(float, w.z << 16); b[1] = __builtin_bit_cast(float, w.z & 0xffff0000u); b[2] = __builtin_bit_cast(float, w.w << 16); b[3] = __builtin_bit_cast(float, w.w & 0xffff0000u); }
template <int MODE> struct PEpiRes {
    static constexpr bool PERM = true, HAS_MID = false; int tmid; unsigned char* ws;
    __device__ __forceinline__ void operator()(Acc& acc, const pg8::Unit& u, int wr, int wc, int fr, int fq, LAS float* scr) const {
        bf16_t* xb = EB16(WS_XB); float* ssout = EF32(WS_SS); const float alpha = (MODE == 1) ? 1.f : 0.5f;
        float part[2][4][1];
        EPI_FOR_AM { const int r = PROW(ai, m); float s = 0.f;
#pragma unroll
            for (int bj = 0; bj < 2; ++bj) { const size_t off = (size_t)r * DM + 256 * u.pn + 128 * bj + 32 * wc + 8 * fq; f32x4 r0, r1;
                unpack8(*(const u32x4*)(xb + off), r0, r1);
                const f32x4 v0 = r0 + acc[ai][bj][m][0] * alpha, v1 = r1 + acc[ai][bj][m][1] * alpha;
                if (MODE == 2) { float* out = (float*)karg(39); *(f32x4*)(out + off) = v0; *(f32x4*)(out + off + 4) = v1; }
                else { *(u32x4*)(xb + off) = pack8(v0, v1); s += dot4(v0) + dot4(v1); } }
            part[ai][m][0] = s; EPI_FENCE; }
        if (MODE != 2) { xch_rows<1>(part, scr, wr, wc, fr, fq); if (wc == 0 && fq == 0) EPI_FOR_AM ssout[PROW(ai, m) * 4 + u.pn] = part[ai][m][0]; }
    }
};
struct PEpiWo {
    static constexpr bool PERM = true, HAS_MID = true; int tmid; unsigned char* ws;
    __device__ __forceinline__ void rsv(int row, float& rm, float& rsm) const { const float* ssy = EF32(WS_SSY); const f32x4 a = *(const f32x4*)(ssy + 8 * row), b = *(const f32x4*)(ssy + 8 * row + 4);
        rm = rsqrtf(((a[0] + a[1]) + (a[2] + a[3])) * (1.f / 512) + EPS); rsm = rsqrtf((b[0] + b[1]) * (1.f / 512) + EPS); }
    __device__ __forceinline__ void mid(Acc& acc, const pg8::Unit& u, int wr, int fr) const {
        EPI_FOR_AM { float rm, rsm; rsv(PROW(ai, m), rm, rsm); const float q = rm / rsm;
#pragma unroll
            for (int bj = 0; bj < 2; ++bj)
#pragma unroll
                for (int n = 0; n < 2; ++n) acc[ai][bj][m][n] = acc[ai][bj][m][n] * q; }
    }
    __device__ __forceinline__ void operator()(Acc& acc, const pg8::Unit& u, int wr, int wc, int fr, int fq, LAS float* scr) const {
        bf16_t* xb = EB16(WS_XB); float* ssout = EF32(WS_SS);
        float part[2][4][1];
        EPI_FOR_AM { const int r = PROW(ai, m); float rm, rsm; rsv(r, rm, rsm); float s = 0.f;
#pragma unroll
            for (int bj = 0; bj < 2; ++bj) { const size_t off = (size_t)r * DM + 256 * u.pn + 128 * bj + 32 * wc + 8 * fq; f32x4 r0, r1; unpack8(*(const u32x4*)(xb + off), r0, r1);
                const f32x4 v0 = r0 + acc[ai][bj][m][0] * rsm, v1 = r1 + acc[ai][bj][m][1] * rsm; *(u32x4*)(xb + off) = pack8(v0, v1); s += dot4(v0) + dot4(v1); }
            part[ai][m][0] = s; EPI_FENCE; }
        xch_rows<1>(part, scr, wr, wc, fr, fq); if (wc == 0 && fq == 0) EPI_FOR_AM ssout[PROW(ai, m) * 4 + u.pn] = part[ai][m][0];
    }
};
struct PEpiIn {
    static constexpr bool PERM = true, HAS_MID = false; int tmid; unsigned char* ws;
    __device__ __forceinline__ void operator()(Acc& acc, const pg8::Unit& u, int wr, int wc, int fr, int fq, LAS float* scr) const {
        const float* ss = EF32(WS_SS); float* ssq = EF32(WS_SSQ); float* sskr = EF32(WS_SSKR); float* sskv = EF32(WS_SSKV);
        float part[2][4][2];
        EPI_FOR_AM { const int r = PROW(ai, m); const float rs = rs_from4(ss, r, 1.f / DM);
#pragma unroll
            for (int bj = 0; bj < 2; ++bj) { const f32x4 v0 = acc[ai][bj][m][0] * rs, v1 = acc[ai][bj][m][1] * rs; const int c = 128 * bj + 32 * wc + 8 * fq; bf16_t* dst = nullptr;
                if (u.pn == 0) dst = EB16(WS_CQ) + (size_t)r * QRANK + c;
                else if (u.pn == 1) { if (bj == 0) dst = EB16(WS_CQ) + (size_t)r * QRANK + 256 + c; else if (wc < 2) dst = EB16(WS_KR) + (size_t)r * 64 + (c - 128); }
                else if (u.pn == 2) dst = EB16(WS_CKV) + (size_t)r * KVRANK + c;
                else dst = EB16(WS_U) + (size_t)r * SSMW + 256 * (u.pn - 3) + c;
                if (dst) *(u32x4*)dst = pack8(v0, v1);
                part[ai][m][bj] = dot4(v0) + dot4(v1); } }
        if (u.pn < 3) {
            if (u.pn == 1 && wc >= 2) EPI_FOR_AM part[ai][m][1] = 0.f;
            xch_rows<2>(part, scr, wr, wc, fr, fq);
            if (wc == 0 && fq == 0) EPI_FOR_AM { const int r = PROW(ai, m);
                if (u.pn == 0) ssq[2 * r] = part[ai][m][0] + part[ai][m][1];
                else if (u.pn == 1) { ssq[2 * r + 1] = part[ai][m][0]; sskr[r] = part[ai][m][1]; }
                else sskv[r] = part[ai][m][0] + part[ai][m][1]; } }
    }
};
struct PEpiQ {
    static constexpr bool PERM = true, HAS_MID = false; int tmid; unsigned char* ws;
    __device__ __forceinline__ void operator()(Acc& acc, const pg8::Unit& u, int wr, int wc, int fr, int fq, LAS float* scr) const {
        const float* ssq = EF32(WS_SSQ); bf16_t* Q = EB16(WS_Q); const float2* tab = (const float2*)(ws + WS_ROPE);
        float part[2][4][1];
        EPI_FOR_AM { const int r = PROW(ai, m); const float rs = rsqrtf((ssq[2 * r] + ssq[2 * r + 1]) * (1.f / QRANK) + EPS); float s = 0.f;
#pragma unroll
            for (int bj = 0; bj < 2; ++bj)
#pragma unroll
                for (int n = 0; n < 2; ++n) { acc[ai][bj][m][n] = acc[ai][bj][m][n] * rs; s += dot4(acc[ai][bj][m][n]); }
            part[ai][m][0] = s; }
        xch_rows<1>(part, scr, wr, wc, fr, fq);
        const float* gq = EFI(13);
        EPI_FOR_AM { const int r = PROW(ai, m); const float rh = rsqrtf(part[ai][m][0] * (1.f / DQK) + EPS) * QSCALE;
            bf16_t* qp = Q + (size_t)r * (NH * DQK) + DQK * u.pn;
            if (wc < 3) { const f32x4 g0 = *(const f32x4*)(gq + 32 * wc + 8 * fq), g1 = *(const f32x4*)(gq + 32 * wc + 8 * fq + 4);
                *(u32x4*)(qp + 32 * wc + 8 * fq) = pack8(acc[ai][0][m][0] * g0 * rh, acc[ai][0][m][1] * g1 * rh);
                if (wc == 0) { const f32x4 h0 = *(const f32x4*)(gq + 96 + 8 * fq), h1 = *(const f32x4*)(gq + 96 + 8 * fq + 4);
                    *(u32x4*)(qp + 96 + 8 * fq) = pack8(acc[ai][1][m][0] * h0 * rh, acc[ai][1][m][1] * h1 * rh); }
            } else { f32x4 o1[2], o2[2];
#pragma unroll
                for (int n = 0; n < 2; ++n) { const f32x4 g1 = *(const f32x4*)(gq + 128 + 8 * fq + 4 * n), g2 = *(const f32x4*)(gq + 160 + 8 * fq + 4 * n);
#pragma unroll
                    for (int i = 0; i < 4; ++i) { const float2 cs = tab[(size_t)r * 32 + 8 * fq + 4 * n + i]; const float x1 = acc[ai][0][m][n][i] * g1[i] * rh, x2 = acc[ai][1][m][n][i] * g2[i] * rh;
                        o1[n][i] = x1 * cs.x - x2 * cs.y; o2[n][i] = x2 * cs.x + x1 * cs.y; } }
                *(u32x4*)(qp + 128 + 8 * fq) = pack8(o1[0], o1[1]); *(u32x4*)(qp + 160 + 8 * fq) = pack8(o2[0], o2[1]); } EPI_FENCE; }
    }
};
template <bool WITH_VT> struct PEpiKV {
    static constexpr bool PERM = true, HAS_MID = false; int tmid; unsigned char* ws;
    __device__ __forceinline__ void operator()(Acc& acc, const pg8::Unit& u, int wr, int wc, int fr, int fq, LAS float* scr) const {
        const float* sskv = EF32(WS_SSKV); const float* sskr = EF32(WS_SSKR); const float2* tab = (const float2*)(ws + WS_ROPE); const bf16_t* krb = EB16(WS_KR); bf16_t* K = EB16(WS_K); bf16_t* V = EB16(WS_V); bf16_t* Vt = EB16(WS_VT);
        float part[2][4][1];
        EPI_FOR_AM { const int r = PROW(ai, m); const float rs = rsqrtf(sskv[r] * (1.f / KVRANK) + EPS);
#pragma unroll
            for (int bj = 0; bj < 2; ++bj)
#pragma unroll
                for (int n = 0; n < 2; ++n) acc[ai][bj][m][n] = acc[ai][bj][m][n] * rs;
            part[ai][m][0] = dot4(acc[ai][0][m][0]) + dot4(acc[ai][0][m][1]); }
        xch_rows<1>(part, scr, wr, wc, fr, fq);
        const float* gk = EFI(14);
        EPI_FOR_AM { const int r = PROW(ai, m); const float rk = rsqrtf((part[ai][m][0] + sskr[r]) * (1.f / DQK) + EPS);
            bf16_t* kp = K + (size_t)r * (NH * DQK) + DQK * u.pn;
            const f32x4 g0 = *(const f32x4*)(gk + 32 * wc + 8 * fq), g1 = *(const f32x4*)(gk + 32 * wc + 8 * fq + 4);
            *(u32x4*)(kp + 32 * wc + 8 * fq) = pack8(acc[ai][0][m][0] * g0 * rk, acc[ai][0][m][1] * g1 * rk);
            *(u32x4*)(V + (size_t)r * 512 + 128 * u.pn + 32 * wc + 8 * fq) = pack8(acc[ai][1][m][0], acc[ai][1][m][1]);
            if (WITH_VT) { const int b = r / SEQ, t = r % SEQ;
#pragma unroll
                for (int n = 0; n < 2; ++n)
#pragma unroll
                    for (int i = 0; i < 4; ++i) Vt[((size_t)(b * NH + u.pn) * DV + 32 * wc + 8 * fq + 4 * n + i) * SEQ + t] = (bf16_t)f2bf(acc[ai][1][m][n][i]); }
            const int idx = 8 * wc + 2 * fq; const bf16_t* kr = krb + (size_t)r * 64;
            const unsigned a1 = *(const unsigned*)(kr + idx), a2 = *(const unsigned*)(kr + 32 + idx); const f32x4 cs = *(const f32x4*)((const float*)tab + ((size_t)r * 32 + idx) * 2);
            const float x1a = bf2f((unsigned short)(a1 & 0xffff)) * gk[128 + idx] * rk, x1b = bf2f((unsigned short)(a1 >> 16)) * gk[129 + idx] * rk;
            const float x2a = bf2f((unsigned short)(a2 & 0xffff)) * gk[160 + idx] * rk, x2b = bf2f((unsigned short)(a2 >> 16)) * gk[161 + idx] * rk;
            *(unsigned*)(kp + 128 + idx) = pk2(x1a * cs[0] - x2a * cs[1], x1b * cs[2] - x2b * cs[3]);
            *(unsigned*)(kp + 160 + idx) = pk2(x2a * cs[0] + x1a * cs[1], x2b * cs[2] + x1b * cs[3]); EPI_FENCE; }
    }
};
struct PEpiGlu {
    static constexpr bool PERM = true, HAS_MID = false; int tmid; unsigned char* ws;
    __device__ __forceinline__ void operator()(Acc& acc, const pg8::Unit& u, int wr, int wc, int fr, int fq, LAS float* scr) const {
        const bf16_t* G = EB16(WS_G); const float* bias = EFI(24); bf16_t* ycat = EB16(WS_YCAT); float* ssy = EF32(WS_SSY);
        float part[2][4][1];
        EPI_FOR_AM { const int r = PROW(ai, m); float s = 0.f;
#pragma unroll
            for (int bj = 0; bj < 2; ++bj) { const int col = 256 * u.pn + 128 * bj + 32 * wc + 8 * fq; const bf16x8 gb = *(const bf16x8*)(G + (size_t)r * SSMW + col); f32x4 o[2];
#pragma unroll
                for (int n = 0; n < 2; ++n) { const f32x4 bv = *(const f32x4*)(bias + col + 4 * n);
#pragma unroll
                    for (int i = 0; i < 4; ++i) { const float g = bf2f((unsigned short)gb[4 * n + i]); o[n][i] = g / (1.f + __expf(-(acc[ai][bj][m][n][i] + bv[i]))); } s += dot4(o[n]); }
                *(u32x4*)(ycat + (size_t)r * DM + 512 + col) = pack8(o[0], o[1]); }
            part[ai][m][0] = s; }
        xch_rows<1>(part, scr, wr, wc, fr, fq); if (wc == 0 && fq == 0) EPI_FOR_AM ssy[PROW(ai, m) * 8 + 4 + u.pn] = part[ai][m][0];
    }
};
struct PEpiXQ {
    static constexpr bool PERM = true, HAS_MID = false; int tmid; unsigned char* ws;
    __device__ __forceinline__ void operator()(Acc& acc, const pg8::Unit& u, int wr, int wc, int fr, int fq, LAS float* scr) const {
        const float* ss = EF32(WS_SS); bf16_t* XQ = EB16(WS_XQ);
        float part[2][4][2];
        EPI_FOR_AM { const int r = PROW(ai, m); const float rs = rs_from4(ss, r, 1.f / DM);
#pragma unroll
            for (int bj = 0; bj < 2; ++bj) { acc[ai][bj][m][0] = acc[ai][bj][m][0] * rs; acc[ai][bj][m][1] = acc[ai][bj][m][1] * rs; part[ai][m][bj] = dot4(acc[ai][bj][m][0]) + dot4(acc[ai][bj][m][1]); } }
        xch_rows<2>(part, scr, wr, wc, fr, fq);
        const float* gq = EFI(32);
        const f32x4 g0 = *(const f32x4*)(gq + 32 * wc + 8 * fq), g1 = *(const f32x4*)(gq + 32 * wc + 8 * fq + 4);
        EPI_FOR_AM { const int r = PROW(ai, m);
#pragma unroll
            for (int bj = 0; bj < 2; ++bj) { const float rh = rsqrtf(part[ai][m][bj] * (1.f / 128) + EPS) * XSCALE;
                *(u32x4*)(XQ + (size_t)r * 512 + 256 * u.pn + 128 * bj + 32 * wc + 8 * fq) = pack8(acc[ai][bj][m][0] * g0 * rh, acc[ai][bj][m][1] * g1 * rh); } }
    }
};
template <bool WITH_VT> struct PEpiMemKV {
    static constexpr bool PERM = true, HAS_MID = false; int tmid; unsigned char* ws;
    __device__ __forceinline__ void operator()(Acc& acc, const pg8::Unit& u, int wr, int wc, int fr, int fq, LAS float* scr) const {
        const float* ss = EF32(WS_SSMEM); bf16_t* XK = EB16(WS_XK); bf16_t* XV = EB16(WS_XV); bf16_t* XVt = EB16(WS_XVT);
        float part[2][4][2];
        EPI_FOR_AM { const int r = PROW(ai, m); const float rs = rs_from4(ss, r, 1.f / DM);
#pragma unroll
            for (int bj = 0; bj < 2; ++bj) { acc[ai][bj][m][0] = acc[ai][bj][m][0] * rs; acc[ai][bj][m][1] = acc[ai][bj][m][1] * rs; part[ai][m][bj] = dot4(acc[ai][bj][m][0]) + dot4(acc[ai][bj][m][1]); } }
        if (u.pn < 2) {
            xch_rows<2>(part, scr, wr, wc, fr, fq);
            const float* gk = EFI(33);
            const f32x4 g0 = *(const f32x4*)(gk + 32 * wc + 8 * fq), g1 = *(const f32x4*)(gk + 32 * wc + 8 * fq + 4);
            EPI_FOR_AM { const int r = PROW(ai, m);
#pragma unroll
                for (int bj = 0; bj < 2; ++bj) { const float rh = rsqrtf(part[ai][m][bj] * (1.f / 128) + EPS);
                    *(u32x4*)(XK + (size_t)r * 512 + 256 * u.pn + 128 * bj + 32 * wc + 8 * fq) = pack8(acc[ai][bj][m][0] * g0 * rh, acc[ai][bj][m][1] * g1 * rh); } }
        } else {
            EPI_FOR_AM { const int r = PROW(ai, m), b = r / MEML, mm = r % MEML;
#pragma unroll
                for (int bj = 0; bj < 2; ++bj) { const int c0 = 256 * (u.pn - 2) + 128 * bj + 32 * wc + 8 * fq;
                    *(u32x4*)(XV + (size_t)r * 512 + c0) = pack8(acc[ai][bj][m][0], acc[ai][bj][m][1]);
                    if (WITH_VT) {
#pragma unroll
                        for (int n = 0; n < 2; ++n)
#pragma unroll
                            for (int i = 0; i < 4; ++i) { const int c = c0 + 4 * n + i, h = c >> 7, d = c & 127; XVt[((size_t)(b * NH + h) * 128 + d) * MEML + mm] = (bf16_t)f2bf(acc[ai][bj][m][n][i]); } } } }
        }
    }
};
template <int DK, int DVv, bool CAUSAL> __device__ __forceinline__ void attn_simple_vb(int qblk, int bh, int vtid, const bf16_t* Q, const bf16_t* K, const bf16_t* Vt, bf16_t* O, float* ssout, int ldq, int ldk, int ldo, int ssld, int Sq, int Skv) {
    const int lane = vtid & 63, w = vtid >> 6, c = lane & 31, hi = lane >> 5;
    const int b = bh / NH, h = bh % NH, q0 = 128 * qblk + 32 * w;
    const bf16_t* qp = Q + (size_t)(b * Sq + q0 + c) * ldq + h * DK + 8 * hi;
    f32x16 o[DVv / 32];
#pragma unroll
    for (int d = 0; d < DVv / 32; ++d)
#pragma unroll
        for (int r = 0; r < 16; ++r) o[d][r] = 0.f;
    float m = -1e30f, l = 0.f;
    const int ntile = CAUSAL ? (q0 / 32 + 1) : (Skv / 32);
    const bf16_t* kbase = K + (size_t)(b * Skv) * ldk + h * DK + 8 * hi;
    const bf16_t* vbase = Vt + (size_t)bh * DVv * Skv;
    for (int tt = 0; tt < ntile; ++tt) {
        const int key0 = 32 * tt;
        f32x16 p;
#pragma unroll
        for (int r = 0; r < 16; ++r) p[r] = 0.f;
        const bf16_t* kp = kbase + (size_t)(key0 + c) * ldk;
#pragma unroll
        for (int s = 0; s < DK / 16; ++s) { const bf16x8 kf = *(const bf16x8*)(kp + 16 * s); const bf16x8 qf = *(const bf16x8*)(qp + 16 * s); p = __builtin_amdgcn_mfma_f32_32x32x16_bf16(kf, qf, p, 0, 0, 0); }
        if (CAUSAL && tt == ntile - 1) {
#pragma unroll
            for (int r = 0; r < 16; ++r) { const int key = key0 + (r & 3) + 8 * (r >> 2) + 4 * hi; if (key > q0 + c) p[r] = -INFINITY; }
        }
        float tm = p[0];
#pragma unroll
        for (int r = 1; r < 16; ++r) tm = fmaxf(tm, p[r]);
        tm = fmaxf(tm, __shfl_xor(tm, 32));
        const float mn = fmaxf(m, tm), alpha = exp2f(m - mn); m = mn;
        float ps = 0.f;
#pragma unroll
        for (int r = 0; r < 16; ++r) { p[r] = exp2f(p[r] - mn); ps += p[r]; }
        l = l * alpha + ps;
        bf16x8 pf[2];
#pragma unroll
        for (int s = 0; s < 2; ++s)
#pragma unroll
            for (int j = 0; j < 8; ++j) pf[s][j] = (short)f2bf(p[8 * s + j]);
#pragma unroll
        for (int d = 0; d < DVv / 32; ++d) {
#pragma unroll
            for (int r = 0; r < 16; ++r) o[d][r] *= alpha;
            const bf16_t* vp = vbase + (size_t)(32 * d + c) * Skv + key0 + 4 * hi;
#pragma unroll
            for (int s = 0; s < 2; ++s) { const bf16x4 v0 = *(const bf16x4*)(vp + 16 * s), v1 = *(const bf16x4*)(vp + 16 * s + 8);
                const bf16x8 vf = {v0[0], v0[1], v0[2], v0[3], v1[0], v1[1], v1[2], v1[3]};
                o[d] = __builtin_amdgcn_mfma_f32_32x32x16_bf16(vf, pf[s], o[d], 0, 0, 0); }
        }
    }
    l += __shfl_xor(l, 32); const float il = 1.f / l; float ss = 0.f;
    bf16_t* op = O + (size_t)(b * Sq + q0 + c) * ldo + h * DVv;
#pragma unroll
    for (int d = 0; d < DVv / 32; ++d)
#pragma unroll
        for (int g = 0; g < 4; ++g) { f32x4 v = {o[d][4 * g] * il, o[d][4 * g + 1] * il, o[d][4 * g + 2] * il, o[d][4 * g + 3] * il}; ss += dot4(v); st_bf4(op + 32 * d + 8 * g + 4 * hi, v); }
    if (ssout) { ss += __shfl_xor(ss, 32); if (hi == 0) ssout[(size_t)(b * Sq + q0 + c) * ssld + h] = ss; }
}

__device__ __forceinline__ void ssm_seq_wave(int bg, int p, const bf16_t* proj, const float* a_re, const float* a_im, const float* log_dt, const float* b_re, const float* b_im, const float* c_re, const float* c_im, const float* dd, bf16_t* G) {
    const int b = bg / SG, g = bg % SG;
    const float lr = a_re[g * SP + p], li = a_im[g * SP + p], dt = expf(log_dt[g]);
    const float decay = expf(lr * dt); float sn, cs; sincosf(li * dt, &sn, &cs);
    const float ar = decay * cs, ai = decay * sn, den = lr * lr + li * li, nr = ar - 1.f;
    const float cr = (nr * lr + ai * li) / den, ci = (ai * lr - nr * li) / den;
    float bbr[16], bbi[16], ccr[16], cci[16];
#pragma unroll
    for (int h = 0; h < 16; ++h) { const float br = b_re[(g * SP + p) * 16 + h], bi = b_im[(g * SP + p) * 16 + h]; bbr[h] = cr * br - ci * bi; bbi[h] = cr * bi + ci * br;
        ccr[h] = c_re[(g * 16 + h) * SP + p]; cci[h] = c_im[(g * 16 + h) * SP + p]; }
    const float dmy = dd[g * 16 + (p & 15)];
    float xr = 0.f, xi = 0.f;
    for (int t = 0; t < SEQ; ++t) {
        const bf16_t* up = proj + (size_t)(b * SEQ + t) * SSMW + g * 16;
        const bf16x8 u0 = *(const bf16x8*)up, u1 = *(const bf16x8*)(up + 8);
        float u[16];
#pragma unroll
        for (int h = 0; h < 8; ++h) { u[h] = bf2f((unsigned short)u0[h]); u[8 + h] = bf2f((unsigned short)u1[h]); }
        float bur = 0.f, bui = 0.f;
#pragma unroll
        for (int h = 0; h < 16; ++h) { bur += bbr[h] * u[h]; bui += bbi[h] * u[h]; }
        const float nxr = ar * xr - ai * xi + bur, nxi = ar * xi + ai * xr + bui; xr = nxr; xi = nxi;
        float ymine = 0.f;
#pragma unroll
        for (int h = 0; h < 16; ++h) { float v = wave_sum(xr * ccr[h] - xi * cci[h]); if ((p & 15) == h) ymine = v + dmy * u[h]; }
        if (p < 16) { const float y = ymine; const float gl = 0.5f * y * (1.f + tanhf(0.7978845608028654f * (y + 0.044715f * y * y * y)));
            G[(size_t)(b * SEQ + t) * SSMW + g * 16 + p] = (bf16_t)f2bf(gl); }
    }
}
namespace att {
typedef short v4i16_t __attribute__((ext_vector_type(4)));
__device__ __forceinline__ unsigned voff_b(unsigned row, unsigned ch) { return 256u * row + 16u * (ch ^ (((row & 3u) << 2) | ((row >> 2) & 3u))); }
template <int DK> struct Cfg { static constexpr int KB = 64 * DK * 2, VB = 64 * 128 * 2, STG = KB + VB, NPK = KB / 1024, NP = STG / 1024, NPW = NP / 8; };
template <int DK> __device__ __forceinline__ void stage_tile(LAS unsigned char* stg, const bf16_t* Kg, int ldk, const bf16_t* Vg, int ldv, int kt, int wid, int lane) {
    typedef Cfg<DK> C;
#pragma unroll
    for (int i = 0; i < C::NPW; ++i) { const int pi = wid * C::NPW + i;
        const bf16_t* src;
        if (pi < C::NPK) { const int seg = pi >> 3, kg = pi & 7, prow = lane >> 3, pch = lane & 7, kr = prow ^ (kg & 1), ch = pch ^ kr;
            src = Kg + (size_t)(64 * kt + 8 * kg + kr) * ldk + 64 * seg + 8 * ch; }
        else { const unsigned pv = pi - C::NPK, row = 4 * pv + (lane >> 4), chs = lane & 15, ch = chs ^ (((row & 3u) << 2) | ((row >> 2) & 3u)); src = Vg + (size_t)(64 * kt + row) * ldv + 8 * ch; }
        __builtin_amdgcn_global_load_lds((const unsigned*)src, (LAS unsigned*)(stg + pi * 1024), 16, 0, 0); }
}
template <int DK, bool CAUSAL, int ABL = 0> __device__ __forceinline__ void attn_wg(int tid, LAS unsigned char* ring, const bf16_t* Qbh, int ldq, const bf16_t* Kbh, int ldk, const bf16_t* Vbh, int ldv, bf16_t* Obh, int ldo, float* ssout, int ssld, int qrow_w, int nt_w, int nt_max) {
    typedef Cfg<DK> C; constexpr float THR = 8.f;
    const int lane = tid & 63, wid = __builtin_amdgcn_readfirstlane(tid >> 6), c = lane & 31, hi = lane >> 5;
    stage_tile<DK>(ring, Kbh, ldk, Vbh, ldv, 0, wid, lane);
    if (nt_max > 1) stage_tile<DK>(ring + C::STG, Kbh, ldk, Vbh, ldv, 1, wid, lane);
    bf16x8 qf[DK / 16];
    { const bf16_t* qp = Qbh + (size_t)(qrow_w + c) * ldq + 8 * hi;
#pragma unroll
      for (int s = 0; s < DK / 16; ++s) qf[s] = *(const bf16x8*)(qp + 16 * s); }
    f32x16 o[4];
#pragma unroll
    for (int d = 0; d < 4; ++d)
#pragma unroll
        for (int r = 0; r < 16; ++r) o[d][r] = 0.f;
    float m = -1e30f, l = 0.f;
    const int qrow = qrow_w + c;
    const unsigned q4 = (lane & 15) >> 2, p4 = lane & 3, blk = (lane >> 4) & 1, cl = 2 * blk + (p4 >> 1);
    const unsigned vbase0 = 256u * (4 * hi + q4) + 16u * (cl ^ (unsigned)hi) + 8u * (p4 & 1), vbase1 = 2048u + 256u * (4 * hi + q4) + 16u * (cl ^ (2u + (unsigned)hi)) + 8u * (p4 & 1);
    f32x16 zero16;
#pragma unroll
    for (int r = 0; r < 16; ++r) zero16[r] = 0.f;
    const int kkr = c & 7, kkg = c >> 3; const unsigned kbase = (unsigned)(kkg * 1024 + (kkr ^ (kkg & 1)) * 128); unsigned koff[4];
#pragma unroll
    for (int i = 0; i < 4; ++i) koff[i] = (unsigned)(((2 * i + hi) ^ kkr) * 16);
    int st = 0;
    for (int t = 0; t < nt_max; ++t) {
        if (t + 1 < nt_max) asm volatile("s_waitcnt vmcnt(%0)" :: "n"(C::NPW) : "memory"); else asm volatile("s_waitcnt vmcnt(0)" ::: "memory");
        asm volatile("s_waitcnt lgkmcnt(0)" ::: "memory"); __builtin_amdgcn_s_barrier(); asm volatile("" ::: "memory");
        if (t + 2 < nt_max && !((ABL & 8) && t > 0)) { const int st2 = (st == 0) ? 2 : st - 1; stage_tile<DK>(ring + st2 * C::STG, Kbh, ldk, Vbh, ldv, t + 2, wid, lane); }
        if (t < nt_w) {
            LAS unsigned char* stg = ring + st * C::STG;
            f32x16 p0, p1;
            if (ABL & 2) { p0 = zero16; p1 = zero16; asm volatile("" : "+v"(p0), "+v"(p1)); } else
            { const LAS unsigned char* kp = stg + kbase; bf16x8 ka[4], kb[4];
#define ATT_KA(s) (((s) >> 2) * 8192 + koff[(s) & 3])
#define ATT_KLD(dst, s) do { dst[0] = *(const LAS bf16x8*)(kp + ATT_KA(s)); dst[1] = *(const LAS bf16x8*)(kp + ATT_KA(s) + 4096); dst[2] = *(const LAS bf16x8*)(kp + ATT_KA((s) + 1)); dst[3] = *(const LAS bf16x8*)(kp + ATT_KA((s) + 1) + 4096); } while (0)
#define ATT_MM(k, s) do { p0 = __builtin_amdgcn_mfma_f32_32x32x16_bf16(k[0], qf[s], p0, 0, 0, 0); p1 = __builtin_amdgcn_mfma_f32_32x32x16_bf16(k[1], qf[s], p1, 0, 0, 0); \
                          p0 = __builtin_amdgcn_mfma_f32_32x32x16_bf16(k[2], qf[(s) + 1], p0, 0, 0, 0); p1 = __builtin_amdgcn_mfma_f32_32x32x16_bf16(k[3], qf[(s) + 1], p1, 0, 0, 0); } while (0)
#define ATT_SB __builtin_amdgcn_sched_barrier(0)
              ATT_KLD(ka, 0); ATT_SB; ATT_KLD(kb, 2); ATT_SB;
              p0 = __builtin_amdgcn_mfma_f32_32x32x16_bf16(ka[0], qf[0], zero16, 0, 0, 0); p1 = __builtin_amdgcn_mfma_f32_32x32x16_bf16(ka[1], qf[0], zero16, 0, 0, 0);
              p0 = __builtin_amdgcn_mfma_f32_32x32x16_bf16(ka[2], qf[1], p0, 0, 0, 0); p1 = __builtin_amdgcn_mfma_f32_32x32x16_bf16(ka[3], qf[1], p1, 0, 0, 0); ATT_SB;
              ATT_KLD(ka, 4); ATT_SB; ATT_MM(kb, 2); ATT_SB;
              ATT_KLD(kb, 6); ATT_SB; ATT_MM(ka, 4); ATT_SB;
              if (DK == 192) { ATT_KLD(ka, 8); ATT_SB; ATT_MM(kb, 6); ATT_SB; ATT_KLD(kb, 10); ATT_SB; ATT_MM(ka, 8); ATT_SB; ATT_MM(kb, 10); ATT_SB; }
              else { ATT_MM(kb, 6); ATT_SB; }
            }
            if (CAUSAL && (64 * t + 63 > qrow_w)) {
#pragma unroll
                for (int r = 0; r < 16; ++r) { const int key = 64 * t + (r & 3) + 8 * (r >> 2) + 4 * hi; if (key > qrow) p0[r] = -INFINITY; if (key + 32 > qrow) p1[r] = -INFINITY; } }
            float tm = fmaxf(p0[0], p1[0]);
#pragma unroll
            for (int r = 1; r < 16; ++r) tm = fmaxf(tm, fmaxf(p0[r], p1[r]));
            tm = fmaxf(tm, __shfl_xor(tm, 32));
            if (__any(tm > m + THR)) {
                const float mn = fmaxf(m, tm), alpha = __builtin_amdgcn_exp2f(m - mn); m = mn; l *= alpha;
#pragma unroll
                for (int d0 = 0; d0 < 4; ++d0)
#pragma unroll
                    for (int r = 0; r < 16; ++r) o[d0][r] *= alpha; }
            float ps = 0.f;
            if (!(ABL & 4)) {
#pragma unroll
            for (int r = 0; r < 16; ++r) { p0[r] = __builtin_amdgcn_exp2f(p0[r] - m); p1[r] = __builtin_amdgcn_exp2f(p1[r] - m); ps += p0[r] + p1[r]; } }
            l += ps;
            bf16x8 pf[4];
#pragma unroll
            for (int ks = 0; ks < 4; ++ks) { u32x4 w;
                if (ks < 2) { w.x = pk2(p0[8 * ks], p0[8 * ks + 1]); w.y = pk2(p0[8 * ks + 2], p0[8 * ks + 3]); w.z = pk2(p0[8 * ks + 4], p0[8 * ks + 5]); w.w = pk2(p0[8 * ks + 6], p0[8 * ks + 7]); }
                else { const int b = 8 * (ks - 2); w.x = pk2(p1[b], p1[b + 1]); w.y = pk2(p1[b + 2], p1[b + 3]); w.z = pk2(p1[b + 4], p1[b + 5]); w.w = pk2(p1[b + 6], p1[b + 7]); }
                pf[ks] = __builtin_bit_cast(bf16x8, w); }
            { const LAS unsigned char* vt = stg + C::KB; v4i16_t va[8], vb[8];
#define ATT_VLD(dst, d0) do { _Pragma("unroll") for (int ks = 0; ks < 4; ++ks) { \
                  dst[2 * ks] = __builtin_amdgcn_ds_read_tr16_b64_v4i16((LAS v4i16_t*)(vt + vbase0 + 64u * ((unsigned)(d0) ^ q4) + 4096u * ks)); \
                  dst[2 * ks + 1] = __builtin_amdgcn_ds_read_tr16_b64_v4i16((LAS v4i16_t*)(vt + vbase1 + 64u * ((unsigned)(d0) ^ q4) + 4096u * ks)); } } while (0)
#define ATT_PV(v, d0) do { _Pragma("unroll") for (int ks = 0; ks < 4; ++ks) { const bf16x8 vf = {v[2 * ks][0], v[2 * ks][1], v[2 * ks][2], v[2 * ks][3], v[2 * ks + 1][0], v[2 * ks + 1][1], v[2 * ks + 1][2], v[2 * ks + 1][3]}; \
                  o[d0] = __builtin_amdgcn_mfma_f32_32x32x16_bf16(vf, pf[ks], o[d0], 0, 0, 0); } } while (0)
              if (!(ABL & 1)) { ATT_VLD(va, 0); ATT_SB; ATT_VLD(vb, 1); ATT_SB; ATT_PV(va, 0); ATT_SB; ATT_VLD(va, 2); ATT_SB; ATT_PV(vb, 1); ATT_SB; ATT_VLD(vb, 3); ATT_SB; ATT_PV(va, 2); ATT_SB; ATT_PV(vb, 3); ATT_SB; } else { asm volatile("" :: "v"(pf[0]), "v"(pf[1]), "v"(pf[2]), "v"(pf[3])); }
            }
        }
        st = (st == 2) ? 0 : st + 1;
    }
    l += __shfl_xor(l, 32); const float il = 1.f / l; float ss = 0.f;
    bf16_t* op = Obh + (size_t)(qrow_w + c) * ldo;
#pragma unroll
    for (int d = 0; d < 4; ++d)
#pragma unroll
        for (int g = 0; g < 4; ++g) { f32x4 v = {o[d][4 * g] * il, o[d][4 * g + 1] * il, o[d][4 * g + 2] * il, o[d][4 * g + 3] * il}; ss += dot4(v); st_bf4(op + 32 * d + 8 * g + 4 * hi, v); }
    if (ssout) { ss += __shfl_xor(ss, 32); if (hi == 0) ssout[(size_t)(qrow_w + c) * ssld] = ss; }
    asm volatile("s_waitcnt lgkmcnt(0)" ::: "memory"); __builtin_amdgcn_s_barrier(); asm volatile("" ::: "memory");
}
struct LaneC { unsigned kbase, koff[4], vbase0, vbase1, q4; int c, hi; };
template <int DK, int MODE> __device__ __forceinline__ void tile_compute(const LAS unsigned char* stg, const bf16x8 (&qf)[8], const LAS unsigned char* qr, f32x16 (&o)[4], float& m, float& l, int t, int qrow_w, const LaneC& L) {
    typedef Cfg<DK> C; constexpr float THR = 8.f; constexpr bool H0 = (MODE != 2), H1 = (MODE != 1);
    const int qrow = qrow_w + L.c, hi = L.hi;
    f32x16 p0 = {0.f, 0.f, 0.f, 0.f, 0.f, 0.f, 0.f, 0.f, 0.f, 0.f, 0.f, 0.f, 0.f, 0.f, 0.f, 0.f}, p1 = p0;
    { const LAS unsigned char* kp = stg + L.kbase;
#define ATT_KA(s) (((s) >> 2) * 8192 + L.koff[(s) & 3])
#define ATT_SB __builtin_amdgcn_sched_barrier(0)
      if (MODE == 0) { bf16x8 k3[3][2], q3[3];
#define ATT_KLD(i, s) do { k3[i][0] = *(const LAS bf16x8*)(kp + ATT_KA(s)); k3[i][1] = *(const LAS bf16x8*)(kp + ATT_KA(s) + 4096); if ((s) >= 8) q3[i] = *(const LAS bf16x8*)(qr + ((s) - 8) * 32); } while (0)
#define ATT_MM(i, s) do { const bf16x8 q_ = ((s) < 8) ? qf[(s) < 8 ? (s) : 0] : q3[i]; p0 = __builtin_amdgcn_mfma_f32_32x32x16_bf16(k3[i][0], q_, p0, 0, 0, 0); p1 = __builtin_amdgcn_mfma_f32_32x32x16_bf16(k3[i][1], q_, p1, 0, 0, 0); } while (0)
          ATT_KLD(0, 0); ATT_KLD(1, 1); ATT_SB;
#pragma unroll
          for (int s = 0; s < DK / 16; ++s) { if (s + 2 < DK / 16) ATT_KLD((s + 2) % 3, s + 2); ATT_SB; ATT_MM(s % 3, s); ATT_SB; }
#undef ATT_KLD
#undef ATT_MM
      } else { constexpr int KO = (MODE == 2) ? 4096 : 0; bf16x8 ka[4], kb[4];
#define ATT_KLD1(dst, s) do { dst[0] = *(const LAS bf16x8*)(kp + ATT_KA(s) + KO); dst[1] = *(const LAS bf16x8*)(kp + ATT_KA((s) + 1) + KO); dst[2] = *(const LAS bf16x8*)(kp + ATT_KA((s) + 2) + KO); dst[3] = *(const LAS bf16x8*)(kp + ATT_KA((s) + 3) + KO); } while (0)
#define ATT_MM1(k, s) do { _Pragma("unroll") for (int i_ = 0; i_ < 4; ++i_) { const bf16x8 q_ = ((s) < 8) ? qf[((s) < 8 ? (s) : 0) + i_] : *(const LAS bf16x8*)(qr + i_ * 32); if (MODE == 1) p0 = __builtin_amdgcn_mfma_f32_32x32x16_bf16(k[i_], q_, p0, 0, 0, 0); else p1 = __builtin_amdgcn_mfma_f32_32x32x16_bf16(k[i_], q_, p1, 0, 0, 0); } } while (0)
          ATT_KLD1(ka, 0); ATT_SB; ATT_KLD1(kb, 4); ATT_SB; ATT_MM1(ka, 0); ATT_SB;
          if (DK == 192) { ATT_KLD1(ka, 8); ATT_SB; ATT_MM1(kb, 4); ATT_SB; ATT_MM1(ka, 8); ATT_SB; } else { ATT_MM1(kb, 4); ATT_SB; }
#undef ATT_KLD1
#undef ATT_MM1
      }
    }
    if (64 * t + 63 > qrow_w) {
#pragma unroll
        for (int r = 0; r < 16; ++r) { const int key = 64 * t + (r & 3) + 8 * (r >> 2) + 4 * hi; if (H0 && key > qrow) p0[r] = -INFINITY; if (H1 && key + 32 > qrow) p1[r] = -INFINITY; } }
    float tm = H0 ? p0[0] : p1[0];
#pragma unroll
    for (int r = 0; r < 16; ++r) { if (H0) tm = fmaxf(tm, p0[r]); if (H1) tm = fmaxf(tm, p1[r]); }
    { auto rr = __builtin_amdgcn_permlane32_swap(__float_as_uint(tm), __float_as_uint(tm), false, false); tm = fmaxf(__uint_as_float(rr[0]), __uint_as_float(rr[1])); }
    if (__any(tm > m + THR)) {
        const float mn = fmaxf(m, tm), alpha = __builtin_amdgcn_exp2f(m - mn); m = mn; l *= alpha;
#pragma unroll
        for (int d0 = 0; d0 < 4; ++d0)
#pragma unroll
            for (int r = 0; r < 16; ++r) o[d0][r] *= alpha; }
    float ps = 0.f;
#pragma unroll
    for (int r = 0; r < 16; ++r) { if (H0) { p0[r] = __builtin_amdgcn_exp2f(p0[r] - m); ps += p0[r]; } if (H1) { p1[r] = __builtin_amdgcn_exp2f(p1[r] - m); ps += p1[r]; } }
    l += ps;
    bf16x8 pf[4];
#pragma unroll
    for (int ks = 0; ks < 4; ++ks) { u32x4 w = {0u, 0u, 0u, 0u};
        if (ks < 2) { if (H0) { w.x = pk2(p0[8 * ks], p0[8 * ks + 1]); w.y = pk2(p0[8 * ks + 2], p0[8 * ks + 3]); w.z = pk2(p0[8 * ks + 4], p0[8 * ks + 5]); w.w = pk2(p0[8 * ks + 6], p0[8 * ks + 7]); } }
        else if (H1) { const int b = 8 * (ks - 2); w.x = pk2(p1[b], p1[b + 1]); w.y = pk2(p1[b + 2], p1[b + 3]); w.z = pk2(p1[b + 4], p1[b + 5]); w.w = pk2(p1[b + 6], p1[b + 7]); }
        pf[ks] = __builtin_bit_cast(bf16x8, w); }
    { const LAS unsigned char* vt = stg + C::KB; constexpr int KS0 = H0 ? 0 : 2, NKS = (MODE == 0) ? 4 : 2; v4i16_t va[2 * NKS], vb[2 * NKS];
#define ATT_VLD(dst, d0) do { _Pragma("unroll") for (int k_ = 0; k_ < NKS; ++k_) { \
          dst[2 * k_] = __builtin_amdgcn_ds_read_tr16_b64_v4i16((LAS v4i16_t*)(vt + L.vbase0 + 64u * ((unsigned)(d0) ^ L.q4) + 4096u * (KS0 + k_))); \
          dst[2 * k_ + 1] = __builtin_amdgcn_ds_read_tr16_b64_v4i16((LAS v4i16_t*)(vt + L.vbase1 + 64u * ((unsigned)(d0) ^ L.q4) + 4096u * (KS0 + k_))); } } while (0)
#define ATT_PV(v, d0) do { _Pragma("unroll") for (int k_ = 0; k_ < NKS; ++k_) { const bf16x8 vf = {v[2 * k_][0], v[2 * k_][1], v[2 * k_][2], v[2 * k_][3], v[2 * k_ + 1][0], v[2 * k_ + 1][1], v[2 * k_ + 1][2], v[2 * k_ + 1][3]}; \
          o[d0] = __builtin_amdgcn_mfma_f32_32x32x16_bf16(vf, pf[KS0 + k_], o[d0], 0, 0, 0); } } while (0)
      ATT_VLD(va, 0); ATT_SB; ATT_VLD(vb, 1); ATT_SB; ATT_PV(va, 0); ATT_SB; ATT_VLD(va, 2); ATT_SB; ATT_PV(vb, 1); ATT_SB; ATT_VLD(vb, 3); ATT_SB; ATT_PV(va, 2); ATT_SB; ATT_PV(vb, 3); ATT_SB;
#undef ATT_VLD
#undef ATT_PV
    }
#undef ATT_KA
#undef ATT_SB
}
__device__ __forceinline__ void attn_store(const f32x16 (&o)[4], float l, bf16_t* Obh, int ldo, float* ssout, int ssld, int qrow_w, int c, int hi) {
    l += __shfl_xor(l, 32); const float il = 1.f / l; float ss = 0.f;
    bf16_t* op = Obh + (size_t)(qrow_w + c) * ldo;
#pragma unroll
    for (int d = 0; d < 4; ++d)
#pragma unroll
        for (int g = 0; g < 4; ++g) { f32x4 v = {o[d][4 * g] * il, o[d][4 * g + 1] * il, o[d][4 * g + 2] * il, o[d][4 * g + 3] * il}; ss += dot4(v); st_bf4(op + 32 * d + 8 * g + 4 * hi, v); }
    if (ssout) { ss += __shfl_xor(ss, 32); if (hi == 0) ssout[(size_t)(qrow_w + c) * ssld] = ss; }
}
template <int DK> __device__ __forceinline__ void attn_wg2(int tid, LAS unsigned char* ring, LAS float* comb, unsigned char* ws, int b, int h, int qrow_own, int nt_own, int qrow_par, int nt_par, int nt_max) {
    typedef Cfg<DK> C;
    constexpr int ldq = NH * DQK, ldk = NH * DQK, ldv = 512, ldo = DM, ssld = 8;
    const bf16_t* Qbh = EB16(WS_Q) + (size_t)b * SEQ * ldq + DQK * h; const bf16_t* Kbh = EB16(WS_K) + (size_t)b * SEQ * ldk + DQK * h; const bf16_t* Vbh = EB16(WS_V) + (size_t)b * SEQ * ldv + DV * h;
    bf16_t* Obh = EB16(WS_YCAT) + (size_t)b * SEQ * ldo + DV * h; float* ssout = EF32(WS_SSY) + (size_t)b * SEQ * ssld + h;
    const int lane = tid & 63, wid = __builtin_amdgcn_readfirstlane(tid >> 6), c = lane & 31, hi = lane >> 5;
    const bool is_short = nt_own < nt_par;
    stage_tile<DK>(ring, Kbh, ldk, Vbh, ldv, 0, wid, lane);
    if (nt_max > 1) stage_tile<DK>(ring + C::STG, Kbh, ldk, Vbh, ldv, 1, wid, lane);
    static_assert(DK == 192, "attn_wg2 is the MLA body");
    LAS unsigned char* qslot = ring + 3 * C::STG + wid * 4608; const LAS unsigned char* qr = qslot + c * 144 + hi * 16;
    bf16x8 qf[8];
#define ATT_LOADQ(qrow_) do { const bf16_t* qp = Qbh + (size_t)((qrow_) + c) * ldq + 8 * hi; bf16x8 qrp[4]; \
      _Pragma("unroll") for (int s = 0; s < 8; ++s) qf[s] = *(const bf16x8*)(qp + 16 * s); \
      _Pragma("unroll") for (int s = 0; s < 4; ++s) qrp[s] = *(const bf16x8*)(qp + 128 + 16 * s); \
      _Pragma("unroll") for (int s = 0; s < 4; ++s) *(LAS bf16x8*)(qslot + c * 144 + hi * 16 + s * 32) = qrp[s]; \
      asm volatile("s_waitcnt lgkmcnt(0)" ::: "memory"); } while (0)
    ATT_LOADQ(qrow_own);
    f32x16 o[4];
#pragma unroll
    for (int r = 0; r < 16; ++r) { o[0][r] = 0.f; o[1][r] = 0.f; o[2][r] = 0.f; o[3][r] = 0.f; }
    float m = -1e30f, l = 0.f;
    LaneC LC; { const unsigned q4 = (lane & 15) >> 2, p4 = lane & 3, blk = (lane >> 4) & 1, cl = 2 * blk + (p4 >> 1); LC.q4 = q4; LC.c = c; LC.hi = hi;
        LC.vbase0 = 256u * (4 * hi + q4) + 16u * (cl ^ (unsigned)hi) + 8u * (p4 & 1); LC.vbase1 = 2048u + 256u * (4 * hi + q4) + 16u * (cl ^ (2u + (unsigned)hi)) + 8u * (p4 & 1);
        const int kkr = c & 7, kkg = c >> 3; LC.kbase = (unsigned)(kkg * 1024 + (kkr ^ (kkg & 1)) * 128);
#pragma unroll
        for (int i = 0; i < 4; ++i) LC.koff[i] = (unsigned)(((2 * i + hi) ^ kkr) * 16); }
    const int nt_sw = is_short ? nt_own : nt_par;
    int st = 0;
#define ATT_ITER_HEAD() do { if (t + 1 < nt_max) asm volatile("s_waitcnt vmcnt(%0)" :: "n"(C::NPW) : "memory"); else asm volatile("s_waitcnt vmcnt(0)" ::: "memory"); \
        asm volatile("s_waitcnt lgkmcnt(0)" ::: "memory"); __builtin_amdgcn_s_barrier(); asm volatile("" ::: "memory"); \
        if (t + 2 < nt_max) { const int st2 = (st == 0) ? 2 : st - 1; stage_tile<DK>(ring + st2 * C::STG, Kbh, ldk, Vbh, ldv, t + 2, wid, lane); } } while (0)
    int t = 0;
#pragma unroll 1
    for (; t < nt_sw; ++t) { ATT_ITER_HEAD(); tile_compute<DK, 0>(ring + st * C::STG, qf, qr, o, m, l, t, qrow_own, LC); st = (st == 2) ? 0 : st + 1; }
    int qrow_cur = qrow_own, nt_end = nt_own;
    if (is_short) {
        attn_store(o, l, Obh, ldo, ssout, ssld, qrow_own, c, hi);
        ATT_LOADQ(qrow_par);
#pragma unroll
        for (int r = 0; r < 16; ++r) { o[0][r] = 0.f; o[1][r] = 0.f; o[2][r] = 0.f; o[3][r] = 0.f; }
        m = -1e30f; l = 0.f; qrow_cur = qrow_par; nt_end = nt_par; }
#pragma unroll 1
    for (; t < nt_max; ++t) { ATT_ITER_HEAD();
        if (t < nt_end) { if (is_short) tile_compute<DK, 2>(ring + st * C::STG, qf, qr, o, m, l, t, qrow_cur, LC); else tile_compute<DK, 1>(ring + st * C::STG, qf, qr, o, m, l, t, qrow_cur, LC); }
        st = (st == 2) ? 0 : st + 1; }
#undef ATT_ITER_HEAD
    asm volatile("s_waitcnt lgkmcnt(0)" ::: "memory"); __builtin_amdgcn_s_barrier(); asm volatile("" ::: "memory");
    LAS float* slot = comb + ((wid & 3) * 64 + lane) * 68;
    if (is_short) { slot[0] = m; slot[1] = l;
#pragma unroll
        for (int d = 0; d < 4; ++d)
#pragma unroll
            for (int g = 0; g < 4; ++g) *(LAS f32x4*)(slot + 4 + 16 * d + 4 * g) = (f32x4){o[d][4 * g], o[d][4 * g + 1], o[d][4 * g + 2], o[d][4 * g + 3]}; }
    asm volatile("s_waitcnt lgkmcnt(0)" ::: "memory"); __builtin_amdgcn_s_barrier(); asm volatile("" ::: "memory");
    if (!is_short) { const float mh = slot[0], lh = slot[1]; const float ms = fmaxf(m, mh), ao = __builtin_amdgcn_exp2f(m - ms), ah = __builtin_amdgcn_exp2f(mh - ms); l = l * ao + lh * ah;
#pragma unroll
        for (int d = 0; d < 4; ++d)
#pragma unroll
            for (int g = 0; g < 4; ++g) { const f32x4 v = *(const LAS f32x4*)(slot + 4 + 16 * d + 4 * g);
#pragma unroll
                for (int i = 0; i < 4; ++i) o[d][4 * g + i] = o[d][4 * g + i] * ao + v[i] * ah; }
        attn_store(o, l, Obh, ldo, ssout, ssld, qrow_own, c, hi); }
    asm volatile("s_waitcnt lgkmcnt(0)" ::: "memory"); __builtin_amdgcn_s_barrier(); asm volatile("" ::: "memory");
}
}

constexpr int NTHREADS_C = 512;
constexpr int SSM_UL = 0, SSM_UL_STRIDE = 1040, SSM_KTL = 66560, SSM_SL = SSM_KTL + 16384, SSM_XPL = 140288, SSM_XP_STRIDE = 272;
__device__ __forceinline__ void pow_entry(float lr, float li, double dt, int n, float& re, float& im) {
    double a = (double)li * dt * (double)n; a -= 6.283185307179586 * rint(a * 0.15915494309189535); float sn, cs; __sincosf((float)a, &sn, &cs); const float mag = __expf((float)((double)lr * dt * (double)n)); re = mag * cs; im = mag * sn;
}
__device__ __forceinline__ void ssm_tables_item(int item, int tid, unsigned char* ldsb, unsigned char* ws) {
    const int g = item >> 3, part = item & 7;
    float2* pw = (float2*)ldsb;
    float2* bb = pw + 64 * 33;
    float2* cc = bb + 64 * 16;
    const float* a_re = EFI(15); const float* a_im = EFI(16); const float* log_dt = EFI(17);
    const double dt = exp((double)log_dt[g]);
    for (int e = tid; e < 64 * 33; e += NTHREADS_C) { const int p = e / 33, n = e % 33; float re, im; pow_entry(a_re[g * SP + p], a_im[g * SP + p], dt, n, re, im); pw[e] = make_float2(re, im); }
    { const float* b_re = EFI(18); const float* b_im = EFI(19);
      for (int e = tid; e < 64 * 16; e += NTHREADS_C) { const int p = e >> 4, h = e & 15; const float lr = a_re[g * SP + p], li = a_im[g * SP + p];
        float ar, ai; pow_entry(lr, li, dt, 1, ar, ai); const float den = lr * lr + li * li, nr = ar - 1.f;
        const float cr = (nr * lr + ai * li) / den, ci = (ai * lr - nr * li) / den; const float br = b_re[(g * SP + p) * 16 + h], bi = b_im[(g * SP + p) * 16 + h];
        bb[e] = make_float2(cr * br - ci * bi, cr * bi + ci * br); } }
    { const float* c_re = EFI(20); const float* c_im = EFI(21);
      for (int e = tid; e < 16 * 64; e += NTHREADS_C) cc[e] = make_float2(c_re[g * 16 * SP + e], c_im[g * 16 * SP + e]); }
    __syncthreads();
    if (part < 4) {
        const int hh = tid & 255, h = hh >> 4, h2 = hh & 15, tau0 = 8 * part + 4 * (tid >> 8);
        float acc[4];
#pragma unroll
        for (int j = 0; j < 4; ++j) acc[j] = 0.f;
        for (int p = 0; p < 64; ++p) { const float2 b = bb[p * 16 + h2], cv = cc[h * 64 + p];
#pragma unroll
            for (int j = 0; j < 4; ++j) { const float2 w = pw[p * 33 + tau0 + j]; const float wr = w.x * b.x - w.y * b.y, wi = w.x * b.y + w.y * b.x; acc[j] += cv.x * wr - cv.y * wi; } }
        if (tau0 == 0 && h == h2) acc[0] += EFI(22)[g * 16 + h];
        bf16_t* KT = EB16(WS_KT) + (size_t)g * 8192;
#pragma unroll
        for (int j = 0; j < 4; ++j) KT[((tau0 + j) * 16 + h) * 16 + h2] = (bf16_t)f2bf(acc[j]);
    } else if (part < 6) {
        bf16_t* BsT = EB16(WS_BST) + (size_t)g * 65536; const int k = tid, s = k >> 4, h2 = k & 15;
        for (int n = 64 * (part - 4); n < 64 * (part - 3); ++n) { const int p = n & 63; const float2 w = pw[p * 33 + 31 - s], b = bb[p * 16 + h2];
            const float v = (n < 64) ? (w.x * b.x - w.y * b.y) : (w.x * b.y + w.y * b.x); BsT[n * 512 + k] = (bf16_t)f2bf(v); }
    } else {
        bf16_t* CmT = EB16(WS_CMT) + (size_t)g * 65536; const int k = tid & 127, p = k & 63;
        for (int j = 0; j < 64; ++j) { const int n = 256 * (part - 6) + (tid >> 7) + 4 * j, t = n >> 4, h = n & 15; const float2 w = pw[p * 33 + t + 1], cv = cc[h * 64 + p];
            const float v = (k < 64) ? (cv.x * w.x - cv.y * w.y) : -(cv.x * w.y + cv.y * w.x); CmT[n * 128 + k] = (bf16_t)f2bf(v); }
    }
    __syncthreads();
}
__device__ __forceinline__ float gelu_tanh(float y) { const float z = 0.7978845608028654f * (y + 0.044715f * y * y * y); return y / (1.f + __expf(-2.f * z)); }
__device__ __forceinline__ void ssm_unit(int bg, int tid, LAS unsigned char* L, unsigned char* ws) {
    const int b = bg >> 5, g = bg & 31, lane = tid & 63, wid = __builtin_amdgcn_readfirstlane(tid >> 6), fr = lane & 15, fq = lane >> 4;
    const bf16_t* U = EB16(WS_U) + (size_t)b * SEQ * SSMW + g * 16;
    const bf16_t* BsT = EB16(WS_BST) + (size_t)g * 65536; const bf16_t* CmT = EB16(WS_CMT) + (size_t)g * 65536;
    bf16_t* Gout = EB16(WS_G) + (size_t)b * SEQ * SSMW + g * 16;
    { const u32x4* src = (const u32x4*)(EB16(WS_KT) + (size_t)g * 8192); LAS u32x4* dst = (LAS u32x4*)(L + SSM_KTL); dst[tid] = src[tid]; dst[tid + NTHREADS_C] = src[tid + NTHREADS_C]; }
    float xr = 0.f, xi = 0.f, Ar = 0.f, Ai = 0.f;
    if (wid == 0) pow_entry(EFI(15)[g * SP + lane], EFI(16)[g * SP + lane], exp((double)EFI(17)[g]), 32, Ar, Ai);
    const int tl0 = wid, tl1 = 15 - wid, tl2 = 16 + wid, tl3 = 31 - wid;
#define SSM_T(tt) ((tt) == 0 ? tl0 : (tt) == 1 ? tl1 : (tt) == 2 ? tl2 : tl3)
    bf16x8 cfr[4][4];
#pragma unroll
    for (int ks = 0; ks < 4; ++ks)
#pragma unroll
        for (int tt = 0; tt < 4; ++tt) cfr[ks][tt] = *(const bf16x8*)(CmT + (size_t)(SSM_T(tt) * 16 + fr) * 128 + 32 * ks + 8 * fq);
#pragma unroll 1
    for (int hf = 0; hf < 2; ++hf) {
#pragma unroll
        for (int i = 0; i < 4; ++i) { const int row = tid + NTHREADS_C * i; const u32x4* s = (const u32x4*)(U + (size_t)(hf * 2048 + row) * SSMW); LAS unsigned char* d = L + SSM_UL + (row >> 5) * SSM_UL_STRIDE + (row & 31) * 32;
            const u32x4 v0 = s[0], v1 = s[1]; *(LAS u32x4*)d = v0; *(LAS u32x4*)(d + 16) = v1; }
        __syncthreads();
        { f32x4 sacc[4]; bf16x8 bfr[16];
#pragma unroll
          for (int ks = 0; ks < 16; ++ks) bfr[ks] = *(const bf16x8*)(BsT + (size_t)(16 * wid + fr) * 512 + 32 * ks + 8 * fq);
#pragma unroll
          for (int mf = 0; mf < 4; ++mf) sacc[mf] = (f32x4){0.f, 0.f, 0.f, 0.f};
#pragma unroll
          for (int ks = 0; ks < 16; ++ks) {
#pragma unroll
              for (int mf = 0; mf < 4; ++mf) { const bf16x8 afr = *(const LAS bf16x8*)(L + SSM_UL + (16 * mf + fr) * SSM_UL_STRIDE + (2 * ks + (fq >> 1)) * 32 + (fq & 1) * 16);
                  sacc[mf] = __builtin_amdgcn_mfma_f32_16x16x32_bf16(bfr[ks], afr, sacc[mf], 0, 0, 0); } }
#pragma unroll
          for (int mf = 0; mf < 4; ++mf) *(LAS f32x4*)(L + SSM_SL + ((16 * mf + fr) * 128 + 16 * wid + 4 * fq) * 4) = sacc[mf]; }
        __syncthreads();
        if (wid == 0) { const LAS float* S = (const LAS float*)(L + SSM_SL);
#pragma unroll 1
            for (int c0 = 0; c0 < 64; c0 += 8) { float sr[8], si[8];
#pragma unroll
                for (int i = 0; i < 8; ++i) { sr[i] = S[(c0 + i) * 128 + lane]; si[i] = S[(c0 + i) * 128 + 64 + lane]; }
#pragma unroll
                for (int i = 0; i < 8; ++i) { LAS bf16_t* xp = (LAS bf16_t*)(L + SSM_XPL + (c0 + i) * SSM_XP_STRIDE); xp[lane] = (bf16_t)f2bf(xr); xp[64 + lane] = (bf16_t)f2bf(xi);
                    const float nr = Ar * xr - Ai * xi + sr[i], ni = Ar * xi + Ai * xr + si[i]; xr = nr; xi = ni; } } }
        f32x4 acc[4][4];
#pragma unroll
        for (int tt = 0; tt < 4; ++tt)
#pragma unroll
            for (int mf = 0; mf < 4; ++mf) acc[tt][mf] = (f32x4){0.f, 0.f, 0.f, 0.f};
#pragma unroll 2
        for (int ks = 0; ks < 16; ++ks) { if (2 * ks > tl3) break;
            bf16x8 afr[4];
#pragma unroll
            for (int mf = 0; mf < 4; ++mf) afr[mf] = *(const LAS bf16x8*)(L + SSM_UL + (16 * mf + fr) * SSM_UL_STRIDE + (2 * ks + (fq >> 1)) * 32 + (fq & 1) * 16);
#pragma unroll
            for (int tt = 0; tt < 4; ++tt) { const int t = SSM_T(tt);
                if (2 * ks <= t) { const int tau = t - 2 * ks - (fq >> 1); bf16x8 bfr = {0, 0, 0, 0, 0, 0, 0, 0};
                    if (tau >= 0) bfr = *(const LAS bf16x8*)(L + SSM_KTL + ((tau * 16 + fr) * 16 + 8 * (fq & 1)) * 2);
#pragma unroll
                    for (int mf = 0; mf < 4; ++mf) acc[tt][mf] = __builtin_amdgcn_mfma_f32_16x16x32_bf16(bfr, afr[mf], acc[tt][mf], 0, 0, 0); } } }
        __syncthreads();
#pragma unroll
        for (int ks = 0; ks < 4; ++ks) { bf16x8 afr[4];
#pragma unroll
            for (int mf = 0; mf < 4; ++mf) afr[mf] = *(const LAS bf16x8*)(L + SSM_XPL + (16 * mf + fr) * SSM_XP_STRIDE + (32 * ks + 8 * fq) * 2);
#pragma unroll
            for (int tt = 0; tt < 4; ++tt) {
#pragma unroll
                for (int mf = 0; mf < 4; ++mf) acc[tt][mf] = __builtin_amdgcn_mfma_f32_16x16x32_bf16(cfr[ks][tt], afr[mf], acc[tt][mf], 0, 0, 0); } }
#pragma unroll
        for (int tt = 0; tt < 4; ++tt) { const int t = SSM_T(tt);
#pragma unroll
            for (int mf = 0; mf < 4; ++mf) { f32x4 v = acc[tt][mf];
#pragma unroll
                for (int i = 0; i < 4; ++i) v[i] = gelu_tanh(v[i]);
                st_bf4(Gout + (size_t)(hf * 2048 + (16 * mf + fr) * 32 + t) * SSMW + 4 * fq, v); } }
        __syncthreads();
    }
#undef SSM_T
}

constexpr int NWAVES = 8, NTHREADS = NWAVES * 64;
constexpr int RING_BYTES = 131072, LDS_BYTES = 163840, LDSCTL_OFF = LDS_BYTES - 1024, MISC_OFF = LDSCTL_OFF + 320, SCR_OFF = RING_BYTES + 1024;
constexpr size_t CTL_ZERO_BYTES = 64 * 1024;
constexpr int CW_BAR = 1024;
#define RLX_AGENT __ATOMIC_RELAXED, __HIP_MEMORY_SCOPE_AGENT
#define XB_TMO      128
#define XB_XCNT(j)  (256  + 64 * (j))
#define XB_XSUB(j)  (1280 + 64 * (j))
#define XB_XGEN(j)  (2304 + 64 * (j))
#define XB_TOP      3328
#define XB_TOPGEN   3392
#define XCD_BAR_WORDS 3456
#define XB_SPIN_CAP (1u << 24)
static_assert((CW_BAR + XCD_BAR_WORDS) * 4 <= (int)CTL_ZERO_BYTES, "barrier words inside the memset region");
__device__ __forceinline__ unsigned xb_ld(unsigned* p)              { return __hip_atomic_load(p, __ATOMIC_RELAXED, __HIP_MEMORY_SCOPE_AGENT); }
__device__ __forceinline__ unsigned xb_add(unsigned* p, unsigned v) { return __hip_atomic_fetch_add(p, v, __ATOMIC_RELAXED, __HIP_MEMORY_SCOPE_AGENT); }
__device__ __forceinline__ unsigned xb_xcc_id() { return (unsigned)__builtin_amdgcn_s_getreg((3 << 11) | 20) & 0xFu; }
#define XB_SPIN(cond, bar) do { unsigned _sp = 0; while (cond) { __builtin_amdgcn_s_sleep(1); \
    if ((++_sp & 255u) == 0u) { if (xb_ld(&(bar)[XB_TMO])) break; if (_sp > XB_SPIN_CAP) { atomicAdd(&(bar)[XB_TMO], 1u); break; } } } } while (0)
__device__ __forceinline__ int hw_lane() { return (int)__builtin_amdgcn_mbcnt_hi(~0u, __builtin_amdgcn_mbcnt_lo(~0u, 0u)); }
struct XcdBarrier { unsigned* bar; unsigned x; volatile LAS unsigned* st; int wave; };
__device__ __forceinline__ XcdBarrier xcd_barrier_post(unsigned* bar, volatile LAS unsigned* st, int wave) {
    XcdBarrier b; b.bar = bar; b.x = xb_xcc_id(); b.st = st; b.wave = wave;
    if (wave == 0 && hw_lane() == 0) (void)xb_add(&bar[XB_XCNT(b.x)], 1u);
    return b;
}
__device__ __forceinline__ void xcd_barrier_complete(unsigned* bar, unsigned x, unsigned& nloc, unsigned& nx) {
    const unsigned G = gridDim.x * gridDim.y * gridDim.z;
    unsigned sum, cnt, mine, sp = 0u;
    for (;;) {
        sum = 0u; cnt = 0u; mine = 0u;
#pragma unroll
        for (unsigned j = 0; j < 16; ++j) { const unsigned c = xb_ld(&bar[XB_XCNT(j)]); sum += c; cnt += (c > 0u) ? 1u : 0u; mine = (j == x) ? c : mine; }
        if (sum == G) break;
        __builtin_amdgcn_s_sleep(1);
        if ((++sp & 255u) == 0u) { if (xb_ld(&bar[XB_TMO])) break; if (sp > XB_SPIN_CAP) { atomicAdd(&bar[XB_TMO], 1u); break; } }
    }
    nloc = mine > 0u ? mine : 1u; nx = cnt > 0u ? cnt : 1u;
}
__device__ __forceinline__ void xcd_barrier(const XcdBarrier& b) {
    asm volatile("s_waitcnt vmcnt(0)" ::: "memory");
    __syncthreads();
    if (b.wave == 0 && hw_lane() == 0) {
        unsigned* bar = b.bar;
        __builtin_amdgcn_s_waitcnt(0);
        unsigned nloc = b.st[0], nx = b.st[1];
        if (nloc == 0u) { xcd_barrier_complete(bar, b.x, nloc, nx); b.st[0] = nloc; b.st[1] = nx; }
        const unsigned old = xb_add(&bar[XB_XSUB(b.x)], 1u);
        const unsigned gen = old / nloc;
        if (old + 1u == (gen + 1u) * nloc) {
            __builtin_amdgcn_fence(__ATOMIC_RELEASE, "agent");
            asm volatile("s_waitcnt vmcnt(0)" ::: "memory");
            const unsigned og = xb_add(&bar[XB_TOP], 1u);
            const unsigned tg = og / nx;
            if (og + 1u == (tg + 1u) * nx) xb_add(&bar[XB_TOPGEN], 1u);
            else XB_SPIN(xb_ld(&bar[XB_TOPGEN]) == tg, bar);
            __builtin_amdgcn_fence(__ATOMIC_ACQUIRE, "agent");
            xb_add(&bar[XB_XGEN(b.x)], 1u);
            asm volatile("s_waitcnt vmcnt(0)" ::: "memory");
        } else {
            XB_SPIN(xb_ld(&bar[XB_XGEN(b.x)]) == gen, bar);
            __builtin_amdgcn_fence(__ATOMIC_ACQUIRE, "agent");
            asm volatile("s_waitcnt vmcnt(0)" ::: "memory");
        }
    }
    __syncthreads();
}

constexpr int REP5A = 1, REP5S = 1, ATT_ABL = 0; constexpr int REP0 = 1; constexpr int REP1 = 1; constexpr int REP2 = 1; constexpr int REP3 = 1; constexpr int REP4 = 1; constexpr int REP5 = 1; constexpr int REP6 = 1; constexpr int REP7 = 1; constexpr int REP8 = 1; constexpr int REP9 = 1; constexpr int REP10 = 1; constexpr int REP11 = 1;
#define FI(i) ((const float*)karg(i))
#define KOUT() ((float*)karg(39))
#define KWS() ((unsigned char*)karg(40))
#define B16(off) ((bf16_t*)(ws + (off)))
#define F32(off) ((float*)(ws + (off)))
#define PHASE_IDS() int tid = wave_idx * 64 + hw_lane(); asm volatile("" : "+v"(tid)); const int lane = tid & 63, wave = __builtin_amdgcn_readfirstlane(tid >> 6), half = tid >> 8, vtid = tid & 255; \
    const int G = gridDim.x, bid = blockIdx.x; unsigned char* ws = KWS(); (void)lane; (void)wave; (void)half; (void)vtid; (void)G; (void)bid; (void)ws
#define FOR_VB(vb, n) for (int vb = 2 * bid + half; vb < (n); vb += 2 * G)
#define RING ((LAS unsigned char*)lds)
#define SCR ((LAS float*)(lds + SCR_OFF))
__global__ void __launch_bounds__(NTHREADS, 2) fwd_megakernel(Params P) {
    extern __shared__ __attribute__((aligned(16))) unsigned char lds[];
    const int wave_idx = __builtin_amdgcn_readfirstlane((int)threadIdx.x >> 6);
    { const int tid0 = wave_idx * 64 + hw_lane(); for (int u = tid0; u < (LDS_BYTES - LDSCTL_OFF) / 4; u += NTHREADS) ((unsigned*)(lds + LDSCTL_OFF))[u] = 0u; }
    __syncthreads();
    XcdBarrier bar = xcd_barrier_post((unsigned*)(KWS() + WS_CTL) + CW_BAR, (volatile LAS unsigned*)(lds + MISC_OFF) + 8, wave_idx);
#define GRID_BAR() xcd_barrier(bar)

#pragma unroll 1
    for (int rep = 0; rep < REP0; ++rep) {
    { PHASE_IDS();
        LAS float* scr = (LAS float*)(lds + wave * 8448);
        convert_subset(WM_P0, bid * NWAVES + wave, G * NWAVES, lane, scr, ws);
        for (int idx = bid * NWAVES + wave; idx < NROW_ITEMS; idx += G * NWAVES) { const int r0 = 8 * idx; const float* x = FI(0);
#pragma unroll 2
            for (int j = 0; j < 8; ++j) row_to_bf16(x, B16(WS_XB), F32(WS_SS), r0 + j, lane); }
    }
    GRID_BAR(); }
#pragma unroll 1
    for (int rep = 0; rep < REP1; ++rep) {
    { PHASE_IDS(); pg8::Gemm g{B16(WS_XB), B16(WS_W1T), DM, DM, T, NUP}; pg8::StaticOrder S; S.init(T, NUP, G, bid);
      const PEpiUp<1> e{0, ws}; pg8::gemm_phase(tid, RING, SCR, g, S, e); }
    { PHASE_IDS(); const int nfull = ((T / 256) * (NUP / 256)) % G;
      const int nw = (nfull > 0 ? (G - nfull) : G) * NWAVES, wr = ((nfull > 0 ? bid - nfull : bid)) * NWAVES + wave;
      if (nfull == 0 || bid >= nfull) { LAS float* scr = (LAS float*)(lds + wave * 8448);
          convert_subset(WM_P1, wr, nw, lane, scr, ws);
          for (int idx = wr; idx < NMEM_ITEMS + NROPE_ITEMS; idx += nw) {
              if (idx < NMEM_ITEMS) { const int r0 = 8 * idx; const float* mem = FI(1); for (int j = 0; j < 8; ++j) row_to_bf16(mem, B16(WS_MEMB), F32(WS_SSMEM), r0 + j, lane); }
              else { const int e0 = 512 * (idx - NMEM_ITEMS); const int* pos = (const int*)karg(2); for (int j = 0; j < 8; ++j) rope_entry(pos, (float2*)(ws + WS_ROPE), e0 + 64 * j + lane); } } } }
    GRID_BAR(); }
#pragma unroll 1
    for (int rep = 0; rep < REP2; ++rep) {
    { PHASE_IDS(); pg8::Gemm g{B16(WS_H), B16(WS_WD1T), DFFP, DFFP, T, DM}; pg8::StaticOrder S; S.init(T, DM, G, bid);
      const PEpiRes<0> e{0, ws}; pg8::gemm_phase(tid, RING, SCR, g, S, e); }
    GRID_BAR(); }
#pragma unroll 1
    for (int rep = 0; rep < REP3; ++rep) {
    { PHASE_IDS(); pg8::Gemm g{B16(WS_XB), B16(WS_WINT), DM, DM, T, NIN}; pg8::StaticOrder S; S.init(T, NIN, G, bid);
      const PEpiIn e{0, ws}; pg8::gemm_phase(tid, RING, SCR, g, S, e); }
    { PHASE_IDS(); pg8::Gemm g{B16(WS_MEMB), B16(WS_WXKVT), DM, DM, TM, DM}; pg8::StaticOrder S; S.init(TM, DM, G, (bid >= 64 && bid < 80) ? bid - 64 : -1); S.G = 16;
      const PEpiMemKV<false> e{0, ws}; pg8::gemm_phase(tid, RING, SCR, g, S, e); }
    { PHASE_IDS(); if (G > 80 && bid >= 80) for (int it = bid - 80; it < 8 * SG; it += G - 80) ssm_tables_item(it, tid, lds, ws);
      if (G <= 80) for (int it = bid; it < 8 * SG; it += G) ssm_tables_item(it, tid, lds, ws); }
    GRID_BAR(); }
#pragma unroll 1
    for (int rep = 0; rep < REP4; ++rep) {
    { PHASE_IDS(); pg8::Gemm g{B16(WS_CQ), B16(WS_WUQT), QRANK, QRANK, T, 1024}; pg8::StaticOrder S; S.init(T, 1024, G, bid);
      const PEpiQ e{0, ws}; pg8::gemm_phase(tid, RING, SCR, g, S, e); }
    { PHASE_IDS(); pg8::Gemm g{B16(WS_CKV), B16(WS_WUKVT), KVRANK, KVRANK, T, 1024}; pg8::StaticOrder S; S.init(T, 1024, G, bid);
      const PEpiKV<false> e{0, ws}; pg8::gemm_phase(tid, RING, SCR, g, S, e); }
    GRID_BAR(); }
#pragma unroll 1
    for (int rep = 0; rep < REP5; ++rep) {
    { PHASE_IDS(); const int vcu = (G % 8 == 0) ? (bid % 8) * (G / 8) + bid / 8 : bid;
#pragma unroll 1
      for (int rr = 0; rr < REP5A; ++rr)
      for (int v = vcu; v < 256; v += G) { const int bh = v >> 4, j = v & 15, b = bh / NH, h = bh % NH;
          const int wq = wave >> 1, qblk = (wq == 0) ? j : (wq == 1) ? 31 - j : (wq == 2) ? 63 - j : 32 + j, qpar = (wq == 0) ? 63 - j : (wq == 1) ? 32 + j : (wq == 2) ? j : 31 - j;
          att::attn_wg2<DQK>(tid, RING, (LAS float*)RING, ws, b, h, 64 * qblk + 32 * (wave & 1), qblk + 1, 64 * qpar + 32 * (wave & 1), qpar + 1, 64 - j); } }
    { PHASE_IDS(); const int vcu = (G % 8 == 0) ? (bid % 8) * (G / 8) + bid / 8 : bid;
#pragma unroll 1
      for (int rr = 0; rr < REP5S; ++rr)
      for (int v = vcu; v < 256; v += G) if ((v & 15) >= 8) ssm_unit((v >> 4) * 8 + (v & 15) - 8, tid, RING, ws); }
    GRID_BAR(); }
#pragma unroll 1
    for (int rep = 0; rep < REP6; ++rep) {
    { PHASE_IDS(); pg8::Gemm g{B16(WS_G), B16(WS_WGLUT), SSMW, SSMW, T, SSMW}; pg8::StaticOrder S; S.init(T, SSMW, G, bid);
      const PEpiGlu e{0, ws}; pg8::gemm_phase(tid, RING, SCR, g, S, e); }
    { PHASE_IDS(); const int nun = (T / 256) * (SSMW / 256);
      if (G > nun) { if (bid >= nun) convert_subset(WM_P6, (bid - nun) * NWAVES + wave, (G - nun) * NWAVES, lane, (LAS float*)(lds + wave * 8448), ws); }
      else convert_subset(WM_P6, bid * NWAVES + wave, G * NWAVES, lane, (LAS float*)(lds + wave * 8448), ws); }
    GRID_BAR(); }
#pragma unroll 1
    for (int rep = 0; rep < REP7; ++rep) {
    { PHASE_IDS(); pg8::Gemm g{B16(WS_YCAT), B16(WS_WOT), DM, DM, T, DM}; pg8::StaticOrder S; S.init(T, DM, G, bid);
      const PEpiWo e{8, ws}; pg8::gemm_phase(tid, RING, SCR, g, S, e); }
    GRID_BAR(); }
#pragma unroll 1
    for (int rep = 0; rep < REP8; ++rep) {
    { PHASE_IDS(); pg8::Gemm g{B16(WS_XB), B16(WS_WXQT), DM, DM, T, 512}; pg8::StaticOrder S; S.init(T, 512, G, bid);
      const PEpiXQ e{0, ws}; pg8::gemm_phase(tid, RING, SCR, g, S, e); }
    { PHASE_IDS(); const int nun = (T / 256) * (512 / 256);
      if (G > nun) { if (bid >= nun) convert_subset(WM_P8, (bid - nun) * NWAVES + wave, (G - nun) * NWAVES, lane, (LAS float*)(lds + wave * 8448), ws); }
      else convert_subset(WM_P8, bid * NWAVES + wave, G * NWAVES, lane, (LAS float*)(lds + wave * 8448), ws); }
    GRID_BAR(); }
#pragma unroll 1
    for (int rep = 0; rep < REP9; ++rep) {
    { PHASE_IDS(); const int vcu = (G % 8 == 0) ? (bid % 8) * (G / 8) + bid / 8 : bid;
      for (int v = vcu; v < 256; v += G) { const int bh = v >> 4, qb = v & 15, b = bh / NH, h = bh % NH; const size_t row0 = (size_t)b * SEQ + 256 * qb;
        att::attn_wg<128, false>(tid, RING, B16(WS_XQ) + (size_t)b * SEQ * 512 + 128 * h, 512, B16(WS_XK) + (size_t)b * MEML * 512 + 128 * h, 512, B16(WS_XV) + (size_t)b * MEML * 512 + 128 * h, 512,
                                 B16(WS_XO) + (size_t)b * SEQ * 512 + 128 * h, 512, (float*)nullptr, 0, 256 * qb + 32 * wave, MEML / 64, MEML / 64); } }
    GRID_BAR(); }
#pragma unroll 1
    for (int rep = 0; rep < REP10; ++rep) {
    { PHASE_IDS(); pg8::Gemm g{B16(WS_XO), B16(WS_WXOT), 512, 512, T, DM}; pg8::StaticOrder S; S.init(T, DM, G, bid);
      const PEpiRes<1> e{0, ws}; pg8::gemm_phase(tid, RING, SCR, g, S, e); }
    GRID_BAR(); }
#pragma unroll 1
    for (int rep = 0; rep < REP11; ++rep) {
    { PHASE_IDS(); pg8::Gemm g{B16(WS_XB), B16(WS_W2T), DM, DM, T, NUP}; pg8::StaticOrder S; S.init(T, NUP, G, bid);
      const PEpiUp<1> e{0, ws}; pg8::gemm_phase(tid, RING, SCR, g, S, e); }
    GRID_BAR(); }
    { PHASE_IDS(); pg8::Gemm g{B16(WS_H), B16(WS_WD2T), DFFP, DFFP, T, DM}; pg8::StaticOrder S; S.init(T, DM, G, bid);
      const PEpiRes<2> e{0, ws}; pg8::gemm_phase(tid, RING, SCR, g, S, e); }
}

extern "C" void kernel_launch(void* const* d_in, const int* in_sizes, int n_in, void* d_out, int out_size, void* d_ws, size_t ws_size, hipStream_t stream) {
    static int grid = 0;
    if (grid == 0) {
        if (n_in != 39 || out_size != T * DM || ws_size < WS_END) { fprintf(stderr, "kernel_launch: unexpected shapes (n_in %d out %d ws %zu)\n", n_in, out_size, ws_size); grid = -1; return; }
        int dev = 0, cus = 0, per_cu = 0;
        if (hipGetDevice(&dev) != hipSuccess || hipDeviceGetAttribute(&cus, hipDeviceAttributeMultiprocessorCount, dev) != hipSuccess) { grid = -1; return; }
        if (hipFuncSetAttribute((const void*)fwd_megakernel, hipFuncAttributeMaxDynamicSharedMemorySize, LDS_BYTES) != hipSuccess) { fprintf(stderr, "kernel_launch: hipFuncSetAttribute failed\n"); grid = -1; return; }
        if (hipOccupancyMaxActiveBlocksPerMultiprocessor(&per_cu, (const void*)fwd_megakernel, NTHREADS, LDS_BYTES) != hipSuccess || per_cu < 1) { fprintf(stderr, "kernel_launch: occupancy query says %d\n", per_cu); }
        (void)hipGetLastError();
        grid = cus;
    }
    if (grid < 0) return;
    (void)hipMemsetAsync((char*)d_ws + WS_CTL, 0, CTL_ZERO_BYTES, stream);
    Params p{};
    for (int i = 0; i < 39; ++i) p.in[i] = d_in[i];
    p.out = (float*)d_out; p.ws = (unsigned char*)d_ws;
    hipLaunchKernelGGL(fwd_megakernel, dim3(grid), dim3(NTHREADS), LDS_BYTES, stream, p);
}
```
